# Optimizing an MI355X kernel written in HIP

```python
import jax, jax.numpy as jnp
from jax import lax
import numpy as np

D_MODEL = 1024
BATCH = 8
SEQ = 8192
DEPTH = 1

HEAD_DIM = 64
N_FOX_HEADS = 8
N_SB_HEADS = 8
FOX_WIDTH = N_FOX_HEADS * HEAD_DIM
SB_WIDTH = N_SB_HEADS * HEAD_DIM
IN_COLS = 3 * FOX_WIDTH + N_FOX_HEADS + 3 * SB_WIDTH + 2 * D_MODEL
D_FF = 2816
CONV_WIDTH = 3
Q_BLOCK = 128
LN_EPS = 1e-5
N_MOD = 6
DEEPNORM_ALPHA = (2.0 * DEPTH) ** 0.25
DEEPNORM_BETA = (8.0 * DEPTH) ** -0.25
ATTN_SCALE = HEAD_DIM ** -0.5

kernel_name = "fox_stickbreak_gated_hybrid_deepnorm_adaln"


def _split_points():
    cols = [FOX_WIDTH] * 3 + [N_FOX_HEADS] + [SB_WIDTH] * 3 + [D_MODEL] * 2
    return [int(v) for v in np.cumsum(cols)[:-1]]


def _layer_norm(x, g, b):
    xf = x.astype(jnp.float32)
    mu = jnp.mean(xf, axis=-1, keepdims=True)
    var = jnp.mean(jnp.square(xf - mu), axis=-1, keepdims=True)
    y = (xf - mu) * lax.rsqrt(var + LN_EPS)
    return (y * g.astype(jnp.float32) + b.astype(jnp.float32)).astype(x.dtype)


def _to_heads(t, n_heads):
    b, s, _ = t.shape
    return t.reshape(b, s, n_heads, HEAD_DIM).transpose(0, 2, 1, 3)


def _merge_heads(t):
    b, h, s, d = t.shape
    return t.transpose(0, 2, 1, 3).reshape(b, s, h * d)


def _blocks(t):
    b, h, s = t.shape[:3]
    nb = s // Q_BLOCK
    t = t.reshape((b, h, nb, Q_BLOCK) + t.shape[3:])
    return jnp.moveaxis(t, 2, 0)


def _unblocks(t):
    nb, b, h, qb, d = t.shape
    return jnp.moveaxis(t, 0, 2).reshape(b, h, nb * qb, d)


def _forgetting_attention(q, k, v, log_f):
    s_len = q.shape[2]
    cum = jnp.cumsum(log_f, axis=-1)
    kpos = jnp.arange(s_len)

    def block(args):
        qi, cqi, bi = args
        qpos = bi * Q_BLOCK + jnp.arange(Q_BLOCK)
        logits = (jnp.einsum('bhqd,bhkd->bhqk', qi, k).astype(jnp.float32) * ATTN_SCALE
                  + cqi[..., None] - cum[:, :, None, :])
        causal = kpos[None, :] <= qpos[:, None]
        logits = jnp.where(causal, logits, -jnp.inf)
        p = jax.nn.softmax(logits, axis=-1)
        return jnp.einsum('bhqk,bhkd->bhqd', p.astype(v.dtype), v)

    nb = s_len // Q_BLOCK
    out = lax.map(block, (_blocks(q), _blocks(cum), jnp.arange(nb, dtype=jnp.int32)))
    return _unblocks(out)


def _stick_breaking_attention(q, k, v):
    s_len = q.shape[2]
    kpos = jnp.arange(s_len)

    def block(args):
        qi, bi = args
        qpos = bi * Q_BLOCK + jnp.arange(Q_BLOCK)
        z = jnp.einsum('bhqd,bhkd->bhqk', qi, k).astype(jnp.float32) * ATTN_SCALE
        strict = kpos[None, :] < qpos[:, None]
        log_beta = jax.nn.log_sigmoid(z)
        log_one_minus = jnp.where(strict, jax.nn.log_sigmoid(-z), 0.0)
        rest = lax.cumsum(log_one_minus, axis=3, reverse=True) - log_one_minus
        a = jnp.where(strict, jnp.exp(log_beta + rest), 0.0)
        return jnp.einsum('bhqk,bhkd->bhqd', a.astype(v.dtype), v)

    nb = s_len // Q_BLOCK
    out = lax.map(block, (_blocks(q), jnp.arange(nb, dtype=jnp.int32)))
    return _unblocks(out)


def _causal_depthwise_conv(h, w, b):
    s_len = h.shape[1]
    hp = jnp.pad(h, ((0, 0), (CONV_WIDTH - 1, 0), (0, 0)))
    out = b
    for tap in range(CONV_WIDTH):
        out = out + hp[:, tap:tap + s_len, :] * w[tap]
    return out


def setup_inputs(seed: int = 0) -> dict:
    key = jax.random.key(seed)
    ks = jax.random.split(key, 17)
    f32 = jnp.float32
    d = D_MODEL
    nrm = lambda k, shape, s: jax.random.normal(k, shape, f32) * s
    return {
        "x": nrm(ks[0], (BATCH, SEQ, d), 1.0),
        "c": nrm(ks[1], (BATCH, d), 1.0),
        "w_ada": nrm(ks[2], (d, N_MOD * d), 0.1 * d ** -0.5),
        "b_ada": nrm(ks[3], (N_MOD * d,), 0.01),
        "w_in": nrm(ks[4], (d, IN_COLS), d ** -0.5),
        "b_forget": jnp.linspace(1.0, 5.0, N_FOX_HEADS, dtype=f32) + nrm(ks[5], (N_FOX_HEADS,), 0.1),
        "w_fox_proj": nrm(ks[6], (FOX_WIDTH, d), FOX_WIDTH ** -0.5),
        "w_sb_proj": nrm(ks[7], (SB_WIDTH, d), SB_WIDTH ** -0.5),
        "w_o": nrm(ks[8], (d, d), DEEPNORM_BETA * d ** -0.5),
        "ln1_g": 1.0 + nrm(ks[9], (d,), 0.02),
        "ln1_b": nrm(ks[10], (d,), 0.02),
        "w_up": nrm(ks[11], (d, 2 * D_FF), d ** -0.5),
        "conv_w": nrm(ks[12], (CONV_WIDTH, 2 * D_FF), CONV_WIDTH ** -0.5),
        "conv_b": nrm(ks[13], (2 * D_FF,), 0.01),
        "w_down": nrm(ks[14], (D_FF, d), DEEPNORM_BETA * D_FF ** -0.5),
        "ln2_g": 1.0 + nrm(ks[15], (d,), 0.02),
        "ln2_b": nrm(ks[16], (d,), 0.02),
    }


def reference(x, c, w_ada, b_ada, w_in, b_forget, w_fox_proj, w_sb_proj, w_o,
              ln1_g, ln1_b, w_up, conv_w, conv_b, w_down, ln2_g, ln2_b):
    for _ in range(DEPTH):
        mod = c @ w_ada + b_ada
        sh1, sc1, gt1, sh2, sc2, gt2 = [m[:, None, :] for m in jnp.split(mod, N_MOD, axis=-1)]

        u = x * (1.0 + sc1) + sh1
        proj = u @ w_in
        q_a, k_a, v_a, f_a, q_b, k_b, v_b, g_a, g_b = jnp.split(proj, _split_points(), axis=-1)

        log_f = jax.nn.log_sigmoid((f_a + b_forget).astype(jnp.float32)).transpose(0, 2, 1)
        y_fox = _merge_heads(_forgetting_attention(
            _to_heads(q_a, N_FOX_HEADS), _to_heads(k_a, N_FOX_HEADS), _to_heads(v_a, N_FOX_HEADS), log_f))
        y_sb = _merge_heads(_stick_breaking_attention(
            _to_heads(q_b, N_SB_HEADS), _to_heads(k_b, N_SB_HEADS), _to_heads(v_b, N_SB_HEADS)))

        merged = jax.nn.sigmoid(g_a) * (y_fox @ w_fox_proj) + jax.nn.sigmoid(g_b) * (y_sb @ w_sb_proj)
        attn_out = merged @ w_o
        x = _layer_norm(DEEPNORM_ALPHA * x + (1.0 + gt1) * attn_out, ln1_g, ln1_b)

        u2 = x * (1.0 + sc2) + sh2
        h = _causal_depthwise_conv(u2 @ w_up, conv_w, conv_b)
        h_gate, h_val = jnp.split(h, 2, axis=-1)
        ffn_out = (jax.nn.silu(h_gate) * h_val) @ w_down
        x = _layer_norm(DEEPNORM_ALPHA * x + (1.0 + gt2) * ffn_out, ln2_g, ln2_b)
    return x
```

```cpp
#include <hip/hip_runtime.h>
#include <hip/hip_cooperative_groups.h>
#include <cstdio>
#include <cstdint>
constexpr int MTOK = 65536;
constexpr float DN_ALPHA = 1.189207115002721f;
namespace pg8 {
#define PG8_LAS __attribute__((address_space(3)))
typedef unsigned short bf16_t;
typedef short bf16x8 __attribute__((ext_vector_type(8)));
typedef float f32x4 __attribute__((ext_vector_type(4)));
typedef unsigned u32x4 __attribute__((ext_vector_type(4)));
constexpr int BM = 256, BK = 64, HALF = 128, HTB = HALF * BK * 2  , STAGE_BYTES = 8 * HTB, NXCD = 8, WGM = 8;

__host__ __device__ __forceinline__ int lds_byte(int r, int c) { const int st = (r >> 4) * 2 + (c >> 5), rr = r & 15, cc = c & 31, ob = rr * 64 + cc * 2; return st * 1024 + (ob ^ (((ob >> 9) & 1) << 5)); }
__host__ __device__ __forceinline__ void stage_rc(int b, int& R, int& C) { const int st = b / 1024, sb = b % 1024, swz = sb ^ (((sb >> 9) & 1) << 5); R = (st >> 1) * 16 + swz / 64; C = (st & 1) * 32 + (swz % 64) / 2; }
__host__ __device__ __forceinline__ int perm32(int rho) { const int n = rho >> 4, i = rho & 15; return 8 * (i >> 2) + 4 * n + (i & 3); }

struct Unit { int pm, pn; };
struct Gemm { const bf16_t* A; const bf16_t* Bt; int M, N, K; size_t a_tstep; };

struct StaticOrder {
    int nM, nN, nwg, G, c;
    __host__ __device__ void init(int M, int N, int G_, int c_) { nM = M / BM; nN = N / BM; nwg = nM * nN; G = G_; c = c_; }
    __host__ __device__ void init_tiles(int nM_, int nN_, int G_, int c_) { nM = nM_; nN = nN_; nwg = nM * nN; G = G_; c = c_; }
    __host__ __device__ bool next(int i, Unit& u) const {
        const long L = (long)i * G + c; if (L >= nwg) return false;
        int wgid = (int)L; { const int q = nwg / NXCD, r = nwg % NXCD, xcd = wgid % NXCD, off = wgid / NXCD; wgid = (xcd < r ? xcd * (q + 1) : r * (q + 1) + (xcd - r) * q) + off; }
        const int nig = WGM * nN, gid = wgid / nig, fm = gid * WGM, gsz = (nM - fm) < WGM ? (nM - fm) : WGM;
        u.pm = fm + ((wgid % nig) % gsz); u.pn = (wgid % nig) / gsz; return true;
    }
    __device__ __forceinline__ void a_ready(const Unit&) const {}
    __device__ __forceinline__ void done(const Unit&) const {}
};

__device__ __forceinline__ unsigned cvt_pk_bf16(float lo, float hi) { unsigned r; asm volatile("v_cvt_pk_bf16_f32 %0, %1, %2" : "=v"(r) : "v"(lo), "v"(hi)); return r; }
typedef float f32x2 __attribute__((ext_vector_type(2)));
constexpr float C2f = 0.125f * 1.4426950408889634f;
constexpr float LOG2E = 1.4426950408889634f;
__device__ __forceinline__ float sigm(float v) { return __builtin_amdgcn_rcpf(1.0f + __builtin_amdgcn_exp2f(-LOG2E * v)); }
__device__ __forceinline__ float bflo(unsigned w) { return __builtin_bit_cast(float, w << 16); }
__device__ __forceinline__ float bfhi(unsigned w) { return __builtin_bit_cast(float, w & 0xffff0000u); }

struct EpiInProj {
    static constexpr bool PERM = true, AFTER_DRAIN = false;
    bf16_t* qkv; bf16_t* gates;
    __device__ __forceinline__ void operator()(const f32x4 (&acc)[2][2][4][2], const Unit& u, int wr, int wc, int fr, int fq) const {
        const int pn = u.pn; bf16_t* base; int ldc, colt; float sc = 1.f; bool sg = false;
        if (pn < 12) { const int t = pn >> 1, slot = (0x541320 >> (4 * t)) & 7; base = qkv + (size_t)slot * ((size_t)MTOK * 512); ldc = 512; colt = (pn & 1) * 256; if (t == 0 || t == 3) sc = C2f; }
        else { const int t = (pn - 12) >> 2; base = gates + (size_t)t * ((size_t)MTOK * 1024); ldc = 1024; colt = ((pn - 12) & 3) * 256; sg = true; }
        const int row0 = u.pm * BM + wr * 64 + fr, col0 = colt + wc * 32 + 8 * fq;
#pragma unroll
        for (int ai = 0; ai < 2; ++ai)
#pragma unroll
            for (int m = 0; m < 4; ++m) { bf16_t* rowp = base + (size_t)(row0 + ai * HALF + m * 16) * ldc + col0;
#pragma unroll
                for (int bj = 0; bj < 2; ++bj) { f32x4 v0 = acc[ai][bj][m][0], v1 = acc[ai][bj][m][1];
                    if (sg) { v0 = (f32x4){sigm(v0[0]), sigm(v0[1]), sigm(v0[2]), sigm(v0[3])}; v1 = (f32x4){sigm(v1[0]), sigm(v1[1]), sigm(v1[2]), sigm(v1[3])}; }
                    else { v0 = v0 * sc; v1 = v1 * sc; }
                    u32x4 w; w.x = cvt_pk_bf16(v0[0], v0[1]); w.y = cvt_pk_bf16(v0[2], v0[3]); w.z = cvt_pk_bf16(v1[0], v1[1]); w.w = cvt_pk_bf16(v1[2], v1[3]);
                    *(u32x4*)(rowp + bj * HALF) = w; } }
    }
};

struct EpiMerge {
    static constexpr bool PERM = true, AFTER_DRAIN = false;
    const bf16_t* gates; float* park; bf16_t* merged;
    __device__ __forceinline__ void operator()(const f32x4 (&acc)[2][2][4][2], const Unit& u, int wr, int wc, int fr, int fq) const {
        const int grp = u.pn >> 2, pnn = u.pn & 3, pmm = u.pm & 255;
        const bf16_t* G = gates + (size_t)grp * ((size_t)MTOK * 1024);
        const int row0 = pmm * BM + wr * 64 + fr, col0 = pnn * BM + wc * 32 + 8 * fq;
#pragma unroll
        for (int ai = 0; ai < 2; ++ai)
#pragma unroll
            for (int m = 0; m < 4; ++m)
#pragma unroll
                for (int bj = 0; bj < 2; ++bj) { const size_t off = (size_t)(row0 + ai * HALF + m * 16) * 1024 + col0 + bj * HALF;
                    const u32x4 gw = *(const u32x4*)(G + off);
                    f32x4 v0 = acc[ai][bj][m][0] * (f32x4){bflo(gw.x), bfhi(gw.x), bflo(gw.y), bfhi(gw.y)};
                    f32x4 v1 = acc[ai][bj][m][1] * (f32x4){bflo(gw.z), bfhi(gw.z), bflo(gw.w), bfhi(gw.w)};
                    if (grp == 0) { *(f32x4*)(park + off) = v0; *(f32x4*)(park + off + 4) = v1; }
                    else { v0 = v0 + *(const f32x4*)(park + off); v1 = v1 + *(const f32x4*)(park + off + 4);
                        u32x4 w; w.x = cvt_pk_bf16(v0[0], v0[1]); w.y = cvt_pk_bf16(v0[2], v0[3]); w.z = cvt_pk_bf16(v1[0], v1[1]); w.w = cvt_pk_bf16(v1[2], v1[3]);
                        *(u32x4*)(merged + off) = w; } }
    }
};

struct EpiRes {
    static constexpr bool PERM = true, AFTER_DRAIN = false;
    const float* base; const float* gt; float* out;
    __device__ __forceinline__ void operator()(const f32x4 (&acc)[2][2][4][2], const Unit& u, int wr, int wc, int fr, int fq) const {
        const int row0 = u.pm * BM + wr * 64 + fr, col0 = u.pn * BM + wc * 32 + 8 * fq; const float* g = gt + (size_t)(u.pm >> 5) * 6144 + col0;
#pragma unroll
        for (int bj = 0; bj < 2; ++bj)
#pragma unroll
            for (int n = 0; n < 2; ++n) { const f32x4 gv = *(const f32x4*)(g + bj * HALF + 4 * n) + 1.0f;
#pragma unroll
                for (int ai = 0; ai < 2; ++ai)
#pragma unroll
                    for (int m = 0; m < 4; ++m) { const size_t off = (size_t)(row0 + ai * HALF + m * 16) * 1024 + col0 + bj * HALF + 4 * n;
                        *(f32x4*)(out + off) = *(const f32x4*)(base + off) * DN_ALPHA + gv * acc[ai][bj][m][n]; } }
    }
};

struct EpiUpConv {
    static constexpr bool PERM = true, AFTER_DRAIN = false;
    const float* cw; const float* cb; bf16_t* act; PG8_LAS f32x4* xch;
    __device__ __forceinline__ f32x4 conv1(const f32x4 cur, const f32x4 prv, const f32x4 w0, const f32x4 w1, const f32x4 w2, const f32x4 bb, int fr, int s1, int s2, int tseq) const {
        const f32x4 a1 = (fr >= 15) ? prv : cur, a2 = (fr >= 14) ? prv : cur;
        f32x4 p1, p2;
#pragma unroll
        for (int j = 0; j < 4; ++j) { p1[j] = __shfl(a1[j], s1); p2[j] = __shfl(a2[j], s2); }
        if (tseq < 1) p1 = (f32x4){0.f, 0.f, 0.f, 0.f};
        if (tseq < 2) p2 = (f32x4){0.f, 0.f, 0.f, 0.f};
        return bb + w0 * p2 + w1 * p1 + w2 * cur;
    }
    __device__ __forceinline__ void operator()(const f32x4 (&acc)[2][2][4][2], const Unit& u, int wr, int wc, int, int) const {
        int t_ = threadIdx.x; asm volatile("" : "+v"(t_));
        const int fr = t_ & 15, fq = (t_ >> 4) & 3, lane = t_ & 63;
        const int R0 = 254 * u.pm - 2, ch0 = 128 * u.pn + 32 * wc + 8 * fq;
        const int xi = fq * 2 + (fr - 14);
        if (fr >= 14) {
#pragma unroll
            for (int ai = 0; ai < 2; ++ai)
#pragma unroll
                for (int bj = 0; bj < 2; ++bj)
#pragma unroll
                    for (int n = 0; n < 2; ++n) xch[(((((ai * 2 + wr) * 4 + wc) * 2 + bj) * 2 + n) * 8) + xi] = acc[ai][bj][3][n];
        }
        asm volatile("s_waitcnt lgkmcnt(0)\n\ts_barrier" ::: "memory");
        const int s1 = (lane & 48) | ((fr - 1) & 15), s2 = (lane & 48) | ((fr - 2) & 15);
#pragma unroll
        for (int ai = 0; ai < 2; ++ai)
#pragma unroll
            for (int n = 0; n < 2; ++n) {
                asm volatile("" ::: "memory");
                const bool hasup = (fr >= 14) && ((ai * 2 + wr) >= 1);
                const int upi = (((((ai * 2 + wr - 1) * 4 + wc) * 2 + 0) * 2 + n) * 8) + xi;
                f32x4 cg[4];
                {   int cbase = ch0 + 4 * n; asm volatile("" : "+v"(cbase));
                    const f32x4 w0 = *(const f32x4*)(cw + cbase), w1 = *(const f32x4*)(cw + 5632 + cbase), w2 = *(const f32x4*)(cw + 2 * 5632 + cbase), bb = *(const f32x4*)(cb + cbase);
                    f32x4 up = (f32x4){0.f, 0.f, 0.f, 0.f}; if (hasup) up = xch[upi];
#pragma unroll
                    for (int m = 0; m < 4; ++m) cg[m] = conv1(acc[ai][0][m][n], (m == 0) ? up : acc[ai][0][m > 0 ? m - 1 : 0][n], w0, w1, w2, bb, fr, s1, s2, (R0 + 128 * ai + 64 * wr + 16 * m + fr) & 8191);
                }
                {   int cbase = 2816 + ch0 + 4 * n; asm volatile("" : "+v"(cbase));
                    const f32x4 w0 = *(const f32x4*)(cw + cbase), w1 = *(const f32x4*)(cw + 5632 + cbase), w2 = *(const f32x4*)(cw + 2 * 5632 + cbase), bb = *(const f32x4*)(cb + cbase);
                    f32x4 up = (f32x4){0.f, 0.f, 0.f, 0.f}; if (hasup) up = xch[upi + 16];
#pragma unroll
                    for (int m = 0; m < 4; ++m) {
                        const int rr = 128 * ai + 64 * wr + 16 * m + fr, grow = R0 + rr;
                        const f32x4 vl = conv1(acc[ai][1][m][n], (m == 0) ? up : acc[ai][1][m > 0 ? m - 1 : 0][n], w0, w1, w2, bb, fr, s1, s2, grow & 8191);
                        const f32x4 gt = cg[m];
                        const float o0 = gt[0] * sigm(gt[0]) * vl[0], o1 = gt[1] * sigm(gt[1]) * vl[1], o2 = gt[2] * sigm(gt[2]) * vl[2], o3 = gt[3] * sigm(gt[3]) * vl[3];
                        if (rr >= 2 && grow < MTOK) { typedef unsigned u32x2 __attribute__((ext_vector_type(2))); u32x2 w; w.x = cvt_pk_bf16(o0, o1); w.y = cvt_pk_bf16(o2, o3);
                            *(u32x2*)(act + (size_t)grow * 2816 + ch0 + 4 * n) = w; }
                    }
                }
            }
    }
};
template <class Epi, class Sched, bool ALIGN_EPI = false, bool SP2 = false>
__device__ __forceinline__ void gemm_phase(PG8_LAS unsigned char* lds, const Gemm g, const Sched& S, const Epi& E) {
    int tid_ = threadIdx.x; asm volatile("" : "+v"(tid_));
    const int tid = tid_, wid = __builtin_amdgcn_readfirstlane(tid >> 6), lane = tid & 63, wr = wid >> 2, wc = wid & 3, fr = lane & 15, fq = lane >> 4;
    const int K = g.K, nt = K / BK;
    unsigned voffA[2], voffB[2];
#pragma unroll
    for (int i = 0; i < 2; ++i) { int R, C; stage_rc(tid * 16 + i * 8192, R, C); const int Rb = Epi::PERM ? ((R & ~31) + perm32(R & 31)) : R;
        voffA[i] = (unsigned)(R * K + C) * 2u; voffB[i] = (unsigned)(Rb * K + C) * 2u; }
    const size_t kstep = (size_t)(BK * 2);
    const size_t hstep = (size_t)HALF * K * 2;
    const size_t tstep = 2 * hstep;
    const unsigned ldsw = (unsigned)wid * 1024u;
    const int aoff = lds_byte(wr * 64 + fr, fq * 8), boff = lds_byte(wc * 32 + fr, fq * 8);
#define PG8_SA(b, h) (((b) * 2 + (h)) * HTB)
#define PG8_SB(b, h) ((4 + (b) * 2 + (h)) * HTB)
#define PG8_STAGE(bufoff, gbase, voff) do { _Pragma("unroll") for (int _i = 0; _i < 2; ++_i) \
        __builtin_amdgcn_global_load_lds((const unsigned*)((const char*)(gbase) + (voff)[_i]), (PG8_LAS unsigned*)(lds + (bufoff) + ldsw + _i * 8192), 16, 0, 0); } while (0)
#define PG8_LDA(dst, b, h) do { _Pragma("unroll") for (int m = 0; m < 4; ++m) _Pragma("unroll") for (int k = 0; k < 2; ++k) dst[m][k] = *(const PG8_LAS bf16x8*)(lds + PG8_SA(b, h) + aoff + m * 2048 + k * 1024); } while (0)
#define PG8_LDB(dst, b, h) do { _Pragma("unroll") for (int n = 0; n < 2; ++n) _Pragma("unroll") for (int k = 0; k < 2; ++k) dst[n][k] = *(const PG8_LAS bf16x8*)(lds + PG8_SB(b, h) + boff + n * 2048 + k * 1024); } while (0)
#define PG8_MMA(ai, bj, At, Bt) do { __builtin_amdgcn_s_setprio(1); _Pragma("unroll") for (int m = 0; m < 4; ++m) _Pragma("unroll") for (int n = 0; n < 2; ++n) _Pragma("unroll") for (int k = 0; k < 2; ++k) \
        acc[ai][bj][m][n] = __builtin_amdgcn_mfma_f32_16x16x32_bf16(Bt[n][k], At[m][k], acc[ai][bj][m][n], 0, 0, 0); __builtin_amdgcn_s_setprio(0); } while (0)
#define PG8_WAIT_V(n) asm volatile("s_waitcnt vmcnt(" #n ")" ::: "memory")
#define PG8_WAIT_L(n) asm volatile("s_waitcnt lgkmcnt(" #n ")" ::: "memory")
#define PG8_BAR __builtin_amdgcn_s_barrier()
#define PG8_SCHED __builtin_amdgcn_sched_barrier(0)
    Unit cur, nxt; int ui = 0;
    if (!S.next(0, cur)) return;
    f32x4 acc[2][2][4][2];
#pragma unroll
    for (int a = 0; a < 2; ++a)
#pragma unroll
        for (int b = 0; b < 2; ++b)
#pragma unroll
            for (int m = 0; m < 4; ++m)
#pragma unroll
                for (int n = 0; n < 2; ++n) acc[a][b][m][n] = (f32x4){0.f, 0.f, 0.f, 0.f};
    bf16x8 At[4][2], B0[2][2], B1[2][2];
    const char* cA = (const char*)g.A + (size_t)cur.pm * g.a_tstep; const char* cB = (const char*)g.Bt + (size_t)cur.pn * tstep;
    S.a_ready(cur);
    if constexpr (SP2) {
        PG8_STAGE(PG8_SB(0, 0), cB, voffB); PG8_STAGE(PG8_SB(0, 1), cB + hstep, voffB); PG8_STAGE(PG8_SA(0, 0), cA, voffA); PG8_STAGE(PG8_SA(0, 1), cA + hstep, voffA);
        if (wr == 1) PG8_BAR;
        PG8_WAIT_V(2); PG8_BAR;
        PG8_STAGE(PG8_SB(1, 0), cB + kstep, voffB); PG8_STAGE(PG8_SA(1, 0), cA + kstep, voffA); PG8_STAGE(PG8_SB(1, 1), cB + hstep + kstep, voffB);
        PG8_WAIT_V(6); PG8_BAR;
    } else {
        PG8_STAGE(PG8_SB(0, 0), cB, voffB); PG8_STAGE(PG8_SA(0, 0), cA, voffA); PG8_STAGE(PG8_SB(0, 1), cB + hstep, voffB); PG8_STAGE(PG8_SA(0, 1), cA + hstep, voffA);
        if (wr == 1) PG8_BAR;
        PG8_WAIT_V(4); PG8_BAR;
        PG8_STAGE(PG8_SB(1, 0), cB + kstep, voffB); PG8_STAGE(PG8_SA(1, 0), cA + kstep, voffA); PG8_STAGE(PG8_SB(1, 1), cB + hstep + kstep, voffB);
        PG8_WAIT_V(6); PG8_BAR;
    }
    for (;;) {
        const bool has_next = S.next(ui + 1, nxt);
        const char* nA = has_next ? (const char*)g.A + (size_t)nxt.pm * g.a_tstep : cA; const char* nB = has_next ? (const char*)g.Bt + (size_t)nxt.pn * tstep : cB;
        for (int t = 0; t < nt; t += 2) {
            const bool last = (t == nt - 2);
            const char* a1 = cA + (size_t)(t + 1) * kstep;
            const char* a2 = last ? nA : cA + (size_t)(t + 2) * kstep; const char* b2 = last ? nB : cB + (size_t)(t + 2) * kstep;
            const char* a3 = a2 + kstep; const char* b3 = b2 + kstep;
            if (last && has_next) S.a_ready(nxt);
            if constexpr (SP2) {
            PG8_LDB(B0, 0, 0); PG8_LDB(B1, 0, 1); PG8_SCHED; PG8_LDA(At, 0, 0); PG8_STAGE(PG8_SA(1, 1), a1 + hstep, voffA);
            PG8_WAIT_V(8); PG8_WAIT_L(0); PG8_BAR; PG8_MMA(0, 0, At, B0); PG8_MMA(0, 1, At, B1); PG8_BAR; PG8_SCHED;
            PG8_LDA(At, 0, 1); PG8_STAGE(PG8_SB(0, 0), b2, voffB); PG8_STAGE(PG8_SB(0, 1), b2 + hstep, voffB); PG8_STAGE(PG8_SA(0, 0), a2, voffA);
            PG8_WAIT_V(8); PG8_WAIT_L(0); PG8_BAR; PG8_MMA(1, 0, At, B0); PG8_MMA(1, 1, At, B1); PG8_BAR; PG8_SCHED;
            PG8_LDB(B0, 1, 0); PG8_LDB(B1, 1, 1); PG8_SCHED; PG8_LDA(At, 1, 0); PG8_STAGE(PG8_SA(0, 1), a2 + hstep, voffA);
            PG8_WAIT_V(8); PG8_WAIT_L(0); PG8_BAR; PG8_MMA(0, 0, At, B0); PG8_MMA(0, 1, At, B1); PG8_BAR; PG8_SCHED;
            PG8_LDA(At, 1, 1); PG8_STAGE(PG8_SB(1, 0), b3, voffB); PG8_STAGE(PG8_SB(1, 1), b3 + hstep, voffB); PG8_STAGE(PG8_SA(1, 0), a3, voffA);
            PG8_WAIT_V(8); PG8_WAIT_L(0); PG8_BAR; PG8_MMA(1, 0, At, B0); PG8_MMA(1, 1, At, B1); PG8_BAR; PG8_SCHED;
            } else {
            PG8_LDB(B0, 0, 0); PG8_SCHED; PG8_LDA(At, 0, 0); PG8_STAGE(PG8_SA(1, 1), a1 + hstep, voffA);
            PG8_WAIT_L(8); PG8_BAR; PG8_WAIT_L(0); PG8_MMA(0, 0, At, B0); PG8_BAR; PG8_SCHED;
            PG8_LDB(B1, 0, 1); PG8_STAGE(PG8_SB(0, 0), b2, voffB);
            PG8_BAR; PG8_WAIT_L(0); PG8_MMA(0, 1, At, B1); PG8_BAR;
            PG8_LDA(At, 0, 1); PG8_STAGE(PG8_SA(0, 0), a2, voffA);
            PG8_BAR; PG8_WAIT_L(0); PG8_MMA(1, 0, At, B0); PG8_BAR; PG8_SCHED;
            PG8_STAGE(PG8_SB(0, 1), b2 + hstep, voffB);
            PG8_WAIT_V(6); PG8_BAR; PG8_MMA(1, 1, At, B1); PG8_BAR;
            PG8_LDB(B0, 1, 0); PG8_SCHED; PG8_LDA(At, 1, 0); PG8_STAGE(PG8_SA(0, 1), a2 + hstep, voffA);
            PG8_WAIT_L(8); PG8_BAR; PG8_WAIT_L(0); PG8_MMA(0, 0, At, B0); PG8_BAR; PG8_SCHED;
            PG8_LDB(B1, 1, 1); PG8_STAGE(PG8_SB(1, 0), b3, voffB);
            PG8_BAR; PG8_WAIT_L(0); PG8_MMA(0, 1, At, B1); PG8_BAR;
            PG8_LDA(At, 1, 1); PG8_STAGE(PG8_SA(1, 0), a3, voffA);
            PG8_BAR; PG8_WAIT_L(0); PG8_MMA(1, 0, At, B0); PG8_BAR; PG8_SCHED;
            PG8_STAGE(PG8_SB(1, 1), b3 + hstep, voffB);
            PG8_WAIT_V(6); PG8_BAR; PG8_MMA(1, 1, At, B1); PG8_BAR;
            }
        }
        if constexpr (ALIGN_EPI) { if (wr == 0) PG8_BAR; }
        if constexpr (!Epi::AFTER_DRAIN) { E(acc, cur, wr, wc, fr, fq); S.done(cur); }
        if (!has_next) break;
#pragma unroll
        for (int a = 0; a < 2; ++a)
#pragma unroll
            for (int b = 0; b < 2; ++b)
#pragma unroll
                for (int m = 0; m < 4; ++m)
#pragma unroll
                    for (int n = 0; n < 2; ++n) acc[a][b][m][n] = (f32x4){0.f, 0.f, 0.f, 0.f};
        cur = nxt; cA = nA; cB = nB; ++ui;
        if constexpr (ALIGN_EPI) { if (wr == 1) PG8_BAR; }
    }
    PG8_WAIT_V(0);
    if constexpr (!ALIGN_EPI) { if (wr == 0) PG8_BAR; }
    PG8_BAR;
    if constexpr (Epi::AFTER_DRAIN) { E.fused(acc, cur, wr, wc, fr, fq, lds, wid, lane); S.done(cur); }
#undef PG8_SA
#undef PG8_SB
#undef PG8_STAGE
#undef PG8_LDA
#undef PG8_LDB
#undef PG8_MMA
#undef PG8_WAIT_V
#undef PG8_WAIT_L
#undef PG8_BAR
#undef PG8_SCHED
}
}
#include <hip/hip_bf16.h>
#include <cmath>
namespace attn_body {
using bf16=__hip_bfloat16;
using bf16x8=__attribute__((ext_vector_type(8)))short;
using s16x4=__attribute__((ext_vector_type(4)))short;
using f32x16=__attribute__((ext_vector_type(16)))float;
using u32x4=__attribute__((ext_vector_type(4)))unsigned;
constexpr int BATCH=8,NHEAD=8,SEQ=8192,D=64,DM=NHEAD*D;
constexpr int NW=8,QBLK=32,QB=QBLK*NW,KVBLK=64,NQB=SEQ/QB;
constexpr int ATTN_PITCH=DM, ATTN_UNIT_ROWS=QB;
__device__ __forceinline__ int crow(int r,int hi){return (r&3)+8*(r>>2)+4*hi;}
#define SBAR() __builtin_amdgcn_sched_barrier(0)
__device__ __forceinline__ void cmask(f32x16&p0,f32x16&p1,int jb,int qrel,int hi){
  const float NEG=-INFINITY; int kb=64*jb+4*hi;
  #pragma unroll
  for(int r=0;r<16;++r){int kv=kb+(r&3)+8*(r>>2); if(kv>qrel)p0[r]=NEG; if(kv+32>qrel)p1[r]=NEG;}
}

constexpr int NSLOT=3, SLOTB=8192;
constexpr int LDS_K=0, LDS_V=NSLOT*SLOTB, LDS_WS=2*NSLOT*SLOTB, LDS_OST=LDS_WS+NW*64*4, LDS_CK=LDS_OST+NW*4096, LDS_BYTES=LDS_CK+SEQ*4;
constexpr float C2=0.125f*1.4426950408889634f;
__device__ __forceinline__ void glds16(const void*gsrc,unsigned lds_dst){unsigned keep;
  asm volatile("s_mov_b32 %0, m0\n\ts_mov_b32 m0, %2\n\ts_nop 0\n\tglobal_load_lds_dwordx4 %1, off\n\ts_mov_b32 m0, %0":"=&s"(keep):"v"(gsrc),"s"(lds_dst):"memory");}
__device__ __forceinline__ float max3f(float a,float b,float c){float r;asm("v_max3_f32 %0, %1, %2, %3":"=v"(r):"v"(a),"v"(b),"v"(c));return r;}
__device__ __forceinline__ float max2f(float a,float b){float r;asm("v_max_f32_e32 %0, %1, %2":"=v"(r):"v"(a),"v"(b));return r;}
__device__ __forceinline__ float fadd_s(float a,float b){float r;asm("v_add_f32_e32 %0, %1, %2":"=v"(r):"v"(a),"v"(b));return r;}
__device__ __forceinline__ float fsub_s(float a,float b){float r;asm("v_sub_f32_e32 %0, %1, %2":"=v"(r):"v"(a),"v"(b));return r;}
typedef float f32x2_t __attribute__((ext_vector_type(2))); typedef __bf16 bf16x2_t __attribute__((ext_vector_type(2)));
__device__ __forceinline__ unsigned cvtpk_s(float lo,float hi){f32x2_t v={lo,hi};bf16x2_t b=__builtin_convertvector(v,bf16x2_t);return __builtin_bit_cast(unsigned,b);}
#define WAIT_BAR(N) asm volatile("s_waitcnt vmcnt(" #N ") lgkmcnt(0)\n\ts_barrier":::"memory")

__device__ __forceinline__ void qkt(f32x16&p0,f32x16&p1,const char*Kslot,const bf16x8*qr,int r32,int hi){
  const char*kb=Kslot+hi*1024+r32*16;
  #pragma unroll
  for(int d0=0;d0<4;++d0){
    const bf16x8 b0=*reinterpret_cast<const bf16x8*>(kb+d0*2048);
    const bf16x8 b1=*reinterpret_cast<const bf16x8*>(kb+d0*2048+512);
    {p0=__builtin_amdgcn_mfma_f32_32x32x16_bf16(b0,qr[d0],p0,0,0,0);p1=__builtin_amdgcn_mfma_f32_32x32x16_bf16(b1,qr[d0],p1,0,0,0);}}
}
typedef __attribute__((address_space(3))) const char* lds_cptr;
typedef short v4i16_t __attribute__((ext_vector_type(4)));
__device__ __forceinline__ void kload8(bf16x8*kf,lds_cptr kp){
  kf[0]=*(const __attribute__((address_space(3))) bf16x8*)(kp);      kf[1]=*(const __attribute__((address_space(3))) bf16x8*)(kp+512);
  kf[2]=*(const __attribute__((address_space(3))) bf16x8*)(kp+2048); kf[3]=*(const __attribute__((address_space(3))) bf16x8*)(kp+2560);
  kf[4]=*(const __attribute__((address_space(3))) bf16x8*)(kp+4096); kf[5]=*(const __attribute__((address_space(3))) bf16x8*)(kp+4608);
  kf[6]=*(const __attribute__((address_space(3))) bf16x8*)(kp+6144); kf[7]=*(const __attribute__((address_space(3))) bf16x8*)(kp+6656);
}
__device__ __forceinline__ void kload2(bf16x8*kf,lds_cptr kp,int j){ kf[2*j]=*(const __attribute__((address_space(3))) bf16x8*)(kp+j*2048); kf[2*j+1]=*(const __attribute__((address_space(3))) bf16x8*)(kp+j*2048+512); }
__device__ __forceinline__ s16x4 vtr(lds_cptr p){ return __builtin_bit_cast(s16x4,__builtin_amdgcn_ds_read_tr16_b64_v4i16((__attribute__((address_space(3))) v4i16_t*)p)); }
__device__ __forceinline__ float rowmax(const f32x16&p0,const f32x16&p1){
  float a=max3f(p0[0],p0[1],p1[0]),b=max3f(p0[2],p0[3],p1[1]);a=max3f(a,p1[2],p1[3]);
  #pragma unroll
  for(int r=4;r<16;r+=4){a=max3f(a,p0[r],p0[r+1]);b=max3f(b,p0[r+2],p0[r+3]);a=max3f(a,p1[r],p1[r+1]);b=max3f(b,p1[r+2],p1[r+3]);}
  const float m=max2f(a,b);
  auto rr=__builtin_amdgcn_permlane32_swap(__float_as_uint(m),__float_as_uint(m),false,false);
  return max2f(__uint_as_float(rr[0]),__uint_as_float(rr[1]));
}
__device__ __forceinline__ void pv(f32x16*o,int vb,bf16x8 pa0,bf16x8 pa1,bf16x8 pa2,bf16x8 pa3){
  #pragma unroll
  for(int d0=0;d0<2;++d0){s16x4 lo[4],hi[4];
    #pragma unroll
    for(int ks=0;ks<4;++ks){
      asm volatile("ds_read_b64_tr_b16 %0,%1 offset:%c2":"=&v"(lo[ks]):"v"(vb),"i"(d0*4096+ks*1024):"memory");
      asm volatile("ds_read_b64_tr_b16 %0,%1 offset:%c2":"=&v"(hi[ks]):"v"(vb),"i"(d0*4096+ks*1024+512):"memory");}
    asm volatile("s_waitcnt lgkmcnt(0)":::"memory");SBAR();
    #define PK(k) (bf16x8){lo[k][0],lo[k][1],lo[k][2],lo[k][3],hi[k][0],hi[k][1],hi[k][2],hi[k][3]}
    o[d0]=__builtin_amdgcn_mfma_f32_32x32x16_bf16(pa0,PK(0),o[d0],0,0,0);
    o[d0]=__builtin_amdgcn_mfma_f32_32x32x16_bf16(pa1,PK(1),o[d0],0,0,0);
    o[d0]=__builtin_amdgcn_mfma_f32_32x32x16_bf16(pa2,PK(2),o[d0],0,0,0);
    o[d0]=__builtin_amdgcn_mfma_f32_32x32x16_bf16(pa3,PK(3),o[d0],0,0,0);
    #undef PK
  }
}

typedef __attribute__((address_space(3))) const float* lds_fptr;
typedef float f32x4_t __attribute__((ext_vector_type(4)));
__device__ __forceinline__ void biasinit(f32x16&c0,f32x16&c1,lds_fptr ckt,float aq){
  #pragma unroll
  for(int g=0;g<4;++g){ const f32x4_t v=*(const __attribute__((address_space(3))) f32x4_t*)(ckt+8*g); const f32x4_t w=*(const __attribute__((address_space(3))) f32x4_t*)(ckt+32+8*g);
    c0[4*g]=aq-v[0];c0[4*g+1]=aq-v[1];c0[4*g+2]=aq-v[2];c0[4*g+3]=aq-v[3]; c1[4*g]=aq-w[0];c1[4*g+1]=aq-w[1];c1[4*g+2]=aq-w[2];c1[4*g+3]=aq-w[3]; }
}
#ifndef ATTN_STORE16
#define ATTN_STORE16(p,v) (*(u32x4*)(p)=(v))
#endif
template<int THRL> __device__ __forceinline__ void attn_unit(int b,int h,int qb,const bf16*Q,const bf16*__restrict__ K,const bf16*__restrict__ V,bf16*O,char*shm,const float*__restrict__ CKg){
  int tid_=threadIdx.x; asm volatile("":"+v"(tid_)); const int tid=tid_,lane=tid&63,r32=lane&31,hi=lane>>5; const int wid=__builtin_amdgcn_readfirstlane(tid>>6);
  const long rowbase=(long)b*SEQ; const int q0=qb*QB; const lds_cptr shm3=(lds_cptr)shm;
  const bf16*Qw=Q+(rowbase+q0+wid*QBLK)*DM+h*D;
  const bf16*Kh=K+rowbase*DM+h*D,*Vh=V+rowbase*DM+h*D;
  const unsigned lds0=(unsigned)(uintptr_t)shm;
  float*wsf=(float*)(shm+LDS_WS)+wid*64;
  const bf16*ksrc=Kh+(long)lane*DM+wid*8;
  const bf16*vsrc=Vh+(long)(16*(wid&3)+(lane>>2))*DM+(wid>>2)*32+(lane&3)*8;
  const unsigned kdst=lds0+LDS_K+wid*1024, vdst=lds0+LDS_V+wid*1024;
  #define DMA_K(t,slot) glds16(ksrc+(long)(t)*KVBLK*DM,(unsigned)__builtin_amdgcn_readfirstlane(kdst+(slot)))
  #define DMA_V(t,slot) glds16(vsrc+(long)(t)*KVBLK*DM,(unsigned)__builtin_amdgcn_readfirstlane(vdst+(slot)))
  const int vb0=(int)(lds0+LDS_V)+((lane>>4)&1)*32+(lane&3)*8+(4*hi+((lane&15)>>2))*64;
  const char*Kbase=shm+LDS_K; bf16x8 kf[8];
  const lds_cptr kp0=shm3+LDS_K+hi*1024+r32*16; const lds_cptr vp0=shm3+LDS_V+((lane>>4)&1)*32+(lane&3)*8+(4*hi+((lane&15)>>2))*64;
  const int NT=(q0+QB)/KVBLK;
  { const float*ckh=CKg+(long)(b*NHEAD+h)*SEQ; __attribute__((address_space(3))) f32x4_t*ckd=(__attribute__((address_space(3))) f32x4_t*)((__attribute__((address_space(3))) char*)shm3+LDS_CK);
    for(int i=tid;i<(q0+QB)/4;i+=NW*64) ckd[i]=*(const f32x4_t*)(ckh+4*i);
    asm volatile("s_waitcnt vmcnt(0) lgkmcnt(0)\n\ts_barrier":::"memory"); }
  const lds_fptr ckl=(lds_fptr)(shm3+LDS_CK);
  const float cq=ckl[q0+wid*QBLK+r32]; float aq=cq;
  DMA_K(0,0);DMA_V(0,0);DMA_K(1,SLOTB);
  bf16x8 qr[4];
  #pragma unroll
  for(int d0=0;d0<4;++d0)qr[d0]=*reinterpret_cast<const bf16x8*>(&Qw[(long)r32*DM+d0*16+hi*8]);
  float mhat=0.f,l_reg=0.f;f32x16 o[2];o[0]=f32x16{};o[1]=f32x16{};
  const int qrel=wid*QBLK+r32;
  #define CMASK(P0,P1,t) do{int jb_=(t)-(NT-4); if(jb_>=0)cmask(P0,P1,jb_,qrel,hi);}while(0)
  bool resc=false;
  #define START(P0,P1) do{ const float rm=rowmax(P0,P1); resc=false; \
    { const float dl=rm; mhat=fadd_s(mhat,dl); \
      _Pragma("unroll") for(int r=0;r<16;++r){P0[r]=fsub_s(P0[r],dl);P1[r]=fsub_s(P1[r],dl);} \
      aq=cq-mhat; } \
    _Pragma("unroll") for(int r=0;r<16;++r)P0[r]=__builtin_amdgcn_exp2f(P0[r]); }while(0)
  #define RESC() do{ if(resc){ asm volatile("s_waitcnt lgkmcnt(0)":::"memory"); \
      _Pragma("unroll") for(int d_=0;d_<2;++d_) _Pragma("unroll") for(int r=0;r<16;++r)o[d_][r]*=wsf[crow(r,hi)]; } }while(0)
  f32x16 pA0,pA1,pB0,pB1;
  int sl_prev=0,sl_cur=0,sl_next=SLOTB;
  #define ROT() do{sl_prev=sl_cur;sl_cur=sl_next;sl_next=(sl_next==(NSLOT-1)*SLOTB)?0:sl_next+SLOTB;}while(0)
  DMA_K(2,2*SLOTB);
  WAIT_BAR(3);
  biasinit(pA0,pA1,ckl+4*hi,aq); qkt(pA0,pA1,Kbase,qr,r32,hi);asm volatile("s_nop 15\n\ts_nop 7":"+v"(pA0),"+v"(pA1));CMASK(pA0,pA1,0);
  START(pA0,pA1);
  _Pragma("unroll") for(int r=0;r<16;++r)pA1[r]=__builtin_amdgcn_exp2f(pA1[r]);
  WAIT_BAR(0);
  DMA_K(3,0);DMA_V(1,SLOTB);
  ROT();
  kload8(kf,kp0+sl_cur);
  WAIT_BAR(2);
  s16x4 vlo[8],vhi[8]; u32x4 pw0,pw1,pw2,pw3;
  #define PKW(P,B) cvtpk_s(P[B],P[B+1])
  #define PAF(k) __builtin_bit_cast(bf16x8,pw##k)
  #define VFR(i) (bf16x8){vlo[i][0],vlo[i][1],vlo[i][2],vlo[i][3],vhi[i][0],vhi[i][1],vhi[i][2],vhi[i][3]}
  #define PIN(x) asm volatile("":"+v"(x))
  #define MX3(a,b,c) __builtin_fmaxf(__builtin_fmaxf((a),(b)),(c))
  #define GAPA(MF,A0,A1,A2,A3,W0,W1,PW) do{ MF; sacc+=A0; sacc+=A1; sacc+=A2; sacc+=A3; PIN(sacc); W0; W1; PIN(PW); SBAR(); }while(0)
  #define EX(v) __builtin_amdgcn_exp2f(v)
  #define GAPB(MF,X,B) do{ MF; X[B]=EX(X[B]); X[B+1]=EX(X[B+1]); X[B+2]=EX(X[B+2]); X[B+3]=EX(X[B+3]); PIN(X); SBAR(); }while(0)
  #define VRD(i) do{ vlo[i]=vtr(vp_+(((i)>>2)*4096+((i)&3)*1024)); vhi[i]=vtr(vp_+(((i)>>2)*4096+((i)&3)*1024+512)); }while(0)
  #define KRD(G,j) do{ if(G){ kload2(kf,kp0+sl_next,j); SBAR(); } }while(0)
  #define STEP(C0,C1,P0,P1,t,GK,GV,GL) do{ SBAR(); biasinit(C0,C1,ckl+64*(t)+4*hi,aq); SBAR(); \
    const lds_cptr vp_=vp0+sl_prev; \
    VRD(0); SBAR(); float sacc=(P0[0]+P0[1]); \
    GAPA(C0=__builtin_amdgcn_mfma_f32_32x32x16_bf16(kf[0],qr[0],C0,0,0,0), P0[2],P0[3],P0[4],P0[5],     pw0[0]=PKW(P0,0), pw0[1]=PKW(P0,2), pw0); \
    VRD(4); SBAR(); GAPA(C1=__builtin_amdgcn_mfma_f32_32x32x16_bf16(kf[1],qr[0],C1,0,0,0), P0[6],P0[7],P0[8],P0[9],     pw0[2]=PKW(P0,4), pw0[3]=PKW(P0,6), pw0); \
    VRD(1); SBAR(); GAPA(C0=__builtin_amdgcn_mfma_f32_32x32x16_bf16(kf[2],qr[1],C0,0,0,0),   P0[10],P0[11],P0[12],P0[13], pw1[0]=PKW(P0,8), pw1[1]=PKW(P0,10), pw1); \
    VRD(5); SBAR(); GAPA(C1=__builtin_amdgcn_mfma_f32_32x32x16_bf16(kf[3],qr[1],C1,0,0,0),   P0[14],P0[15],P1[0],P1[1],   pw1[2]=PKW(P0,12),pw1[3]=PKW(P0,14), pw1); \
    VRD(2); SBAR(); GAPA(C0=__builtin_amdgcn_mfma_f32_32x32x16_bf16(kf[4],qr[2],C0,0,0,0),   P1[2],P1[3],P1[4],P1[5],     pw2[0]=PKW(P1,0), pw2[1]=PKW(P1,2), pw2); \
    VRD(6); SBAR(); GAPA(C1=__builtin_amdgcn_mfma_f32_32x32x16_bf16(kf[5],qr[2],C1,0,0,0),   P1[6],P1[7],P1[8],P1[9],     pw2[2]=PKW(P1,4), pw2[3]=PKW(P1,6), pw2); \
    VRD(3); SBAR(); GAPA(C0=__builtin_amdgcn_mfma_f32_32x32x16_bf16(kf[6],qr[3],C0,0,0,0),   P1[10],P1[11],P1[12],P1[13], pw3[0]=PKW(P1,8), pw3[1]=PKW(P1,10), pw3); \
    VRD(7); SBAR(); GAPA(C1=__builtin_amdgcn_mfma_f32_32x32x16_bf16(kf[7],qr[3],C1,0,0,0),   P1[14],P1[15],0.f,0.f,       pw3[2]=PKW(P1,12),pw3[3]=PKW(P1,14), pw3); \
    l_reg+=sacc; \
    if(GK){DMA_K((t)+3,sl_cur);} if(GV){DMA_V((t)+1,sl_next);} \
    CMASK(C0,C1,t); \
    { float a=MX3(C0[0],C0[1],C1[0]),b=MX3(C0[2],C0[3],C1[1]); a=MX3(a,C1[2],C1[3]); \
      _Pragma("unroll") for(int r=4;r<16;r+=4){a=MX3(a,C0[r],C0[r+1]);b=MX3(b,C0[r+2],C0[r+3]);a=MX3(a,C1[r],C1[r+1]);b=MX3(b,C1[r+2],C1[r+3]);} \
      float rm=__builtin_fmaxf(a,b); { auto rr=__builtin_amdgcn_permlane32_swap(__float_as_uint(rm),__float_as_uint(rm),false,false); rm=__builtin_fmaxf(__uint_as_float(rr[0]),__uint_as_float(rr[1])); } \
      resc=false; \
      if(__builtin_expect(__any(rm>(float)THRL),0)){ const float dl=__builtin_fmaxf(rm,0.f); mhat+=dl; \
        _Pragma("unroll") for(int r=0;r<16;++r){C0[r]-=dl;C1[r]-=dl;} \
        aq=cq-mhat; \
        const float f=__builtin_amdgcn_exp2f(-dl); l_reg*=f; if(hi==0)wsf[r32]=f; resc=true; } } \
    SBAR(); \
    GAPB(o[0]=__builtin_amdgcn_mfma_f32_32x32x16_bf16(PAF(0),VFR(0),o[0],0,0,0), C0,0); \
    GAPB(o[1]=__builtin_amdgcn_mfma_f32_32x32x16_bf16(PAF(0),VFR(4),o[1],0,0,0), C0,4); \
    KRD(GL,0); GAPB(o[0]=__builtin_amdgcn_mfma_f32_32x32x16_bf16(PAF(1),VFR(1),o[0],0,0,0), C0,8); \
    KRD(GL,1); GAPB(o[1]=__builtin_amdgcn_mfma_f32_32x32x16_bf16(PAF(1),VFR(5),o[1],0,0,0), C0,12); \
    KRD(GL,2); GAPB(o[0]=__builtin_amdgcn_mfma_f32_32x32x16_bf16(PAF(2),VFR(2),o[0],0,0,0), C1,0); \
    KRD(GL,3); GAPB(o[1]=__builtin_amdgcn_mfma_f32_32x32x16_bf16(PAF(2),VFR(6),o[1],0,0,0), C1,4); \
    GAPB(o[0]=__builtin_amdgcn_mfma_f32_32x32x16_bf16(PAF(3),VFR(3),o[0],0,0,0), C1,8); \
    GAPB(o[1]=__builtin_amdgcn_mfma_f32_32x32x16_bf16(PAF(3),VFR(7),o[1],0,0,0), C1,12); \
    }while(0)
  int t=1;
  #undef CMASK
  #define CMASK(P0,P1,t) do{}while(0)
  for(;t+5<NT;t+=2){
    STEP(pB0,pB1,pA0,pA1,t,true,true,true);     WAIT_BAR(2); RESC(); ROT();
    STEP(pA0,pA1,pB0,pB1,t+1,true,true,true);   WAIT_BAR(2); RESC(); ROT();
  }
  #undef CMASK
  #define CMASK(P0,P1,t) do{int jb_=(t)-(NT-4); if(jb_>=0)cmask(P0,P1,jb_,qrel,hi);}while(0)
  #define ENDW(tt) do{ if((tt)+3<NT){WAIT_BAR(2);} else if((tt)+2<NT){WAIT_BAR(1);} else {WAIT_BAR(0);} }while(0)
  for(;t+1<NT;t+=2){
    STEP(pB0,pB1,pA0,pA1,t,(t+3<NT),(t+1<NT),(t+1<NT));       ENDW(t);   RESC(); ROT();
    STEP(pA0,pA1,pB0,pB1,t+1,(t+4<NT),(t+2<NT),(t+2<NT));     ENDW(t+1); RESC(); ROT();
  }
  STEP(pB0,pB1,pA0,pA1,NT-1,false,false,false); RESC();
  { float sacc=pB0[0]+pB0[1]; _Pragma("unroll") for(int r=2;r<16;++r)sacc+=pB0[r]; _Pragma("unroll") for(int r=0;r<16;++r)sacc+=pB1[r]; l_reg+=sacc;
    pw0=(u32x4){PKW(pB0,0),PKW(pB0,2),PKW(pB0,4),PKW(pB0,6)};pw1=(u32x4){PKW(pB0,8),PKW(pB0,10),PKW(pB0,12),PKW(pB0,14)};pw2=(u32x4){PKW(pB1,0),PKW(pB1,2),PKW(pB1,4),PKW(pB1,6)};pw3=(u32x4){PKW(pB1,8),PKW(pB1,10),PKW(pB1,12),PKW(pB1,14)};
    SBAR(); pv(o,vb0+sl_cur,PAF(0),PAF(1),PAF(2),PAF(3)); }
  #undef PKW
  #undef PAF
  #undef VFR
  #undef PIN
  #undef MX3
  #undef GAPA
  #undef GAPB
  #undef EX
  #undef VRD
  #undef KRD
  #undef STEP
  #undef ENDW
  {auto rr=__builtin_amdgcn_permlane32_swap(__float_as_uint(l_reg),__float_as_uint(l_reg),false,false);l_reg=__uint_as_float(rr[0])+__uint_as_float(rr[1]);}
  if(hi==0)wsf[32+r32]=l_reg;asm volatile("s_waitcnt lgkmcnt(0)":::"memory");
  float rli[16];
  #pragma unroll
  for(int r=0;r<16;++r)rli[r]=__builtin_amdgcn_rcpf(wsf[32+crow(r,hi)]);
  bf16*Ow=O+(rowbase+q0+wid*QBLK)*DM+h*D;
  { bf16*stg=(bf16*)(shm+LDS_OST)+wid*2048;
    #pragma unroll
    for(int r=0;r<16;++r){const int orow=crow(r,hi);
      #pragma unroll
      for(int d0=0;d0<2;++d0)stg[orow*64+d0*32+r32]=__float2bfloat16(o[d0][r]*rli[r]);}
    asm volatile("s_waitcnt lgkmcnt(0)":::"memory");
    #pragma unroll
    for(int i=0;i<4;++i){const int row=i*8+(lane>>3),ch=lane&7; const u32x4 v=*(const u32x4*)(stg+row*64+ch*8); ATTN_STORE16(Ow+(long)row*DM+ch*8,v);} }
  asm volatile("s_waitcnt lgkmcnt(0)\n\ts_barrier":::"memory");
  #undef DMA_K
  #undef DMA_V
  #undef CMASK
  #undef START
  #undef RESC
  #undef ROT
}
constexpr int ATTN_LDS_BYTES=LDS_BYTES;
struct AttnTensors { const bf16* Q; const bf16* K; const bf16* V; bf16* O; const float* CK; };
struct AttnUnit { int bh; int qb; };
struct StaticOrder {
  int vcu;
  __device__ __forceinline__ explicit StaticOrder(int grid,int block):vcu((block%8)*(grid/8)+block/8){}
  __device__ __forceinline__ bool next(int i,AttnUnit&u)const{ if(i>=8)return false; const int s=vcu&7,j=i&3; u.bh=(vcu>>3)+32*(i>>2); u.qb=(j==0)?s:(j==1)?15-s:(j==2)?16+s:31-s; return true; }
  __device__ __forceinline__ void a_ready(const AttnUnit&)const{}
  __device__ __forceinline__ void done(const AttnUnit&)const{}
};
template<class Sched,int THRL=8> __device__ __forceinline__ void attn_phase(char*lds,const AttnTensors&T,const Sched&S){
  AttnUnit u;
  for(int i=0;S.next(i,u);++i){ S.a_ready(u); attn_unit<THRL>(u.bh/NHEAD,u.bh%NHEAD,u.qb,T.Q,T.K,T.V,T.O,lds,T.CK); S.done(u); }
}
#undef SBAR
#undef WAIT_BAR
}
namespace cg = cooperative_groups;
#define LAS __attribute__((address_space(3)))
typedef unsigned v4u __attribute__((ext_vector_type(4)));
typedef unsigned v2u __attribute__((ext_vector_type(2)));
typedef float f32x4 __attribute__((ext_vector_type(4)));
using pg8::bf16_t;
constexpr int NWAVES = 8, SEQ = 8192, DM = 1024, NB = 8, DFF = 2816, NIN = 5128;
constexpr float LN_EPS = 1e-5f, LOG2E_F = 1.4426950408889634f;
constexpr size_t MiB = 1u << 20;
constexpr size_t WS_MOD = 0, WS_WFT = 512 * 1024, WS_LF = 1 * MiB, WS_CK = 3 * MiB;
constexpr size_t WS_WIN = 6 * MiB, WS_WFS = 16 * MiB, WS_WO = 18 * MiB, WS_WUP = 20 * MiB, WS_WDN = 31 * MiB;
constexpr size_t WS_U = 40 * MiB;
constexpr size_t WS_QKV = 168 * MiB;
constexpr size_t WS_MERGED = WS_QKV + 128 * MiB;
constexpr size_t WS_ACT = WS_QKV;
constexpr size_t WS_G = 552 * MiB;
constexpr size_t WS_H1 = WS_G;
constexpr size_t WS_END = 808 * MiB;
constexpr int RING_BYTES = 131072, XCH_OFF = RING_BYTES, MISC_OFF = XCH_OFF + 8192, LDS_BYTES = 147456;

#define LDS_WAIT() asm volatile("s_waitcnt lgkmcnt(0)" ::: "memory")
__device__ __forceinline__ unsigned f2bf(float f) { unsigned u = __builtin_bit_cast(unsigned, f); return (u + 0x7fffu + ((u >> 16) & 1u)) >> 16; }
__device__ __forceinline__ unsigned pk2(float lo, float hi) { return f2bf(lo) | (f2bf(hi) << 16); }
__device__ __forceinline__ float wave_sum(float v) {
#pragma unroll
    for (int o = 1; o < 64; o <<= 1) v += __shfl_xor(v, o);
    return v;
}
__device__ __forceinline__ void tr_item(const float* W, int ldw, int srcc0, int k0, bf16_t* WT, int ldk, int dstr0, LAS float* scr, int lane) {
#pragma unroll 8
    for (int i = 0; i < 32; ++i) { const int kk = 2 * i + (lane >> 5); scr[kk * 33 + (lane & 31)] = W[(size_t)(k0 + kk) * ldw + srcc0 + (lane & 31)]; }
    LDS_WAIT();
    const int c = lane & 7;
#pragma unroll
    for (int j = 0; j < 4; ++j) { const int n = (lane >> 3) + 8 * j; const LAS float* s = scr + (8 * c) * 33 + n;
        v4u o; o.x = pk2(s[0 * 33], s[1 * 33]); o.y = pk2(s[2 * 33], s[3 * 33]); o.z = pk2(s[4 * 33], s[5 * 33]); o.w = pk2(s[6 * 33], s[7 * 33]);
        *(v4u*)(WT + (size_t)(dstr0 + n) * ldk + k0 + 8 * c) = o; }
    LDS_WAIT();
}

typedef short s16x8 __attribute__((ext_vector_type(8)));
typedef float f32x16 __attribute__((ext_vector_type(16)));
__device__ __forceinline__ int crow16(int r, int hi) { return (r & 3) + 8 * (r >> 2) + 4 * hi; }
__device__ __forceinline__ void sb_unit(int b, int h, int qblk, const bf16_t* Q, const bf16_t* __restrict__ K, const bf16_t* __restrict__ V, bf16_t* O, LAS unsigned char* vst, int lane_) {
    int lane = lane_; asm volatile("" : "+v"(lane));
    const int r32 = lane & 31, hi = lane >> 5; const size_t rowbase = (size_t)b * SEQ; const int qw0 = qblk * 32, q = qw0 + r32;
    const bf16_t* Qw = Q + (rowbase + qw0) * 512 + h * 64;
    s16x8 qr[4];
#pragma unroll
    for (int d0 = 0; d0 < 4; ++d0) qr[d0] = *(const s16x8*)(Qw + (size_t)r32 * 512 + d0 * 16 + hi * 8);
    f32x16 o0 = {}, o1 = {}; float R = 0.f;
    for (int jt = qblk; jt >= 0; --jt) {
        const int k0 = jt * 32;
        const bf16_t* Kp = K + (rowbase + k0 + r32) * 512 + h * 64 + hi * 8;
        s16x8 kf[4];
#pragma unroll
        for (int d0 = 0; d0 < 4; ++d0) kf[d0] = *(const s16x8*)(Kp + d0 * 16);
#pragma unroll
        for (int i = 0; i < 4; ++i) { const int c = lane + 64 * i, key = c >> 3, part = c & 7;
            const v4u v = *(const v4u*)(V + (rowbase + k0 + key) * 512 + h * 64 + part * 8); *(LAS v4u*)(vst + key * 144 + part * 16) = v; }
        f32x16 s = {};
#pragma unroll
        for (int d0 = 0; d0 < 4; ++d0) s = __builtin_amdgcn_mfma_f32_32x32x16_bf16(kf[d0], qr[d0], s, 0, 0, 0);
        float Lv[16], lb[16], sfx[16], own[4], oth[4], sufg[4];
#pragma unroll
        for (int r = 0; r < 16; ++r) { const bool valid = (k0 + crow16(r, hi)) < q; const float zz = __builtin_fminf(s[r], 100.f);
            const float l = __builtin_amdgcn_logf(1.0f + __builtin_amdgcn_exp2f(zz)); Lv[r] = valid ? l : 0.f; lb[r] = valid ? (zz - l) : -1e30f; }
#pragma unroll
        for (int i = 0; i < 4; ++i) { const float a3 = Lv[4 * i + 3], a2 = a3 + Lv[4 * i + 2], a1 = a2 + Lv[4 * i + 1]; own[i] = a1 + Lv[4 * i];
            sfx[4 * i + 3] = 0.f; sfx[4 * i + 2] = a3; sfx[4 * i + 1] = a2; sfx[4 * i] = a1; }
#pragma unroll
        for (int i = 0; i < 4; ++i) oth[i] = __shfl_xor(own[i], 32);
        float accs = 0.f;
#pragma unroll
        for (int i = 3; i >= 0; --i) { sufg[i] = accs + (hi == 0 ? oth[i] : 0.f); accs += own[i] + oth[i]; }
        float av[16];
#pragma unroll
        for (int r = 0; r < 16; ++r) av[r] = __builtin_amdgcn_exp2f(lb[r] - (R + sufg[r >> 2] + sfx[r]));
        R += accs;
        v4u pa0, pa1;
        pa0.x = pg8::cvt_pk_bf16(av[0], av[1]); pa0.y = pg8::cvt_pk_bf16(av[2], av[3]); pa0.z = pg8::cvt_pk_bf16(av[4], av[5]); pa0.w = pg8::cvt_pk_bf16(av[6], av[7]);
        pa1.x = pg8::cvt_pk_bf16(av[8], av[9]); pa1.y = pg8::cvt_pk_bf16(av[10], av[11]); pa1.z = pg8::cvt_pk_bf16(av[12], av[13]); pa1.w = pg8::cvt_pk_bf16(av[14], av[15]);
        LDS_WAIT();
#pragma unroll
        for (int ks = 0; ks < 2; ++ks)
#pragma unroll
            for (int d0 = 0; d0 < 2; ++d0) { unsigned short e[8];
#pragma unroll
                for (int j = 0; j < 8; ++j) e[j] = *(const LAS unsigned short*)(vst + (16 * ks + 8 * (j >> 2) + 4 * hi + (j & 3)) * 144 + (32 * d0 + r32) * 2);
                v4u vb; vb.x = e[0] | ((unsigned)e[1] << 16); vb.y = e[2] | ((unsigned)e[3] << 16); vb.z = e[4] | ((unsigned)e[5] << 16); vb.w = e[6] | ((unsigned)e[7] << 16);
                const s16x8 pa = __builtin_bit_cast(s16x8, ks == 0 ? pa0 : pa1), vf = __builtin_bit_cast(s16x8, vb);
                if (d0 == 0) o0 = __builtin_amdgcn_mfma_f32_32x32x16_bf16(pa, vf, o0, 0, 0, 0); else o1 = __builtin_amdgcn_mfma_f32_32x32x16_bf16(pa, vf, o1, 0, 0, 0); }
        LDS_WAIT();
        if (__all(R >= 160.f)) break;
    }
    bf16_t* Ow = O + (rowbase + qw0) * 512 + h * 64;
#pragma unroll
    for (int r = 0; r < 16; ++r) { const int orow = crow16(r, hi);
        Ow[(size_t)orow * 512 + r32] = (bf16_t)f2bf(o0[r]); Ow[(size_t)orow * 512 + 32 + r32] = (bf16_t)f2bf(o1[r]); }
}

struct Args { const float* in[17]; float* out; unsigned char* ws; };

struct MergeOrder {
    pg8::StaticOrder base;
    __device__ bool next(int i, pg8::Unit& u) const { pg8::Unit t; if (!base.next(i >> 1, t)) return false; const int grp = i & 1; u.pm = t.pm + 256 * grp; u.pn = t.pn + 4 * grp; return true; }
    __device__ __forceinline__ void a_ready(const pg8::Unit&) const {}
    __device__ __forceinline__ void done(const pg8::Unit&) const {}
};

__global__ void __launch_bounds__(NWAVES * 64, 2) fwd_mega(Args args) {
    extern __shared__ __attribute__((aligned(16))) unsigned char lds[];
    cg::grid_group grid = cg::this_grid();
    LAS unsigned char* L = (LAS unsigned char*)lds;
    const int tid = threadIdx.x, lane = tid & 63, wave = __builtin_amdgcn_readfirstlane(tid >> 6);
    const int G = gridDim.x, gw = blockIdx.x * NWAVES + wave, NGW = G * NWAVES;
    unsigned char* ws = args.ws;
    const float* x = args.in[0]; const float* cvec = args.in[1]; const float* w_ada = args.in[2]; const float* b_ada = args.in[3]; const float* w_in = args.in[4];
    const float* b_forget = args.in[5]; const float* w_fox = args.in[6]; const float* w_sb = args.in[7]; const float* w_o = args.in[8];
    const float* ln1_g = args.in[9]; const float* ln1_b = args.in[10]; const float* w_up = args.in[11]; const float* conv_w = args.in[12]; const float* conv_b = args.in[13];
    const float* w_dn = args.in[14]; const float* ln2_g = args.in[15]; const float* ln2_b = args.in[16];
    float* MOD = (float*)(ws + WS_MOD); float* WFT = (float*)(ws + WS_WFT); float* LF = (float*)(ws + WS_LF); float* CK = (float*)(ws + WS_CK);
    bf16_t* WIN = (bf16_t*)(ws + WS_WIN); bf16_t* WFS = (bf16_t*)(ws + WS_WFS); bf16_t* WO = (bf16_t*)(ws + WS_WO); bf16_t* WUP = (bf16_t*)(ws + WS_WUP); bf16_t* WDN = (bf16_t*)(ws + WS_WDN);
    bf16_t* U = (bf16_t*)(ws + WS_U); bf16_t* QKV = (bf16_t*)(ws + WS_QKV); bf16_t* MERGED = (bf16_t*)(ws + WS_MERGED); bf16_t* ACT = (bf16_t*)(ws + WS_ACT);
    bf16_t* GATES = (bf16_t*)(ws + WS_G); float* H1 = (float*)(ws + WS_H1);
    const size_t SLOT = (size_t)MTOK * 512;
    bf16_t* QA = QKV; bf16_t* QB = QKV + SLOT; bf16_t* KA = QKV + 2 * SLOT; bf16_t* VA = QKV + 3 * SLOT; bf16_t* KB = QKV + 4 * SLOT; bf16_t* VB = QKV + 5 * SLOT;

#if !defined(SKIP_P0)
    {
        LAS float* scr = (LAS float*)(L + wave * 16384);
        constexpr int I_IN = 16 * 160, I_FS = 8 * 32, I_O = 16 * 32, I_UP = 16 * 176, I_DN = 44 * 32, I_MOD = 768;
        constexpr int NIT = I_MOD + I_IN + 2 * I_FS + I_O + I_UP + I_DN;
        for (int it = gw; it < NIT; it += NGW) {
            int r = it;
            if (r < I_MOD) {
                const int j0 = 8 * r; float a[8][8];
#pragma unroll
                for (int bb = 0; bb < 8; ++bb)
#pragma unroll
                    for (int j = 0; j < 8; ++j) a[bb][j] = 0.f;
#pragma unroll 4
                for (int i = 0; i < 16; ++i) { const int k = lane + 64 * i; const f32x4 w0 = *(const f32x4*)(w_ada + (size_t)k * 6144 + j0), w1 = *(const f32x4*)(w_ada + (size_t)k * 6144 + j0 + 4);
#pragma unroll
                    for (int bb = 0; bb < 8; ++bb) { const float cb = cvec[bb * 1024 + k];
                        a[bb][0] += cb * w0[0]; a[bb][1] += cb * w0[1]; a[bb][2] += cb * w0[2]; a[bb][3] += cb * w0[3]; a[bb][4] += cb * w1[0]; a[bb][5] += cb * w1[1]; a[bb][6] += cb * w1[2]; a[bb][7] += cb * w1[3]; } }
                float mine = 0.f;
#pragma unroll
                for (int bb = 0; bb < 8; ++bb)
#pragma unroll
                    for (int j = 0; j < 8; ++j) { const float s = wave_sum(a[bb][j]); if (lane == bb * 8 + j) mine = s; }
                MOD[(lane >> 3) * 6144 + j0 + (lane & 7)] = mine + b_ada[j0 + (lane & 7)];
                continue;
            }
            r -= I_MOD;
            if (r < I_IN) { const int kb = r / 160, nb = r % 160, n0 = 32 * nb; tr_item(w_in, NIN, n0 + (n0 >= 1536 ? 8 : 0), 64 * kb, WIN, 1024, n0, scr, lane); continue; } r -= I_IN;
            if (r < I_FS) { const int kb = r / 32, nb = r % 32; tr_item(w_fox, 1024, 32 * nb, 64 * kb, WFS, 512, 32 * nb, scr, lane); continue; } r -= I_FS;
            if (r < I_FS) { const int kb = r / 32, nb = r % 32; tr_item(w_sb, 1024, 32 * nb, 64 * kb, WFS, 512, 1024 + 32 * nb, scr, lane); continue; } r -= I_FS;
            if (r < I_O) { const int kb = r / 32, nb = r % 32; tr_item(w_o, 1024, 32 * nb, 64 * kb, WO, 1024, 32 * nb, scr, lane); continue; } r -= I_O;
            if (r < I_UP) { const int kb = r / 176, nb = r % 176, nn0 = 32 * nb; const int src = ((nn0 >> 7) & 1) * DFF + 128 * (nn0 >> 8) + (nn0 & 127);
                tr_item(w_up, 2 * DFF, src, 64 * kb, WUP, 1024, nn0, scr, lane); continue; } r -= I_UP;
            { const int kb = r / 32, nb = r % 32; tr_item(w_dn, 1024, 32 * nb, 64 * kb, WDN, DFF, 32 * nb, scr, lane); }
        }
        for (int e = blockIdx.x * (NWAVES * 64) + tid; e < 8192; e += G * NWAVES * 64) WFT[e] = w_in[(size_t)(e & 1023) * NIN + 1536 + (e >> 10)];
    }
#endif
    grid.sync();

#if !defined(SKIP_P1)
    for (int blk = gw; blk < MTOK / 32; blk += NGW) {
        const int m0 = blk * 32, b = m0 >> 13; const float* mb = MOD + (size_t)b * 6144;
        f32x4 wf[8][4];
#pragma unroll
        for (int hh = 0; hh < 8; ++hh)
#pragma unroll
            for (int j = 0; j < 4; ++j) wf[hh][j] = *(const f32x4*)(WFT + hh * 1024 + 4 * lane + 256 * j);
        const float bf = b_forget[lane & 7];
        for (int r = 0; r < 32; ++r) {
            const int m = m0 + r; const f32x4* xr = (const f32x4*)(x + (size_t)m * 1024) + lane; unsigned long long* o8 = (unsigned long long*)(U + (size_t)m * 1024) + lane;
            f32x4 u[4];
#pragma unroll
            for (int j = 0; j < 4; ++j) { const f32x4 shj = *(const f32x4*)(mb + 4 * lane + 256 * j), scj = *(const f32x4*)(mb + 1024 + 4 * lane + 256 * j) + 1.0f; u[j] = xr[64 * j] * scj + shj; o8[64 * j] = (unsigned long long)pk2(u[j][0], u[j][1]) | ((unsigned long long)pk2(u[j][2], u[j][3]) << 32); }
            float mine = 0.f;
#pragma unroll
            for (int hh = 0; hh < 8; ++hh) { float s = 0.f;
#pragma unroll
                for (int j = 0; j < 4; ++j) { const f32x4 p = u[j] * wf[hh][j]; s += (p[0] + p[1]) + (p[2] + p[3]); }
                s = wave_sum(s); if ((lane & 7) == hh) mine = s; }
            if (lane < 8) { const float f = mine + bf; const float ls = (f >= 0.f) ? -log1pf(expf(-f)) : (f - log1pf(expf(f)));
                LF[((size_t)(b * 8 + lane)) * SEQ + (m & (SEQ - 1))] = ls * LOG2E_F; }
        }
    }
#endif
    grid.sync();

#if !defined(SKIP_P2)
    if (blockIdx.x < 64) {
        LAS double* sm = (LAS double*)(L + MISC_OFF);
        const float* src = LF + (size_t)blockIdx.x * SEQ + 16 * tid; float* dst = CK + (size_t)blockIdx.x * SEQ + 16 * tid;
        f32x4 v[4]; double loc[16]; double run = 0.0;
#pragma unroll
        for (int j = 0; j < 4; ++j) v[j] = *(const f32x4*)(src + 4 * j);
#pragma unroll
        for (int i = 0; i < 16; ++i) { run += (double)v[i >> 2][i & 3]; loc[i] = run; }
        double inc = run;
#pragma unroll
        for (int o = 1; o < 64; o <<= 1) { const double t = __shfl_up(inc, o); if (lane >= o) inc += t; }
        if (lane == 63) sm[wave] = inc;
        __syncthreads();
        double woff = 0.0;
        for (int w = 0; w < wave; ++w) woff += sm[w];
        const double excl = woff + inc - run;
#pragma unroll
        for (int j = 0; j < 4; ++j) *(f32x4*)(dst + 4 * j) = (f32x4){(float)(excl + loc[4 * j]), (float)(excl + loc[4 * j + 1]), (float)(excl + loc[4 * j + 2]), (float)(excl + loc[4 * j + 3])};
        __syncthreads();
    }
    {
        pg8::Gemm g{U, WIN, MTOK, 5120, 1024, (size_t)256 * 1024 * 2}; pg8::StaticOrder S; S.init(MTOK, 5120, G, (int)blockIdx.x);
        pg8::EpiInProj E{QKV, GATES};
        pg8::gemm_phase<pg8::EpiInProj, pg8::StaticOrder, true, true>(L, g, S, E);
    }
#endif
    grid.sync();

#if !defined(SKIP_P3)
    {
        LAS unsigned char* vst = L + wave * 4608;
        for (int i = 0; i < (64 * 256) / NGW + 1; ++i) { const int uid = i * NGW + gw; if (uid >= 64 * 256) break; const int bh = uid >> 8, qblk = uid & 255;
            sb_unit(bh >> 3, bh & 7, qblk, QB, KB, VB, QB, vst, lane); }
        __syncthreads();
        const attn_body::AttnTensors AT{(const attn_body::bf16*)QA, (const attn_body::bf16*)KA, (const attn_body::bf16*)VA, (attn_body::bf16*)QA, CK};
        const attn_body::StaticOrder S(G, (int)blockIdx.x);
        attn_body::attn_phase<attn_body::StaticOrder>((char*)lds, AT, S);
    }
#endif
    grid.sync();

#if !defined(SKIP_P4)
    {
        pg8::Gemm g{QA, WFS, 2 * MTOK, 2048, 512, (size_t)256 * 512 * 2}; MergeOrder S; S.base.init(MTOK, 1024, G, (int)blockIdx.x);
        pg8::EpiMerge E{GATES, args.out, MERGED};
        pg8::gemm_phase<pg8::EpiMerge, MergeOrder, true, true>(L, g, S, E);
    }
#endif
    grid.sync();

#if !defined(SKIP_P5)
    {
        pg8::Gemm g{MERGED, WO, MTOK, 1024, 1024, (size_t)256 * 1024 * 2}; pg8::StaticOrder S; S.init(MTOK, 1024, G, (int)blockIdx.x);
        pg8::EpiRes E{x, MOD + 2048, H1};
        pg8::gemm_phase<pg8::EpiRes, pg8::StaticOrder, true, true>(L, g, S, E);
    }
#endif
    grid.sync();

#if !defined(SKIP_P6)
    for (int blk = gw; blk < MTOK / 32; blk += NGW) {
        const int m0 = blk * 32, b = m0 >> 13; const float* mb = MOD + (size_t)b * 6144;
        f32x4 sc[4], sh[4], lg[4], lb[4];
#pragma unroll
        for (int j = 0; j < 4; ++j) { sh[j] = *(const f32x4*)(mb + 3072 + 4 * lane + 256 * j); sc[j] = *(const f32x4*)(mb + 4096 + 4 * lane + 256 * j) + 1.0f;
            lg[j] = *(const f32x4*)(ln1_g + 4 * lane + 256 * j); lb[j] = *(const f32x4*)(ln1_b + 4 * lane + 256 * j); }
        for (int r = 0; r < 32; ++r) {
            const int m = m0 + r; f32x4* hr = (f32x4*)(H1 + (size_t)m * 1024) + lane; unsigned long long* o8 = (unsigned long long*)(U + (size_t)m * 1024) + lane;
            f32x4 v[4]; float s = 0.f;
#pragma unroll
            for (int j = 0; j < 4; ++j) { v[j] = hr[64 * j]; s += (v[j][0] + v[j][1]) + (v[j][2] + v[j][3]); }
            const float mean = wave_sum(s) * (1.f / 1024.f); float s2 = 0.f;
#pragma unroll
            for (int j = 0; j < 4; ++j) { v[j] = v[j] - mean; s2 += (v[j][0] * v[j][0] + v[j][1] * v[j][1]) + (v[j][2] * v[j][2] + v[j][3] * v[j][3]); }
            const float rstd = 1.f / sqrtf(wave_sum(s2) * (1.f / 1024.f) + LN_EPS);
#pragma unroll
            for (int j = 0; j < 4; ++j) { const f32x4 x1 = v[j] * rstd * lg[j] + lb[j]; hr[64 * j] = x1; const f32x4 u2 = x1 * sc[j] + sh[j];
                o8[64 * j] = (unsigned long long)pk2(u2[0], u2[1]) | ((unsigned long long)pk2(u2[2], u2[3]) << 32); }
        }
    }
#endif
    grid.sync();

#if !defined(SKIP_P7)
    {
        pg8::Gemm g{U - 2 * 1024, WUP, MTOK, 2 * DFF, 1024, (size_t)254 * 1024 * 2}; pg8::StaticOrder S; S.init_tiles(259, 22, G, (int)blockIdx.x);
        pg8::EpiUpConv E{conv_w, conv_b, ACT, (LAS f32x4*)(L + XCH_OFF)};
        pg8::gemm_phase<pg8::EpiUpConv, pg8::StaticOrder, true, true>(L, g, S, E);
    }
#endif
    grid.sync();

#if !defined(SKIP_P8)
    {
        pg8::Gemm g{ACT, WDN, MTOK, 1024, DFF, (size_t)256 * DFF * 2}; pg8::StaticOrder S; S.init(MTOK, 1024, G, (int)blockIdx.x);
        pg8::EpiRes E{H1, MOD + 5120, args.out};
        pg8::gemm_phase<pg8::EpiRes, pg8::StaticOrder, true, true>(L, g, S, E);
    }
#endif
    grid.sync();

#if !defined(SKIP_P9)
    {
        f32x4 lg[4], lb[4];
#pragma unroll
        for (int j = 0; j < 4; ++j) { lg[j] = *(const f32x4*)(ln2_g + 4 * lane + 256 * j); lb[j] = *(const f32x4*)(ln2_b + 4 * lane + 256 * j); }
        for (int m = gw; m < MTOK; m += NGW) {
            f32x4* hr = (f32x4*)(args.out + (size_t)m * 1024) + lane; f32x4 v[4]; float s = 0.f;
#pragma unroll
            for (int j = 0; j < 4; ++j) { v[j] = hr[64 * j]; s += (v[j][0] + v[j][1]) + (v[j][2] + v[j][3]); }
            const float mean = wave_sum(s) * (1.f / 1024.f); float s2 = 0.f;
#pragma unroll
            for (int j = 0; j < 4; ++j) { v[j] = v[j] - mean; s2 += (v[j][0] * v[j][0] + v[j][1] * v[j][1]) + (v[j][2] * v[j][2] + v[j][3] * v[j][3]); }
            const float rstd = 1.f / sqrtf(wave_sum(s2) * (1.f / 1024.f) + LN_EPS);
#pragma unroll
            for (int j = 0; j < 4; ++j) hr[64 * j] = v[j] * rstd * lg[j] + lb[j];
        }
    }
#endif
}

extern "C" void kernel_launch(void* const* d_in, const int* in_sizes, int n_in, void* d_out, int out_size, void* d_ws, size_t ws_size, hipStream_t stream) {
    static int grid = 0;
    if (grid == 0) {
        if (n_in != 17 || out_size != MTOK * 1024 || ws_size < WS_END) { fprintf(stderr, "kernel_launch: unexpected shapes (n_in %d out %d ws %zu)\n", n_in, out_size, ws_size); grid = -1; return; }
        int dev = 0, cus = 0, per_cu = 0;
        hipGetDevice(&dev); hipDeviceGetAttribute(&cus, hipDeviceAttributeMultiprocessorCount, dev);
        if (hipFuncSetAttribute((const void*)fwd_mega, hipFuncAttributeMaxDynamicSharedMemorySize, LDS_BYTES) != hipSuccess) { fprintf(stderr, "kernel_launch: hipFuncSetAttribute failed\n"); grid = -1; return; }
        hipOccupancyMaxActiveBlocksPerMultiprocessor(&per_cu, (const void*)fwd_mega, NWAVES * 64, LDS_BYTES);
        (void)hipGetLastError();
        if (per_cu < 1) per_cu = 1;
        grid = cus * 1;
    }
    if (grid < 0) return;
    Args a{};
    for (int i = 0; i < 17; ++i) a.in[i] = (const float*)d_in[i];
    a.out = (float*)d_out; a.ws = (unsigned char*)d_ws;
    void* kargs[] = {&a};
    hipError_t e = hipLaunchCooperativeKernel((const void*)fwd_mega, dim3(grid), dim3(NWAVES * 64), kargs, LDS_BYTES, stream);
    if (e != hipSuccess) fprintf(stderr, "cooperative launch failed: %s (grid %d)\n", hipGetErrorString(e), grid);
}
```

```cpp
#include <hip/hip_runtime.h>
#include <hip/hip_cooperative_groups.h>
#include <cstdio>
#include <cstdint>
constexpr int MTOK = 65536;
constexpr float DN_ALPHA = 1.189207115002721f;
namespace pg8 {
#define PG8_LAS __attribute__((address_space(3)))
typedef unsigned short bf16_t;
typedef short bf16x8 __attribute__((ext_vector_type(8)));
typedef float f32x4 __attribute__((ext_vector_type(4)));
typedef unsigned u32x4 __attribute__((ext_vector_type(4)));
constexpr int BM = 256, BK = 64, HALF = 128, HTB = HALF * BK * 2  , STAGE_BYTES = 8 * HTB, NXCD = 8, WGM = 8;

__host__ __device__ __forceinline__ int lds_byte(int r, int c) { const int st = (r >> 4) * 2 + (c >> 5), rr = r & 15, cc = c & 31, ob = rr * 64 + cc * 2; return st * 1024 + (ob ^ (((ob >> 9) & 1) << 5)); }
__host__ __device__ __forceinline__ void stage_rc(int b, int& R, int& C) { const int st = b / 1024, sb = b % 1024, swz = sb ^ (((sb >> 9) & 1) << 5); R = (st >> 1) * 16 + swz / 64; C = (st & 1) * 32 + (swz % 64) / 2; }
__host__ __device__ __forceinline__ int perm32(int rho) { const int n = rho >> 4, i = rho & 15; return 8 * (i >> 2) + 4 * n + (i & 3); }

struct Unit { int pm, pn; };
struct Gemm { const bf16_t* A; const bf16_t* Bt; int M, N, K; size_t a_tstep; };

struct StaticOrder {
    int nM, nN, nwg, G, c;
    __host__ __device__ void init(int M, int N, int G_, int c_) { nM = M / BM; nN = N / BM; nwg = nM * nN; G = G_; c = c_; }
    __host__ __device__ void init_tiles(int nM_, int nN_, int G_, int c_) { nM = nM_; nN = nN_; nwg = nM * nN; G = G_; c = c_; }
    __host__ __device__ bool next(int i, Unit& u) const {
        const long L = (long)i * G + c; if (L >= nwg) return false;
        int wgid = (int)L; { const int q = nwg / NXCD, r = nwg % NXCD, xcd = wgid % NXCD, off = wgid / NXCD; wgid = (xcd < r ? xcd * (q + 1) : r * (q + 1) + (xcd - r) * q) + off; }
        const int nig = WGM * nN, gid = wgid / nig, fm = gid * WGM, gsz = (nM - fm) < WGM ? (nM - fm) : WGM;
        u.pm = fm + ((wgid % nig) % gsz); u.pn = (wgid % nig) / gsz; return true;
    }
    __device__ __forceinline__ void a_ready(const Unit&) const {}
    __device__ __forceinline__ void done(const Unit&) const {}
};

__device__ __forceinline__ unsigned cvt_pk_bf16(float lo, float hi) { unsigned r; asm volatile("v_cvt_pk_bf16_f32 %0, %1, %2" : "=v"(r) : "v"(lo), "v"(hi)); return r; }
typedef float f32x2 __attribute__((ext_vector_type(2)));
constexpr float C2f = 0.125f * 1.4426950408889634f;
constexpr float LOG2E = 1.4426950408889634f;
__device__ __forceinline__ float sigm(float v) { return __builtin_amdgcn_rcpf(1.0f + __builtin_amdgcn_exp2f(-LOG2E * v)); }
__device__ __forceinline__ float bflo(unsigned w) { return __builtin_bit_cast(float, w << 16); }
__device__ __forceinline__ float bfhi(unsigned w) { return __builtin_bit_cast(float, w & 0xffff0000u); }

struct EpiInProj {
    static constexpr bool PERM = true, AFTER_DRAIN = false;
    bf16_t* qkv; bf16_t* gates; unsigned* nrm;
    __device__ __forceinline__ void operator()(const f32x4 (&acc)[2][2][4][2], const Unit& u, int wr, int wc, int fr, int fq) const {
        const int pn = u.pn; bf16_t* base; int ldc, colt; float sc = 1.f; bool sg = false;
        if (pn < 12) { const int t = pn >> 1, slot = (0x541320 >> (4 * t)) & 7; base = qkv + (size_t)slot * ((size_t)MTOK * 512); ldc = 512; colt = (pn & 1) * 256; if (t == 0 || t == 3) sc = C2f; }
        else { const int t = (pn - 12) >> 2; base = gates + (size_t)t * ((size_t)MTOK * 1024); ldc = 1024; colt = ((pn - 12) & 3) * 256; sg = true; }
        const int row0 = u.pm * BM + wr * 64 + fr, col0 = colt + wc * 32 + 8 * fq;
        float nmx[2] = {0.f, 0.f};
#pragma unroll
        for (int ai = 0; ai < 2; ++ai)
#pragma unroll
            for (int m = 0; m < 4; ++m) { bf16_t* rowp = base + (size_t)(row0 + ai * HALF + m * 16) * ldc + col0;
#pragma unroll
                for (int bj = 0; bj < 2; ++bj) { f32x4 v0 = acc[ai][bj][m][0], v1 = acc[ai][bj][m][1];
                    if (pn < 4) { const float a0 = bflo(cvt_pk_bf16(v0[0] * sc, 0.f)), a1 = bflo(cvt_pk_bf16(v0[1] * sc, 0.f)), a2 = bflo(cvt_pk_bf16(v0[2] * sc, 0.f)), a3 = bflo(cvt_pk_bf16(v0[3] * sc, 0.f)),
                                      a4 = bflo(cvt_pk_bf16(v1[0] * sc, 0.f)), a5 = bflo(cvt_pk_bf16(v1[1] * sc, 0.f)), a6 = bflo(cvt_pk_bf16(v1[2] * sc, 0.f)), a7 = bflo(cvt_pk_bf16(v1[3] * sc, 0.f));
                        float s = (a0 * a0 + a1 * a1) + (a2 * a2 + a3 * a3) + (a4 * a4 + a5 * a5) + (a6 * a6 + a7 * a7);
                        s += __shfl_xor(s, 16); s += __shfl_xor(s, 32); nmx[bj] = __builtin_fmaxf(nmx[bj], s); }
                    if (sg) { v0 = (f32x4){sigm(v0[0]), sigm(v0[1]), sigm(v0[2]), sigm(v0[3])}; v1 = (f32x4){sigm(v1[0]), sigm(v1[1]), sigm(v1[2]), sigm(v1[3])}; }
                    else { v0 = v0 * sc; v1 = v1 * sc; }
                    u32x4 w; w.x = cvt_pk_bf16(v0[0], v0[1]); w.y = cvt_pk_bf16(v0[2], v0[3]); w.z = cvt_pk_bf16(v1[0], v1[1]); w.w = cvt_pk_bf16(v1[2], v1[3]);
                    *(u32x4*)(rowp + bj * HALF) = w; } }
        if (pn < 4) {
#pragma unroll
            for (int bj = 0; bj < 2; ++bj) { float s = nmx[bj] * 1.0001f;
#pragma unroll
                for (int o = 1; o < 16; o <<= 1) s = __builtin_fmaxf(s, __shfl_xor(s, o));
                if (fr == 0 && fq == 0) atomicMax(nrm + (((u.pm >> 5) * 8 + (pn & 1) * 4 + bj * 2 + (wc >> 1)) * 2 + (pn >> 1)) * 2 + (wc & 1), __builtin_bit_cast(unsigned, s)); }
        }
    }
};

struct EpiMerge {
    static constexpr bool PERM = true, AFTER_DRAIN = false;
    const bf16_t* gates; float* park; bf16_t* merged;
    __device__ __forceinline__ void operator()(const f32x4 (&acc)[2][2][4][2], const Unit& u, int wr, int wc, int fr, int fq) const {
        const int grp = u.pn >> 2, pnn = u.pn & 3, pmm = u.pm & 255;
        const bf16_t* G = gates + (size_t)grp * ((size_t)MTOK * 1024);
        const int row0 = pmm * BM + wr * 64 + fr, col0 = pnn * BM + wc * 32 + 8 * fq;
#pragma unroll
        for (int ai = 0; ai < 2; ++ai)
#pragma unroll
            for (int m = 0; m < 4; ++m)
#pragma unroll
                for (int bj = 0; bj < 2; ++bj) { const size_t off = (size_t)(row0 + ai * HALF + m * 16) * 1024 + col0 + bj * HALF;
                    const u32x4 gw = *(const u32x4*)(G + off);
                    f32x4 v0 = acc[ai][bj][m][0] * (f32x4){bflo(gw.x), bfhi(gw.x), bflo(gw.y), bfhi(gw.y)};
                    f32x4 v1 = acc[ai][bj][m][1] * (f32x4){bflo(gw.z), bfhi(gw.z), bflo(gw.w), bfhi(gw.w)};
                    if (grp == 0) { *(f32x4*)(park + off) = v0; *(f32x4*)(park + off + 4) = v1; }
                    else { v0 = v0 + *(const f32x4*)(park + off); v1 = v1 + *(const f32x4*)(park + off + 4);
                        u32x4 w; w.x = cvt_pk_bf16(v0[0], v0[1]); w.y = cvt_pk_bf16(v0[2], v0[3]); w.z = cvt_pk_bf16(v1[0], v1[1]); w.w = cvt_pk_bf16(v1[2], v1[3]);
                        *(u32x4*)(merged + off) = w; } }
    }
};

struct EpiRes {
    static constexpr bool PERM = true, AFTER_DRAIN = false;
    const float* base; const float* gt; float* out;
    __device__ __forceinline__ void operator()(const f32x4 (&acc)[2][2][4][2], const Unit& u, int wr, int wc, int fr, int fq) const {
        const int row0 = u.pm * BM + wr * 64 + fr, col0 = u.pn * BM + wc * 32 + 8 * fq; const float* g = gt + (size_t)(u.pm >> 5) * 6144 + col0;
#pragma unroll
        for (int bj = 0; bj < 2; ++bj)
#pragma unroll
            for (int n = 0; n < 2; ++n) { const f32x4 gv = *(const f32x4*)(g + bj * HALF + 4 * n) + 1.0f;
#pragma unroll
                for (int ai = 0; ai < 2; ++ai)
#pragma unroll
                    for (int m = 0; m < 4; ++m) { const size_t off = (size_t)(row0 + ai * HALF + m * 16) * 1024 + col0 + bj * HALF + 4 * n;
                        *(f32x4*)(out + off) = *(const f32x4*)(base + off) * DN_ALPHA + gv * acc[ai][bj][m][n]; } }
    }
};

struct EpiUpConv {
    static constexpr bool PERM = true, AFTER_DRAIN = false;
    const float* cw; const float* cb; bf16_t* act; PG8_LAS f32x4* xch;
    __device__ __forceinline__ f32x4 conv1(const f32x4 cur, const f32x4 prv, const f32x4 w0, const f32x4 w1, const f32x4 w2, const f32x4 bb, int fr, int s1, int s2, int tseq) const {
        const f32x4 a1 = (fr >= 15) ? prv : cur, a2 = (fr >= 14) ? prv : cur;
        f32x4 p1, p2;
#pragma unroll
        for (int j = 0; j < 4; ++j) { p1[j] = __shfl(a1[j], s1); p2[j] = __shfl(a2[j], s2); }
        if (tseq < 1) p1 = (f32x4){0.f, 0.f, 0.f, 0.f};
        if (tseq < 2) p2 = (f32x4){0.f, 0.f, 0.f, 0.f};
        return bb + w0 * p2 + w1 * p1 + w2 * cur;
    }
    __device__ __forceinline__ void operator()(const f32x4 (&acc)[2][2][4][2], const Unit& u, int wr, int wc, int, int) const {
        int t_ = threadIdx.x; asm volatile("" : "+v"(t_));
        const int fr = t_ & 15, fq = (t_ >> 4) & 3, lane = t_ & 63;
        const int R0 = 254 * u.pm - 2, ch0 = 128 * u.pn + 32 * wc + 8 * fq;
        const int xi = fq * 2 + (fr - 14);
        if (fr >= 14) {
#pragma unroll
            for (int ai = 0; ai < 2; ++ai)
#pragma unroll
                for (int bj = 0; bj < 2; ++bj)
#pragma unroll
                    for (int n = 0; n < 2; ++n) xch[(((((ai * 2 + wr) * 4 + wc) * 2 + bj) * 2 + n) * 8) + xi] = acc[ai][bj][3][n];
        }
        asm volatile("s_waitcnt lgkmcnt(0)\n\ts_barrier" ::: "memory");
        const int s1 = (lane & 48) | ((fr - 1) & 15), s2 = (lane & 48) | ((fr - 2) & 15);
#pragma unroll
        for (int ai = 0; ai < 2; ++ai)
#pragma unroll
            for (int n = 0; n < 2; ++n) {
                asm volatile("" ::: "memory");
                const bool hasup = (fr >= 14) && ((ai * 2 + wr) >= 1);
                const int upi = (((((ai * 2 + wr - 1) * 4 + wc) * 2 + 0) * 2 + n) * 8) + xi;
                f32x4 cg[4];
                {   int cbase = ch0 + 4 * n; asm volatile("" : "+v"(cbase));
                    const f32x4 w0 = *(const f32x4*)(cw + cbase), w1 = *(const f32x4*)(cw + 5632 + cbase), w2 = *(const f32x4*)(cw + 2 * 5632 + cbase), bb = *(const f32x4*)(cb + cbase);
                    f32x4 up = (f32x4){0.f, 0.f, 0.f, 0.f}; if (hasup) up = xch[upi];
#pragma unroll
                    for (int m = 0; m < 4; ++m) cg[m] = conv1(acc[ai][0][m][n], (m == 0) ? up : acc[ai][0][m > 0 ? m - 1 : 0][n], w0, w1, w2, bb, fr, s1, s2, (R0 + 128 * ai + 64 * wr + 16 * m + fr) & 8191);
                }
                {   int cbase = 2816 + ch0 + 4 * n; asm volatile("" : "+v"(cbase));
                    const f32x4 w0 = *(const f32x4*)(cw + cbase), w1 = *(const f32x4*)(cw + 5632 + cbase), w2 = *(const f32x4*)(cw + 2 * 5632 + cbase), bb = *(const f32x4*)(cb + cbase);
                    f32x4 up = (f32x4){0.f, 0.f, 0.f, 0.f}; if (hasup) up = xch[upi + 16];
#pragma unroll
                    for (int m = 0; m < 4; ++m) {
                        const int rr = 128 * ai + 64 * wr + 16 * m + fr, grow = R0 + rr;
                        const f32x4 vl = conv1(acc[ai][1][m][n], (m == 0) ? up : acc[ai][1][m > 0 ? m - 1 : 0][n], w0, w1, w2, bb, fr, s1, s2, grow & 8191);
                        const f32x4 gt = cg[m];
                        const float o0 = gt[0] * sigm(gt[0]) * vl[0], o1 = gt[1] * sigm(gt[1]) * vl[1], o2 = gt[2] * sigm(gt[2]) * vl[2], o3 = gt[3] * sigm(gt[3]) * vl[3];
                        if (rr >= 2 && grow < MTOK) { typedef unsigned u32x2 __attribute__((ext_vector_type(2))); u32x2 w; w.x = cvt_pk_bf16(o0, o1); w.y = cvt_pk_bf16(o2, o3);
                            *(u32x2*)(act + (size_t)grow * 2816 + ch0 + 4 * n) = w; }
                    }
                }
            }
    }
};
template <class Epi, class Sched, bool ALIGN_EPI = false, bool SP2 = false>
__device__ __forceinline__ void gemm_phase(PG8_LAS unsigned char* lds, const Gemm g, const Sched& S, const Epi& E) {
    int tid_ = threadIdx.x; asm volatile("" : "+v"(tid_));
    const int tid = tid_, wid = __builtin_amdgcn_readfirstlane(tid >> 6), lane = tid & 63, wr = wid >> 2, wc = wid & 3, fr = lane & 15, fq = lane >> 4;
    const int K = g.K, nt = K / BK;
    unsigned voffA[2], voffB[2];
#pragma unroll
    for (int i = 0; i < 2; ++i) { int R, C; stage_rc(tid * 16 + i * 8192, R, C); const int Rb = Epi::PERM ? ((R & ~31) + perm32(R & 31)) : R;
        voffA[i] = (unsigned)(R * K + C) * 2u; voffB[i] = (unsigned)(Rb * K + C) * 2u; }
    const size_t kstep = (size_t)(BK * 2);
    const size_t hstep = (size_t)HALF * K * 2;
    const size_t tstep = 2 * hstep;
    const unsigned ldsw = (unsigned)wid * 1024u;
    const int aoff = lds_byte(wr * 64 + fr, fq * 8), boff = lds_byte(wc * 32 + fr, fq * 8);
#define PG8_SA(b, h) (((b) * 2 + (h)) * HTB)
#define PG8_SB(b, h) ((4 + (b) * 2 + (h)) * HTB)
#define PG8_STAGE(bufoff, gbase, voff) do { _Pragma("unroll") for (int _i = 0; _i < 2; ++_i) \
        __builtin_amdgcn_global_load_lds((const unsigned*)((const char*)(gbase) + (voff)[_i]), (PG8_LAS unsigned*)(lds + (bufoff) + ldsw + _i * 8192), 16, 0, 0); } while (0)
#define PG8_LDA(dst, b, h) do { _Pragma("unroll") for (int m = 0; m < 4; ++m) _Pragma("unroll") for (int k = 0; k < 2; ++k) dst[m][k] = *(const PG8_LAS bf16x8*)(lds + PG8_SA(b, h) + aoff + m * 2048 + k * 1024); } while (0)
#define PG8_LDB(dst, b, h) do { _Pragma("unroll") for (int n = 0; n < 2; ++n) _Pragma("unroll") for (int k = 0; k < 2; ++k) dst[n][k] = *(const PG8_LAS bf16x8*)(lds + PG8_SB(b, h) + boff + n * 2048 + k * 1024); } while (0)
#define PG8_MMA(ai, bj, At, Bt) do { __builtin_amdgcn_s_setprio(1); _Pragma("unroll") for (int m = 0; m < 4; ++m) _Pragma("unroll") for (int n = 0; n < 2; ++n) _Pragma("unroll") for (int k = 0; k < 2; ++k) \
        acc[ai][bj][m][n] = __builtin_amdgcn_mfma_f32_16x16x32_bf16(Bt[n][k], At[m][k], acc[ai][bj][m][n], 0, 0, 0); __builtin_amdgcn_s_setprio(0); } while (0)
#define PG8_WAIT_V(n) asm volatile("s_waitcnt vmcnt(" #n ")" ::: "memory")
#define PG8_WAIT_L(n) asm volatile("s_waitcnt lgkmcnt(" #n ")" ::: "memory")
#define PG8_BAR __builtin_amdgcn_s_barrier()
#define PG8_SCHED __builtin_amdgcn_sched_barrier(0)
    Unit cur, nxt; int ui = 0;
    if (!S.next(0, cur)) return;
    f32x4 acc[2][2][4][2];
#pragma unroll
    for (int a = 0; a < 2; ++a)
#pragma unroll
        for (int b = 0; b < 2; ++b)
#pragma unroll
            for (int m = 0; m < 4; ++m)
#pragma unroll
                for (int n = 0; n < 2; ++n) acc[a][b][m][n] = (f32x4){0.f, 0.f, 0.f, 0.f};
    bf16x8 At[4][2], B0[2][2], B1[2][2];
    const char* cA = (const char*)g.A + (size_t)cur.pm * g.a_tstep; const char* cB = (const char*)g.Bt + (size_t)cur.pn * tstep;
    S.a_ready(cur);
    if constexpr (SP2) {
        PG8_STAGE(PG8_SB(0, 0), cB, voffB); PG8_STAGE(PG8_SB(0, 1), cB + hstep, voffB); PG8_STAGE(PG8_SA(0, 0), cA, voffA); PG8_STAGE(PG8_SA(0, 1), cA + hstep, voffA);
        if (wr == 1) PG8_BAR;
        PG8_WAIT_V(2); PG8_BAR;
        PG8_STAGE(PG8_SB(1, 0), cB + kstep, voffB); PG8_STAGE(PG8_SA(1, 0), cA + kstep, voffA); PG8_STAGE(PG8_SB(1, 1), cB + hstep + kstep, voffB);
        PG8_WAIT_V(6); PG8_BAR;
    } else {
        PG8_STAGE(PG8_SB(0, 0), cB, voffB); PG8_STAGE(PG8_SA(0, 0), cA, voffA); PG8_STAGE(PG8_SB(0, 1), cB + hstep, voffB); PG8_STAGE(PG8_SA(0, 1), cA + hstep, voffA);
        if (wr == 1) PG8_BAR;
        PG8_WAIT_V(4); PG8_BAR;
        PG8_STAGE(PG8_SB(1, 0), cB + kstep, voffB); PG8_STAGE(PG8_SA(1, 0), cA + kstep, voffA); PG8_STAGE(PG8_SB(1, 1), cB + hstep + kstep, voffB);
        PG8_WAIT_V(6); PG8_BAR;
    }
    for (;;) {
        const bool has_next = S.next(ui + 1, nxt);
        const char* nA = has_next ? (const char*)g.A + (size_t)nxt.pm * g.a_tstep : cA; const char* nB = has_next ? (const char*)g.Bt + (size_t)nxt.pn * tstep : cB;
        for (int t = 0; t < nt; t += 2) {
            const bool last = (t == nt - 2);
            const char* a1 = cA + (size_t)(t + 1) * kstep;
            const char* a2 = last ? nA : cA + (size_t)(t + 2) * kstep; const char* b2 = last ? nB : cB + (size_t)(t + 2) * kstep;
            const char* a3 = a2 + kstep; const char* b3 = b2 + kstep;
            if (last && has_next) S.a_ready(nxt);
            if constexpr (SP2) {
            PG8_LDB(B0, 0, 0); PG8_LDB(B1, 0, 1); PG8_SCHED; PG8_LDA(At, 0, 0); PG8_STAGE(PG8_SA(1, 1), a1 + hstep, voffA);
            PG8_WAIT_V(8); PG8_WAIT_L(0); PG8_BAR; PG8_MMA(0, 0, At, B0); PG8_MMA(0, 1, At, B1); PG8_BAR; PG8_SCHED;
            PG8_LDA(At, 0, 1); PG8_STAGE(PG8_SB(0, 0), b2, voffB); PG8_STAGE(PG8_SB(0, 1), b2 + hstep, voffB); PG8_STAGE(PG8_SA(0, 0), a2, voffA);
            PG8_WAIT_V(8); PG8_WAIT_L(0); PG8_BAR; PG8_MMA(1, 0, At, B0); PG8_MMA(1, 1, At, B1); PG8_BAR; PG8_SCHED;
            PG8_LDB(B0, 1, 0); PG8_LDB(B1, 1, 1); PG8_SCHED; PG8_LDA(At, 1, 0); PG8_STAGE(PG8_SA(0, 1), a2 + hstep, voffA);
            PG8_WAIT_V(8); PG8_WAIT_L(0); PG8_BAR; PG8_MMA(0, 0, At, B0); PG8_MMA(0, 1, At, B1); PG8_BAR; PG8_SCHED;
            PG8_LDA(At, 1, 1); PG8_STAGE(PG8_SB(1, 0), b3, voffB); PG8_STAGE(PG8_SB(1, 1), b3 + hstep, voffB); PG8_STAGE(PG8_SA(1, 0), a3, voffA);
            PG8_WAIT_V(8); PG8_WAIT_L(0); PG8_BAR; PG8_MMA(1, 0, At, B0); PG8_MMA(1, 1, At, B1); PG8_BAR; PG8_SCHED;
            } else {
            PG8_LDB(B0, 0, 0); PG8_SCHED; PG8_LDA(At, 0, 0); PG8_STAGE(PG8_SA(1, 1), a1 + hstep, voffA);
            PG8_WAIT_L(8); PG8_BAR; PG8_WAIT_L(0); PG8_MMA(0, 0, At, B0); PG8_BAR; PG8_SCHED;
            PG8_LDB(B1, 0, 1); PG8_STAGE(PG8_SB(0, 0), b2, voffB);
            PG8_BAR; PG8_WAIT_L(0); PG8_MMA(0, 1, At, B1); PG8_BAR;
            PG8_LDA(At, 0, 1); PG8_STAGE(PG8_SA(0, 0), a2, voffA);
            PG8_BAR; PG8_WAIT_L(0); PG8_MMA(1, 0, At, B0); PG8_BAR; PG8_SCHED;
            PG8_STAGE(PG8_SB(0, 1), b2 + hstep, voffB);
            PG8_WAIT_V(6); PG8_BAR; PG8_MMA(1, 1, At, B1); PG8_BAR;
            PG8_LDB(B0, 1, 0); PG8_SCHED; PG8_LDA(At, 1, 0); PG8_STAGE(PG8_SA(0, 1), a2 + hstep, voffA);
            PG8_WAIT_L(8); PG8_BAR; PG8_WAIT_L(0); PG8_MMA(0, 0, At, B0); PG8_BAR; PG8_SCHED;
            PG8_LDB(B1, 1, 1); PG8_STAGE(PG8_SB(1, 0), b3, voffB);
            PG8_BAR; PG8_WAIT_L(0); PG8_MMA(0, 1, At, B1); PG8_BAR;
            PG8_LDA(At, 1, 1); PG8_STAGE(PG8_SA(1, 0), a3, voffA);
            PG8_BAR; PG8_WAIT_L(0); PG8_MMA(1, 0, At, B0); PG8_BAR; PG8_SCHED;
            PG8_STAGE(PG8_SB(1, 1), b3 + hstep, voffB);
            PG8_WAIT_V(6); PG8_BAR; PG8_MMA(1, 1, At, B1); PG8_BAR;
            }
        }
        if constexpr (ALIGN_EPI) { if (wr == 0) PG8_BAR; }
        if constexpr (!Epi::AFTER_DRAIN) { E(acc, cur, wr, wc, fr, fq); S.done(cur); }
        if (!has_next) break;
#pragma unroll
        for (int a = 0; a < 2; ++a)
#pragma unroll
            for (int b = 0; b < 2; ++b)
#pragma unroll
                for (int m = 0; m < 4; ++m)
#pragma unroll
                    for (int n = 0; n < 2; ++n) acc[a][b][m][n] = (f32x4){0.f, 0.f, 0.f, 0.f};
        cur = nxt; cA = nA; cB = nB; ++ui;
        if constexpr (ALIGN_EPI) { if (wr == 1) PG8_BAR; }
    }
    PG8_WAIT_V(0);
    if constexpr (!ALIGN_EPI) { if (wr == 0) PG8_BAR; }
    PG8_BAR;
    if constexpr (Epi::AFTER_DRAIN) { E.fused(acc, cur, wr, wc, fr, fq, lds, wid, lane); S.done(cur); }
#undef PG8_SA
#undef PG8_SB
#undef PG8_STAGE
#undef PG8_LDA
#undef PG8_LDB
#undef PG8_MMA
#undef PG8_WAIT_V
#undef PG8_WAIT_L
#undef PG8_BAR
#undef PG8_SCHED
}
}
#include <hip/hip_bf16.h>
#include <cmath>
namespace attn_body {
using bf16=__hip_bfloat16;
using bf16x8=__attribute__((ext_vector_type(8)))short;
using s16x4=__attribute__((ext_vector_type(4)))short;
using f32x16=__attribute__((ext_vector_type(16)))float;
using u32x4=__attribute__((ext_vector_type(4)))unsigned;
constexpr int BATCH=8,NHEAD=8,SEQ=8192,D=64,DM=NHEAD*D;
constexpr int NW=8,QBLK=32,QB=QBLK*NW,KVBLK=64,NQB=SEQ/QB;
constexpr int ATTN_PITCH=DM, ATTN_UNIT_ROWS=QB;
__device__ __forceinline__ int crow(int r,int hi){return (r&3)+8*(r>>2)+4*hi;}
#define SBAR() __builtin_amdgcn_sched_barrier(0)
__device__ __forceinline__ void cmask(f32x16&p0,f32x16&p1,int jb,int qrel,int hi){
  const float NEG=-INFINITY; int kb=64*jb+4*hi;
  #pragma unroll
  for(int r=0;r<16;++r){int kv=kb+(r&3)+8*(r>>2); if(kv>qrel)p0[r]=NEG; if(kv+32>qrel)p1[r]=NEG;}
}

constexpr int NSLOT=3, SLOTB=8192;
constexpr int LDS_K=0, LDS_V=NSLOT*SLOTB, LDS_WS=2*NSLOT*SLOTB, LDS_OST=LDS_WS+NW*64*4, LDS_CK=LDS_OST+NW*4096, LDS_T0=LDS_CK+SEQ*4, LDS_BYTES=LDS_T0+64;
constexpr float C2=0.125f*1.4426950408889634f;
__device__ __forceinline__ void glds16(const void*gsrc,unsigned lds_dst){unsigned keep;
  asm volatile("s_mov_b32 %0, m0\n\ts_mov_b32 m0, %2\n\ts_nop 0\n\tglobal_load_lds_dwordx4 %1, off\n\ts_mov_b32 m0, %0":"=&s"(keep):"v"(gsrc),"s"(lds_dst):"memory");}
__device__ __forceinline__ float max3f(float a,float b,float c){float r;asm("v_max3_f32 %0, %1, %2, %3":"=v"(r):"v"(a),"v"(b),"v"(c));return r;}
__device__ __forceinline__ float max2f(float a,float b){float r;asm("v_max_f32_e32 %0, %1, %2":"=v"(r):"v"(a),"v"(b));return r;}
__device__ __forceinline__ float fadd_s(float a,float b){float r;asm("v_add_f32_e32 %0, %1, %2":"=v"(r):"v"(a),"v"(b));return r;}
__device__ __forceinline__ float fsub_s(float a,float b){float r;asm("v_sub_f32_e32 %0, %1, %2":"=v"(r):"v"(a),"v"(b));return r;}
typedef float f32x2_t __attribute__((ext_vector_type(2))); typedef __bf16 bf16x2_t __attribute__((ext_vector_type(2)));
__device__ __forceinline__ unsigned cvtpk_s(float lo,float hi){f32x2_t v={lo,hi};bf16x2_t b=__builtin_convertvector(v,bf16x2_t);return __builtin_bit_cast(unsigned,b);}
#define WAIT_BAR(N) asm volatile("s_waitcnt vmcnt(" #N ") lgkmcnt(0)\n\ts_barrier":::"memory")

__device__ __forceinline__ void qkt(f32x16&p0,f32x16&p1,const char*Kslot,const bf16x8*qr,int r32,int hi){
  const char*kb=Kslot+hi*1024+r32*16;
  #pragma unroll
  for(int d0=0;d0<4;++d0){
    const bf16x8 b0=*reinterpret_cast<const bf16x8*>(kb+d0*2048);
    const bf16x8 b1=*reinterpret_cast<const bf16x8*>(kb+d0*2048+512);
    {p0=__builtin_amdgcn_mfma_f32_32x32x16_bf16(b0,qr[d0],p0,0,0,0);p1=__builtin_amdgcn_mfma_f32_32x32x16_bf16(b1,qr[d0],p1,0,0,0);}}
}
typedef __attribute__((address_space(3))) const char* lds_cptr;
typedef short v4i16_t __attribute__((ext_vector_type(4)));
__device__ __forceinline__ void kload8(bf16x8*kf,lds_cptr kp){
  kf[0]=*(const __attribute__((address_space(3))) bf16x8*)(kp);      kf[1]=*(const __attribute__((address_space(3))) bf16x8*)(kp+512);
  kf[2]=*(const __attribute__((address_space(3))) bf16x8*)(kp+2048); kf[3]=*(const __attribute__((address_space(3))) bf16x8*)(kp+2560);
  kf[4]=*(const __attribute__((address_space(3))) bf16x8*)(kp+4096); kf[5]=*(const __attribute__((address_space(3))) bf16x8*)(kp+4608);
  kf[6]=*(const __attribute__((address_space(3))) bf16x8*)(kp+6144); kf[7]=*(const __attribute__((address_space(3))) bf16x8*)(kp+6656);
}
__device__ __forceinline__ void kload2(bf16x8*kf,lds_cptr kp,int j){ kf[2*j]=*(const __attribute__((address_space(3))) bf16x8*)(kp+j*2048); kf[2*j+1]=*(const __attribute__((address_space(3))) bf16x8*)(kp+j*2048+512); }
__device__ __forceinline__ s16x4 vtr(lds_cptr p){ return __builtin_bit_cast(s16x4,__builtin_amdgcn_ds_read_tr16_b64_v4i16((__attribute__((address_space(3))) v4i16_t*)p)); }
__device__ __forceinline__ float rowmax(const f32x16&p0,const f32x16&p1){
  float a=max3f(p0[0],p0[1],p1[0]),b=max3f(p0[2],p0[3],p1[1]);a=max3f(a,p1[2],p1[3]);
  #pragma unroll
  for(int r=4;r<16;r+=4){a=max3f(a,p0[r],p0[r+1]);b=max3f(b,p0[r+2],p0[r+3]);a=max3f(a,p1[r],p1[r+1]);b=max3f(b,p1[r+2],p1[r+3]);}
  const float m=max2f(a,b);
  auto rr=__builtin_amdgcn_permlane32_swap(__float_as_uint(m),__float_as_uint(m),false,false);
  return max2f(__uint_as_float(rr[0]),__uint_as_float(rr[1]));
}
__device__ __forceinline__ void pv(f32x16*o,int vb,bf16x8 pa0,bf16x8 pa1,bf16x8 pa2,bf16x8 pa3){
  #pragma unroll
  for(int d0=0;d0<2;++d0){s16x4 lo[4],hi[4];
    #pragma unroll
    for(int ks=0;ks<4;++ks){
      asm volatile("ds_read_b64_tr_b16 %0,%1 offset:%c2":"=&v"(lo[ks]):"v"(vb),"i"(d0*4096+ks*1024):"memory");
      asm volatile("ds_read_b64_tr_b16 %0,%1 offset:%c2":"=&v"(hi[ks]):"v"(vb),"i"(d0*4096+ks*1024+512):"memory");}
    asm volatile("s_waitcnt lgkmcnt(0)":::"memory");SBAR();
    #define PK(k) (bf16x8){lo[k][0],lo[k][1],lo[k][2],lo[k][3],hi[k][0],hi[k][1],hi[k][2],hi[k][3]}
    o[d0]=__builtin_amdgcn_mfma_f32_32x32x16_bf16(pa0,PK(0),o[d0],0,0,0);
    o[d0]=__builtin_amdgcn_mfma_f32_32x32x16_bf16(pa1,PK(1),o[d0],0,0,0);
    o[d0]=__builtin_amdgcn_mfma_f32_32x32x16_bf16(pa2,PK(2),o[d0],0,0,0);
    o[d0]=__builtin_amdgcn_mfma_f32_32x32x16_bf16(pa3,PK(3),o[d0],0,0,0);
    #undef PK
  }
}

typedef __attribute__((address_space(3))) const float* lds_fptr;
typedef float f32x4_t __attribute__((ext_vector_type(4)));
__device__ __forceinline__ void biasinit(f32x16&c0,f32x16&c1,lds_fptr ckt,float aq){
  #pragma unroll
  for(int g=0;g<4;++g){ const f32x4_t v=*(const __attribute__((address_space(3))) f32x4_t*)(ckt+8*g); const f32x4_t w=*(const __attribute__((address_space(3))) f32x4_t*)(ckt+32+8*g);
    c0[4*g]=aq-v[0];c0[4*g+1]=aq-v[1];c0[4*g+2]=aq-v[2];c0[4*g+3]=aq-v[3]; c1[4*g]=aq-w[0];c1[4*g+1]=aq-w[1];c1[4*g+2]=aq-w[2];c1[4*g+3]=aq-w[3]; }
}
#ifndef ATTN_STORE16
#define ATTN_STORE16(p,v) (*(u32x4*)(p)=(v))
#endif
template<int THRL> __device__ __forceinline__ void attn_unit(int b,int h,int qb,const bf16*Q,const bf16*__restrict__ K,const bf16*__restrict__ V,bf16*O,char*shm,const float*__restrict__ CKg,const float Tskip){
  int tid_=threadIdx.x; asm volatile("":"+v"(tid_)); const int tid=tid_,lane=tid&63,r32=lane&31,hi=lane>>5; const int wid=__builtin_amdgcn_readfirstlane(tid>>6);
  const long rowbase=(long)b*SEQ; const int q0=qb*QB; const lds_cptr shm3=(lds_cptr)shm;
  const float*ckh=CKg+(long)(b*NHEAD+h)*SEQ; int t0;
  { __attribute__((address_space(3))) int*cw=(__attribute__((address_space(3))) int*)((__attribute__((address_space(3))) char*)shm3+LDS_T0);
    const int ntf=(q0+QB)/KVBLK; bool ok=false; if(tid>=1&&tid<=ntf-4) ok=(ckh[64*tid-1]-ckh[q0])>=Tskip;
    const unsigned long long bm=__ballot(ok); if(lane==0)cw[wid]=__popcll(bm);
    asm volatile("s_waitcnt vmcnt(0) lgkmcnt(0)\n\ts_barrier":::"memory");
    t0=__builtin_amdgcn_readfirstlane((cw[0]+cw[1])&~1); }
  const bf16*Qw=Q+(rowbase+q0+wid*QBLK)*DM+h*D;
  const bf16*Kh=K+(rowbase+64*t0)*DM+h*D,*Vh=V+(rowbase+64*t0)*DM+h*D;
  const unsigned lds0=(unsigned)(uintptr_t)shm;
  float*wsf=(float*)(shm+LDS_WS)+wid*64;
  const bf16*ksrc=Kh+(long)lane*DM+wid*8;
  const bf16*vsrc=Vh+(long)(16*(wid&3)+(lane>>2))*DM+(wid>>2)*32+(lane&3)*8;
  const unsigned kdst=lds0+LDS_K+wid*1024, vdst=lds0+LDS_V+wid*1024;
  #define DMA_K(t,slot) glds16(ksrc+(long)(t)*KVBLK*DM,(unsigned)__builtin_amdgcn_readfirstlane(kdst+(slot)))
  #define DMA_V(t,slot) glds16(vsrc+(long)(t)*KVBLK*DM,(unsigned)__builtin_amdgcn_readfirstlane(vdst+(slot)))
  const int vb0=(int)(lds0+LDS_V)+((lane>>4)&1)*32+(lane&3)*8+(4*hi+((lane&15)>>2))*64;
  const char*Kbase=shm+LDS_K; bf16x8 kf[8];
  const lds_cptr kp0=shm3+LDS_K+hi*1024+r32*16; const lds_cptr vp0=shm3+LDS_V+((lane>>4)&1)*32+(lane&3)*8+(4*hi+((lane&15)>>2))*64;
  const int NT=(q0+QB)/KVBLK-t0;
  { __attribute__((address_space(3))) f32x4_t*ckd=(__attribute__((address_space(3))) f32x4_t*)((__attribute__((address_space(3))) char*)shm3+LDS_CK);
    for(int i=tid;i<(q0+QB-64*t0)/4;i+=NW*64) ckd[i]=*(const f32x4_t*)(ckh+64*t0+4*i);
    asm volatile("s_waitcnt vmcnt(0) lgkmcnt(0)\n\ts_barrier":::"memory"); }
  const lds_fptr ckl=(lds_fptr)(shm3+LDS_CK);
  const float cq=ckl[q0-64*t0+wid*QBLK+r32]; float aq=cq;
  DMA_K(0,0);DMA_V(0,0);DMA_K(1,SLOTB);
  bf16x8 qr[4];
  #pragma unroll
  for(int d0=0;d0<4;++d0)qr[d0]=*reinterpret_cast<const bf16x8*>(&Qw[(long)r32*DM+d0*16+hi*8]);
  float mhat=0.f,l_reg=0.f;f32x16 o[2];o[0]=f32x16{};o[1]=f32x16{};
  const int qrel=wid*QBLK+r32;
  #define CMASK(P0,P1,t) do{int jb_=(t)-(NT-4); if(jb_>=0)cmask(P0,P1,jb_,qrel,hi);}while(0)
  bool resc=false;
  #define START(P0,P1) do{ const float rm=rowmax(P0,P1); resc=false; \
    { const float dl=rm; mhat=fadd_s(mhat,dl); \
      _Pragma("unroll") for(int r=0;r<16;++r){P0[r]=fsub_s(P0[r],dl);P1[r]=fsub_s(P1[r],dl);} \
      aq=cq-mhat; } \
    _Pragma("unroll") for(int r=0;r<16;++r)P0[r]=__builtin_amdgcn_exp2f(P0[r]); }while(0)
  #define RESC() do{ if(resc){ asm volatile("s_waitcnt lgkmcnt(0)":::"memory"); \
      _Pragma("unroll") for(int d_=0;d_<2;++d_) _Pragma("unroll") for(int r=0;r<16;++r)o[d_][r]*=wsf[crow(r,hi)]; } }while(0)
  f32x16 pA0,pA1,pB0,pB1;
  int sl_prev=0,sl_cur=0,sl_next=SLOTB;
  #define ROT() do{sl_prev=sl_cur;sl_cur=sl_next;sl_next=(sl_next==(NSLOT-1)*SLOTB)?0:sl_next+SLOTB;}while(0)
  DMA_K(2,2*SLOTB);
  WAIT_BAR(3);
  biasinit(pA0,pA1,ckl+4*hi,aq); qkt(pA0,pA1,Kbase,qr,r32,hi);asm volatile("s_nop 15\n\ts_nop 7":"+v"(pA0),"+v"(pA1));CMASK(pA0,pA1,0);
  START(pA0,pA1);
  _Pragma("unroll") for(int r=0;r<16;++r)pA1[r]=__builtin_amdgcn_exp2f(pA1[r]);
  WAIT_BAR(0);
  DMA_K(3,0);DMA_V(1,SLOTB);
  ROT();
  kload8(kf,kp0+sl_cur);
  WAIT_BAR(2);
  s16x4 vlo[8],vhi[8]; u32x4 pw0,pw1,pw2,pw3;
  #define PKW(P,B) cvtpk_s(P[B],P[B+1])
  #define PAF(k) __builtin_bit_cast(bf16x8,pw##k)
  #define VFR(i) (bf16x8){vlo[i][0],vlo[i][1],vlo[i][2],vlo[i][3],vhi[i][0],vhi[i][1],vhi[i][2],vhi[i][3]}
  #define PIN(x) asm volatile("":"+v"(x))
  #define MX3(a,b,c) __builtin_fmaxf(__builtin_fmaxf((a),(b)),(c))
  #define GAPA(MF,A0,A1,A2,A3,W0,W1,PW) do{ MF; sacc+=A0; sacc+=A1; sacc+=A2; sacc+=A3; PIN(sacc); W0; W1; PIN(PW); SBAR(); }while(0)
  #define EX(v) __builtin_amdgcn_exp2f(v)
  #define GAPB(MF,X,B) do{ MF; X[B]=EX(X[B]); X[B+1]=EX(X[B+1]); X[B+2]=EX(X[B+2]); X[B+3]=EX(X[B+3]); PIN(X); SBAR(); }while(0)
  #define VRD(i) do{ vlo[i]=vtr(vp_+(((i)>>2)*4096+((i)&3)*1024)); vhi[i]=vtr(vp_+(((i)>>2)*4096+((i)&3)*1024+512)); }while(0)
  #define KRD(G,j) do{ if(G){ kload2(kf,kp0+sl_next,j); SBAR(); } }while(0)
  #define STEP(C0,C1,P0,P1,t,GK,GV,GL) do{ SBAR(); biasinit(C0,C1,ckl+64*(t)+4*hi,aq); SBAR(); \
    const lds_cptr vp_=vp0+sl_prev; \
    VRD(0); SBAR(); float sacc=(P0[0]+P0[1]); \
    GAPA(C0=__builtin_amdgcn_mfma_f32_32x32x16_bf16(kf[0],qr[0],C0,0,0,0), P0[2],P0[3],P0[4],P0[5],     pw0[0]=PKW(P0,0), pw0[1]=PKW(P0,2), pw0); \
    VRD(4); SBAR(); GAPA(C1=__builtin_amdgcn_mfma_f32_32x32x16_bf16(kf[1],qr[0],C1,0,0,0), P0[6],P0[7],P0[8],P0[9],     pw0[2]=PKW(P0,4), pw0[3]=PKW(P0,6), pw0); \
    VRD(1); SBAR(); GAPA(C0=__builtin_amdgcn_mfma_f32_32x32x16_bf16(kf[2],qr[1],C0,0,0,0),   P0[10],P0[11],P0[12],P0[13], pw1[0]=PKW(P0,8), pw1[1]=PKW(P0,10), pw1); \
    VRD(5); SBAR(); GAPA(C1=__builtin_amdgcn_mfma_f32_32x32x16_bf16(kf[3],qr[1],C1,0,0,0),   P0[14],P0[15],P1[0],P1[1],   pw1[2]=PKW(P0,12),pw1[3]=PKW(P0,14), pw1); \
    VRD(2); SBAR(); GAPA(C0=__builtin_amdgcn_mfma_f32_32x32x16_bf16(kf[4],qr[2],C0,0,0,0),   P1[2],P1[3],P1[4],P1[5],     pw2[0]=PKW(P1,0), pw2[1]=PKW(P1,2), pw2); \
    VRD(6); SBAR(); GAPA(C1=__builtin_amdgcn_mfma_f32_32x32x16_bf16(kf[5],qr[2],C1,0,0,0),   P1[6],P1[7],P1[8],P1[9],     pw2[2]=PKW(P1,4), pw2[3]=PKW(P1,6), pw2); \
    VRD(3); SBAR(); GAPA(C0=__builtin_amdgcn_mfma_f32_32x32x16_bf16(kf[6],qr[3],C0,0,0,0),   P1[10],P1[11],P1[12],P1[13], pw3[0]=PKW(P1,8), pw3[1]=PKW(P1,10), pw3); \
    VRD(7); SBAR(); GAPA(C1=__builtin_amdgcn_mfma_f32_32x32x16_bf16(kf[7],qr[3],C1,0,0,0),   P1[14],P1[15],0.f,0.f,       pw3[2]=PKW(P1,12),pw3[3]=PKW(P1,14), pw3); \
    l_reg+=sacc; \
    if(GK){DMA_K((t)+3,sl_cur);} if(GV){DMA_V((t)+1,sl_next);} \
    CMASK(C0,C1,t); \
    { float a=MX3(C0[0],C0[1],C1[0]),b=MX3(C0[2],C0[3],C1[1]); a=MX3(a,C1[2],C1[3]); \
      _Pragma("unroll") for(int r=4;r<16;r+=4){a=MX3(a,C0[r],C0[r+1]);b=MX3(b,C0[r+2],C0[r+3]);a=MX3(a,C1[r],C1[r+1]);b=MX3(b,C1[r+2],C1[r+3]);} \
      float rm=__builtin_fmaxf(a,b); { auto rr=__builtin_amdgcn_permlane32_swap(__float_as_uint(rm),__float_as_uint(rm),false,false); rm=__builtin_fmaxf(__uint_as_float(rr[0]),__uint_as_float(rr[1])); } \
      resc=false; \
      if(__builtin_expect(__any(rm>(float)THRL),0)){ const float dl=__builtin_fmaxf(rm,0.f); mhat+=dl; \
        _Pragma("unroll") for(int r=0;r<16;++r){C0[r]-=dl;C1[r]-=dl;} \
        aq=cq-mhat; \
        const float f=__builtin_amdgcn_exp2f(-dl); l_reg*=f; if(hi==0)wsf[r32]=f; resc=true; } } \
    SBAR(); \
    GAPB(o[0]=__builtin_amdgcn_mfma_f32_32x32x16_bf16(PAF(0),VFR(0),o[0],0,0,0), C0,0); \
    GAPB(o[1]=__builtin_amdgcn_mfma_f32_32x32x16_bf16(PAF(0),VFR(4),o[1],0,0,0), C0,4); \
    KRD(GL,0); GAPB(o[0]=__builtin_amdgcn_mfma_f32_32x32x16_bf16(PAF(1),VFR(1),o[0],0,0,0), C0,8); \
    KRD(GL,1); GAPB(o[1]=__builtin_amdgcn_mfma_f32_32x32x16_bf16(PAF(1),VFR(5),o[1],0,0,0), C0,12); \
    KRD(GL,2); GAPB(o[0]=__builtin_amdgcn_mfma_f32_32x32x16_bf16(PAF(2),VFR(2),o[0],0,0,0), C1,0); \
    KRD(GL,3); GAPB(o[1]=__builtin_amdgcn_mfma_f32_32x32x16_bf16(PAF(2),VFR(6),o[1],0,0,0), C1,4); \
    GAPB(o[0]=__builtin_amdgcn_mfma_f32_32x32x16_bf16(PAF(3),VFR(3),o[0],0,0,0), C1,8); \
    GAPB(o[1]=__builtin_amdgcn_mfma_f32_32x32x16_bf16(PAF(3),VFR(7),o[1],0,0,0), C1,12); \
    }while(0)
  int t=1;
  #undef CMASK
  #define CMASK(P0,P1,t) do{}while(0)
  for(;t+5<NT;t+=2){
    STEP(pB0,pB1,pA0,pA1,t,true,true,true);     WAIT_BAR(2); RESC(); ROT();
    STEP(pA0,pA1,pB0,pB1,t+1,true,true,true);   WAIT_BAR(2); RESC(); ROT();
  }
  #undef CMASK
  #define CMASK(P0,P1,t) do{int jb_=(t)-(NT-4); if(jb_>=0)cmask(P0,P1,jb_,qrel,hi);}while(0)
  #define ENDW(tt) do{ if((tt)+3<NT){WAIT_BAR(2);} else if((tt)+2<NT){WAIT_BAR(1);} else {WAIT_BAR(0);} }while(0)
  for(;t+1<NT;t+=2){
    STEP(pB0,pB1,pA0,pA1,t,(t+3<NT),(t+1<NT),(t+1<NT));       ENDW(t);   RESC(); ROT();
    STEP(pA0,pA1,pB0,pB1,t+1,(t+4<NT),(t+2<NT),(t+2<NT));     ENDW(t+1); RESC(); ROT();
  }
  STEP(pB0,pB1,pA0,pA1,NT-1,false,false,false); RESC();
  { float sacc=pB0[0]+pB0[1]; _Pragma("unroll") for(int r=2;r<16;++r)sacc+=pB0[r]; _Pragma("unroll") for(int r=0;r<16;++r)sacc+=pB1[r]; l_reg+=sacc;
    pw0=(u32x4){PKW(pB0,0),PKW(pB0,2),PKW(pB0,4),PKW(pB0,6)};pw1=(u32x4){PKW(pB0,8),PKW(pB0,10),PKW(pB0,12),PKW(pB0,14)};pw2=(u32x4){PKW(pB1,0),PKW(pB1,2),PKW(pB1,4),PKW(pB1,6)};pw3=(u32x4){PKW(pB1,8),PKW(pB1,10),PKW(pB1,12),PKW(pB1,14)};
    SBAR(); pv(o,vb0+sl_cur,PAF(0),PAF(1),PAF(2),PAF(3)); }
  #undef PKW
  #undef PAF
  #undef VFR
  #undef PIN
  #undef MX3
  #undef GAPA
  #undef GAPB
  #undef EX
  #undef VRD
  #undef KRD
  #undef STEP
  #undef ENDW
  {auto rr=__builtin_amdgcn_permlane32_swap(__float_as_uint(l_reg),__float_as_uint(l_reg),false,false);l_reg=__uint_as_float(rr[0])+__uint_as_float(rr[1]);}
  if(hi==0)wsf[32+r32]=l_reg;asm volatile("s_waitcnt lgkmcnt(0)":::"memory");
  float rli[16];
  #pragma unroll
  for(int r=0;r<16;++r)rli[r]=__builtin_amdgcn_rcpf(wsf[32+crow(r,hi)]);
  bf16*Ow=O+(rowbase+q0+wid*QBLK)*DM+h*D;
  { bf16*stg=(bf16*)(shm+LDS_OST)+wid*2048;
    #pragma unroll
    for(int r=0;r<16;++r){const int orow=crow(r,hi);
      #pragma unroll
      for(int d0=0;d0<2;++d0)stg[orow*64+d0*32+r32]=__float2bfloat16(o[d0][r]*rli[r]);}
    asm volatile("s_waitcnt lgkmcnt(0)":::"memory");
    #pragma unroll
    for(int i=0;i<4;++i){const int row=i*8+(lane>>3),ch=lane&7; const u32x4 v=*(const u32x4*)(stg+row*64+ch*8); ATTN_STORE16(Ow+(long)row*DM+ch*8,v);} }
  asm volatile("s_waitcnt lgkmcnt(0)\n\ts_barrier":::"memory");
  #undef DMA_K
  #undef DMA_V
  #undef CMASK
  #undef START
  #undef RESC
  #undef ROT
}
constexpr int ATTN_LDS_BYTES=LDS_BYTES;
struct AttnTensors { const bf16* Q; const bf16* K; const bf16* V; bf16* O; const float* CK; const float* NRM; };
struct AttnUnit { int bh; int qb; };
struct StaticOrder {
  int vcu;
  __device__ __forceinline__ explicit StaticOrder(int grid,int block):vcu((block%8)*(grid/8)+block/8){}
  __device__ __forceinline__ bool next(int i,AttnUnit&u)const{ if(i>=8)return false; const int s=vcu&7,j=i&3; u.bh=(vcu>>3)+32*(i>>2); u.qb=(j==0)?s:(j==1)?15-s:(j==2)?16+s:31-s; return true; }
  __device__ __forceinline__ void a_ready(const AttnUnit&)const{}
  __device__ __forceinline__ void done(const AttnUnit&)const{}
};
struct DynOrder {
  unsigned*ctr; volatile __attribute__((address_space(3))) unsigned*slot; int x;
  __device__ __forceinline__ bool next(int,AttnUnit&u)const{
    if(threadIdx.x==0)*slot=atomicAdd(ctr+64*x,1u);
    __syncthreads(); const unsigned n=*slot; __syncthreads();
    if(n>=256u)return false; const int j=n&7; u.bh=j*8+((x-j)&7); u.qb=31-(int)(n>>3); return true; }
  __device__ __forceinline__ void a_ready(const AttnUnit&)const{}
  __device__ __forceinline__ void done(const AttnUnit&)const{}
};
template<class Sched,int THRL=8> __device__ __forceinline__ void attn_phase(char*lds,const AttnTensors&T,const Sched&S){
  AttnUnit u;
  for(int i=0;S.next(i,u);++i){ S.a_ready(u); { const float*nr=T.NRM+u.bh*4; const float tsk=152.f+2.002f*sqrtf((nr[0]+nr[1])*(nr[2]+nr[3])); attn_unit<THRL>(u.bh/NHEAD,u.bh%NHEAD,u.qb,T.Q,T.K,T.V,T.O,lds,T.CK,tsk); } S.done(u); }
}
#undef SBAR
#undef WAIT_BAR
}
namespace cg = cooperative_groups;
#define LAS __attribute__((address_space(3)))
typedef unsigned v4u __attribute__((ext_vector_type(4)));
typedef unsigned v2u __attribute__((ext_vector_type(2)));
typedef float f32x4 __attribute__((ext_vector_type(4)));
using pg8::bf16_t;
constexpr int NWAVES = 8, SEQ = 8192, DM = 1024, NB = 8, DFF = 2816, NIN = 5128;
constexpr float LN_EPS = 1e-5f, LOG2E_F = 1.4426950408889634f;
constexpr size_t MiB = 1u << 20;
constexpr size_t WS_MOD = 0, WS_WFT = 512 * 1024, WS_NRM = 768 * 1024, WS_CTR = 772 * 1024, WS_LF = 1 * MiB, WS_CK = 3 * MiB;
constexpr size_t WS_WIN = 6 * MiB, WS_WFS = 16 * MiB, WS_WO = 18 * MiB, WS_WUP = 20 * MiB, WS_WDN = 31 * MiB;
constexpr size_t WS_U = 40 * MiB;
constexpr size_t WS_QKV = 168 * MiB;
constexpr size_t WS_MERGED = WS_QKV + 128 * MiB;
constexpr size_t WS_ACT = WS_QKV;
constexpr size_t WS_G = 552 * MiB;
constexpr size_t WS_H1 = WS_G;
constexpr size_t WS_END = 808 * MiB;
constexpr int RING_BYTES = 131072, XCH_OFF = RING_BYTES, MISC_OFF = XCH_OFF + 8192, LDS_BYTES = 147456;

#define LDS_WAIT() asm volatile("s_waitcnt lgkmcnt(0)" ::: "memory")
__device__ __forceinline__ unsigned f2bf(float f) { unsigned u = __builtin_bit_cast(unsigned, f); return (u + 0x7fffu + ((u >> 16) & 1u)) >> 16; }
__device__ __forceinline__ unsigned pk2(float lo, float hi) { return f2bf(lo) | (f2bf(hi) << 16); }
__device__ __forceinline__ float wave_sum(float v) {
#pragma unroll
    for (int o = 1; o < 64; o <<= 1) v += __shfl_xor(v, o);
    return v;
}
__device__ __forceinline__ void tr_item(const float* W, int ldw, int srcc0, int k0, bf16_t* WT, int ldk, int dstr0, LAS float* scr, int lane) {
#pragma unroll 8
    for (int i = 0; i < 32; ++i) { const int kk = 2 * i + (lane >> 5); scr[kk * 33 + (lane & 31)] = W[(size_t)(k0 + kk) * ldw + srcc0 + (lane & 31)]; }
    LDS_WAIT();
    const int c = lane & 7;
#pragma unroll
    for (int j = 0; j < 4; ++j) { const int n = (lane >> 3) + 8 * j; const LAS float* s = scr + (8 * c) * 33 + n;
        v4u o; o.x = pk2(s[0 * 33], s[1 * 33]); o.y = pk2(s[2 * 33], s[3 * 33]); o.z = pk2(s[4 * 33], s[5 * 33]); o.w = pk2(s[6 * 33], s[7 * 33]);
        *(v4u*)(WT + (size_t)(dstr0 + n) * ldk + k0 + 8 * c) = o; }
    LDS_WAIT();
}

typedef short s16x8 __attribute__((ext_vector_type(8)));
typedef float f32x16 __attribute__((ext_vector_type(16)));
__device__ __forceinline__ int crow16(int r, int hi) { return (r & 3) + 8 * (r >> 2) + 4 * hi; }
__device__ __forceinline__ void sb_unit(int b, int h, int qblk, const bf16_t* Q, const bf16_t* __restrict__ K, const bf16_t* __restrict__ V, bf16_t* O, LAS unsigned char* vst, int lane_) {
    int lane = lane_; asm volatile("" : "+v"(lane));
    const int r32 = lane & 31, hi = lane >> 5; const size_t rowbase = (size_t)b * SEQ; const int qw0 = qblk * 32, q = qw0 + r32;
    const bf16_t* Qw = Q + (rowbase + qw0) * 512 + h * 64;
    s16x8 qr[4];
#pragma unroll
    for (int d0 = 0; d0 < 4; ++d0) qr[d0] = *(const s16x8*)(Qw + (size_t)r32 * 512 + d0 * 16 + hi * 8);
    f32x16 o0 = {}, o1 = {}; float R = 0.f;
    s16x8 kn[4]; v4u vn[4];
    { const bf16_t* Kp = K + (rowbase + qblk * 32 + r32) * 512 + h * 64 + hi * 8;
#pragma unroll
      for (int d0 = 0; d0 < 4; ++d0) kn[d0] = *(const s16x8*)(Kp + d0 * 16);
#pragma unroll
      for (int i = 0; i < 4; ++i) { const int c = lane + 64 * i; vn[i] = *(const v4u*)(V + (rowbase + qblk * 32 + (c >> 3)) * 512 + h * 64 + (c & 7) * 8); } }
    for (int jt = qblk; jt >= 0; --jt) {
        const int k0 = jt * 32;
        s16x8 kf[4];
#pragma unroll
        for (int d0 = 0; d0 < 4; ++d0) kf[d0] = kn[d0];
#pragma unroll
        for (int i = 0; i < 4; ++i) { const int c = lane + 64 * i, key = c >> 3, part = c & 7; *(LAS v4u*)(vst + key * 144 + part * 16) = vn[i]; }
        if (jt > 0) { const bf16_t* Kp = K + (rowbase + k0 - 32 + r32) * 512 + h * 64 + hi * 8;
#pragma unroll
            for (int d0 = 0; d0 < 4; ++d0) kn[d0] = *(const s16x8*)(Kp + d0 * 16);
#pragma unroll
            for (int i = 0; i < 4; ++i) { const int c = lane + 64 * i; vn[i] = *(const v4u*)(V + (rowbase + k0 - 32 + (c >> 3)) * 512 + h * 64 + (c & 7) * 8); } }
        f32x16 s = {};
#pragma unroll
        for (int d0 = 0; d0 < 4; ++d0) s = __builtin_amdgcn_mfma_f32_32x32x16_bf16(kf[d0], qr[d0], s, 0, 0, 0);
        float Lv[16], lb[16], sfx[16], own[4], oth[4], sufg[4];
#pragma unroll
        for (int r = 0; r < 16; ++r) { const bool valid = (k0 + crow16(r, hi)) < q; const float zz = __builtin_fminf(s[r], 100.f);
            const float l = __builtin_amdgcn_logf(1.0f + __builtin_amdgcn_exp2f(zz)); Lv[r] = valid ? l : 0.f; lb[r] = valid ? (zz - l) : -1e30f; }
#pragma unroll
        for (int i = 0; i < 4; ++i) { const float a3 = Lv[4 * i + 3], a2 = a3 + Lv[4 * i + 2], a1 = a2 + Lv[4 * i + 1]; own[i] = a1 + Lv[4 * i];
            sfx[4 * i + 3] = 0.f; sfx[4 * i + 2] = a3; sfx[4 * i + 1] = a2; sfx[4 * i] = a1; }
#pragma unroll
        for (int i = 0; i < 4; ++i) oth[i] = __shfl_xor(own[i], 32);
        float accs = 0.f;
#pragma unroll
        for (int i = 3; i >= 0; --i) { sufg[i] = accs + (hi == 0 ? oth[i] : 0.f); accs += own[i] + oth[i]; }
        float av[16];
#pragma unroll
        for (int r = 0; r < 16; ++r) av[r] = __builtin_amdgcn_exp2f(lb[r] - (R + sufg[r >> 2] + sfx[r]));
        R += accs;
        v4u pa0, pa1;
        pa0.x = pg8::cvt_pk_bf16(av[0], av[1]); pa0.y = pg8::cvt_pk_bf16(av[2], av[3]); pa0.z = pg8::cvt_pk_bf16(av[4], av[5]); pa0.w = pg8::cvt_pk_bf16(av[6], av[7]);
        pa1.x = pg8::cvt_pk_bf16(av[8], av[9]); pa1.y = pg8::cvt_pk_bf16(av[10], av[11]); pa1.z = pg8::cvt_pk_bf16(av[12], av[13]); pa1.w = pg8::cvt_pk_bf16(av[14], av[15]);
        LDS_WAIT();
#pragma unroll
        for (int ks = 0; ks < 2; ++ks)
#pragma unroll
            for (int d0 = 0; d0 < 2; ++d0) { unsigned short e[8];
#pragma unroll
                for (int j = 0; j < 8; ++j) e[j] = *(const LAS unsigned short*)(vst + (16 * ks + 8 * (j >> 2) + 4 * hi + (j & 3)) * 144 + (32 * d0 + r32) * 2);
                v4u vb; vb.x = e[0] | ((unsigned)e[1] << 16); vb.y = e[2] | ((unsigned)e[3] << 16); vb.z = e[4] | ((unsigned)e[5] << 16); vb.w = e[6] | ((unsigned)e[7] << 16);
                const s16x8 pa = __builtin_bit_cast(s16x8, ks == 0 ? pa0 : pa1), vf = __builtin_bit_cast(s16x8, vb);
                if (d0 == 0) o0 = __builtin_amdgcn_mfma_f32_32x32x16_bf16(pa, vf, o0, 0, 0, 0); else o1 = __builtin_amdgcn_mfma_f32_32x32x16_bf16(pa, vf, o1, 0, 0, 0); }
        LDS_WAIT();
        if (__all(R >= 160.f)) break;
    }
    bf16_t* Ow = O + (rowbase + qw0) * 512 + h * 64;
#pragma unroll
    for (int r = 0; r < 16; ++r) { const int orow = crow16(r, hi);
        Ow[(size_t)orow * 512 + r32] = (bf16_t)f2bf(o0[r]); Ow[(size_t)orow * 512 + 32 + r32] = (bf16_t)f2bf(o1[r]); }
}

struct Args { const float* in[17]; float* out; unsigned char* ws; };

struct MergeOrder {
    pg8::StaticOrder base;
    __device__ bool next(int i, pg8::Unit& u) const { pg8::Unit t; if (!base.next(i >> 1, t)) return false; const int grp = i & 1; u.pm = t.pm + 256 * grp; u.pn = t.pn + 4 * grp; return true; }
    __device__ __forceinline__ void a_ready(const pg8::Unit&) const {}
    __device__ __forceinline__ void done(const pg8::Unit&) const {}
};

__global__ void __launch_bounds__(NWAVES * 64, 2) fwd_mega(Args args) {
    extern __shared__ __attribute__((aligned(16))) unsigned char lds[];
    cg::grid_group grid = cg::this_grid();
    LAS unsigned char* L = (LAS unsigned char*)lds;
    const int tid = threadIdx.x, lane = tid & 63, wave = __builtin_amdgcn_readfirstlane(tid >> 6);
    const int G = gridDim.x, gw = blockIdx.x * NWAVES + wave, NGW = G * NWAVES;
    unsigned char* ws = args.ws;
    const float* x = args.in[0]; const float* cvec = args.in[1]; const float* w_ada = args.in[2]; const float* b_ada = args.in[3]; const float* w_in = args.in[4];
    const float* b_forget = args.in[5]; const float* w_fox = args.in[6]; const float* w_sb = args.in[7]; const float* w_o = args.in[8];
    const float* ln1_g = args.in[9]; const float* ln1_b = args.in[10]; const float* w_up = args.in[11]; const float* conv_w = args.in[12]; const float* conv_b = args.in[13];
    const float* w_dn = args.in[14]; const float* ln2_g = args.in[15]; const float* ln2_b = args.in[16];
    float* MOD = (float*)(ws + WS_MOD); float* WFT = (float*)(ws + WS_WFT); float* LF = (float*)(ws + WS_LF); float* CK = (float*)(ws + WS_CK);
    bf16_t* WIN = (bf16_t*)(ws + WS_WIN); bf16_t* WFS = (bf16_t*)(ws + WS_WFS); bf16_t* WO = (bf16_t*)(ws + WS_WO); bf16_t* WUP = (bf16_t*)(ws + WS_WUP); bf16_t* WDN = (bf16_t*)(ws + WS_WDN);
    bf16_t* U = (bf16_t*)(ws + WS_U); bf16_t* QKV = (bf16_t*)(ws + WS_QKV); bf16_t* MERGED = (bf16_t*)(ws + WS_MERGED); bf16_t* ACT = (bf16_t*)(ws + WS_ACT);
    bf16_t* GATES = (bf16_t*)(ws + WS_G); float* H1 = (float*)(ws + WS_H1);
    const size_t SLOT = (size_t)MTOK * 512;
    bf16_t* QA = QKV; bf16_t* QB = QKV + SLOT; bf16_t* KA = QKV + 2 * SLOT; bf16_t* VA = QKV + 3 * SLOT; bf16_t* KB = QKV + 4 * SLOT; bf16_t* VB = QKV + 5 * SLOT;

#if !defined(SKIP_P0)
    {
        LAS float* scr = (LAS float*)(L + wave * 16384);
        constexpr int I_IN = 16 * 160, I_FS = 8 * 32, I_O = 16 * 32, I_UP = 16 * 176, I_DN = 44 * 32, I_MOD = 768;
        constexpr int NIT = I_MOD + I_IN + 2 * I_FS + I_O + I_UP + I_DN;
        for (int it = gw; it < NIT; it += NGW) {
            int r = it;
            if (r < I_MOD) {
                const int j0 = 8 * r; float a[8][8];
#pragma unroll
                for (int bb = 0; bb < 8; ++bb)
#pragma unroll
                    for (int j = 0; j < 8; ++j) a[bb][j] = 0.f;
#pragma unroll 4
                for (int i = 0; i < 16; ++i) { const int k = lane + 64 * i; const f32x4 w0 = *(const f32x4*)(w_ada + (size_t)k * 6144 + j0), w1 = *(const f32x4*)(w_ada + (size_t)k * 6144 + j0 + 4);
#pragma unroll
                    for (int bb = 0; bb < 8; ++bb) { const float cb = cvec[bb * 1024 + k];
                        a[bb][0] += cb * w0[0]; a[bb][1] += cb * w0[1]; a[bb][2] += cb * w0[2]; a[bb][3] += cb * w0[3]; a[bb][4] += cb * w1[0]; a[bb][5] += cb * w1[1]; a[bb][6] += cb * w1[2]; a[bb][7] += cb * w1[3]; } }
                float mine = 0.f;
#pragma unroll
                for (int bb = 0; bb < 8; ++bb)
#pragma unroll
                    for (int j = 0; j < 8; ++j) { const float s = wave_sum(a[bb][j]); if (lane == bb * 8 + j) mine = s; }
                MOD[(lane >> 3) * 6144 + j0 + (lane & 7)] = mine + b_ada[j0 + (lane & 7)];
                continue;
            }
            r -= I_MOD;
            if (r < I_IN) { const int kb = r / 160, nb = r % 160, n0 = 32 * nb; tr_item(w_in, NIN, n0 + (n0 >= 1536 ? 8 : 0), 64 * kb, WIN, 1024, n0, scr, lane); continue; } r -= I_IN;
            if (r < I_FS) { const int kb = r / 32, nb = r % 32; tr_item(w_fox, 1024, 32 * nb, 64 * kb, WFS, 512, 32 * nb, scr, lane); continue; } r -= I_FS;
            if (r < I_FS) { const int kb = r / 32, nb = r % 32; tr_item(w_sb, 1024, 32 * nb, 64 * kb, WFS, 512, 1024 + 32 * nb, scr, lane); continue; } r -= I_FS;
            if (r < I_O) { const int kb = r / 32, nb = r % 32; tr_item(w_o, 1024, 32 * nb, 64 * kb, WO, 1024, 32 * nb, scr, lane); continue; } r -= I_O;
            if (r < I_UP) { const int kb = r / 176, nb = r % 176, nn0 = 32 * nb; const int src = ((nn0 >> 7) & 1) * DFF + 128 * (nn0 >> 8) + (nn0 & 127);
                tr_item(w_up, 2 * DFF, src, 64 * kb, WUP, 1024, nn0, scr, lane); continue; } r -= I_UP;
            { const int kb = r / 32, nb = r % 32; tr_item(w_dn, 1024, 32 * nb, 64 * kb, WDN, DFF, 32 * nb, scr, lane); }
        }
        if (blockIdx.x == 0) { ((float*)(ws + WS_NRM))[tid & 255] = 0.f; ((unsigned*)(ws + WS_CTR))[tid] = 0u; }
        for (int e = blockIdx.x * (NWAVES * 64) + tid; e < 8192; e += G * NWAVES * 64) WFT[e] = w_in[(size_t)(e & 1023) * NIN + 1536 + (e >> 10)];
    }
#endif
    grid.sync();

#if !defined(SKIP_P1)
    for (int blk = gw; blk < MTOK / 32; blk += NGW) {
        const int m0 = blk * 32, b = m0 >> 13; const float* mb = MOD + (size_t)b * 6144;
        f32x4 wf[8][4];
#pragma unroll
        for (int hh = 0; hh < 8; ++hh)
#pragma unroll
            for (int j = 0; j < 4; ++j) wf[hh][j] = *(const f32x4*)(WFT + hh * 1024 + 4 * lane + 256 * j);
        const float bf = b_forget[lane & 7];
        for (int r = 0; r < 32; ++r) {
            const int m = m0 + r; const f32x4* xr = (const f32x4*)(x + (size_t)m * 1024) + lane; unsigned long long* o8 = (unsigned long long*)(U + (size_t)m * 1024) + lane;
            f32x4 u[4];
#pragma unroll
            for (int j = 0; j < 4; ++j) { const f32x4 shj = *(const f32x4*)(mb + 4 * lane + 256 * j), scj = *(const f32x4*)(mb + 1024 + 4 * lane + 256 * j) + 1.0f; u[j] = xr[64 * j] * scj + shj; o8[64 * j] = (unsigned long long)pk2(u[j][0], u[j][1]) | ((unsigned long long)pk2(u[j][2], u[j][3]) << 32); }
            float mine = 0.f;
#pragma unroll
            for (int hh = 0; hh < 8; ++hh) { float s = 0.f;
#pragma unroll
                for (int j = 0; j < 4; ++j) { const f32x4 p = u[j] * wf[hh][j]; s += (p[0] + p[1]) + (p[2] + p[3]); }
                s = wave_sum(s); if ((lane & 7) == hh) mine = s; }
            if (lane < 8) { const float f = mine + bf; const float ls = (f >= 0.f) ? -log1pf(expf(-f)) : (f - log1pf(expf(f)));
                LF[((size_t)(b * 8 + lane)) * SEQ + (m & (SEQ - 1))] = ls * LOG2E_F; }
        }
    }
#endif
    grid.sync();

#if !defined(SKIP_P2)
    if (blockIdx.x < 64) {
        LAS double* sm = (LAS double*)(L + MISC_OFF);
        const float* src = LF + (size_t)blockIdx.x * SEQ + 16 * tid; float* dst = CK + (size_t)blockIdx.x * SEQ + 16 * tid;
        f32x4 v[4]; double loc[16]; double run = 0.0;
#pragma unroll
        for (int j = 0; j < 4; ++j) v[j] = *(const f32x4*)(src + 4 * j);
#pragma unroll
        for (int i = 0; i < 16; ++i) { run += (double)v[i >> 2][i & 3]; loc[i] = run; }
        double inc = run;
#pragma unroll
        for (int o = 1; o < 64; o <<= 1) { const double t = __shfl_up(inc, o); if (lane >= o) inc += t; }
        if (lane == 63) sm[wave] = inc;
        __syncthreads();
        double woff = 0.0;
        for (int w = 0; w < wave; ++w) woff += sm[w];
        const double excl = woff + inc - run;
#pragma unroll
        for (int j = 0; j < 4; ++j) *(f32x4*)(dst + 4 * j) = (f32x4){(float)(excl + loc[4 * j]), (float)(excl + loc[4 * j + 1]), (float)(excl + loc[4 * j + 2]), (float)(excl + loc[4 * j + 3])};
        __syncthreads();
    }
    {
        pg8::Gemm g{U, WIN, MTOK, 5120, 1024, (size_t)256 * 1024 * 2}; pg8::StaticOrder S; S.init(MTOK, 5120, G, (int)blockIdx.x);
        pg8::EpiInProj E{QKV, GATES, (unsigned*)(ws + WS_NRM)};
        pg8::gemm_phase<pg8::EpiInProj, pg8::StaticOrder, true, true>(L, g, S, E);
    }
#endif
    grid.sync();

#if !defined(SKIP_P3)
    {
        LAS unsigned char* vst = L + wave * 4608;
        for (int i = 0; i < (64 * 256) / NGW + 1; ++i) { const int uid = i * NGW + gw; if (uid >= 64 * 256) break; const int bh = uid >> 8, qblk = uid & 255;
            sb_unit(bh >> 3, bh & 7, qblk, QB, KB, VB, QB, vst, lane); }
        __syncthreads();
        const attn_body::AttnTensors AT{(const attn_body::bf16*)QA, (const attn_body::bf16*)KA, (const attn_body::bf16*)VA, (attn_body::bf16*)QA, CK, (const float*)(ws + WS_NRM)};
        const attn_body::DynOrder S{(unsigned*)(ws + WS_CTR), (volatile LAS unsigned*)(L + MISC_OFF + 128), (int)(blockIdx.x & 7)};
        attn_body::attn_phase<attn_body::DynOrder>((char*)lds, AT, S);
    }
#endif
    grid.sync();

#if !defined(SKIP_P4)
    {
        pg8::Gemm g{QA, WFS, 2 * MTOK, 2048, 512, (size_t)256 * 512 * 2}; MergeOrder S; S.base.init(MTOK, 1024, G, (int)blockIdx.x);
        pg8::EpiMerge E{GATES, args.out, MERGED};
        pg8::gemm_phase<pg8::EpiMerge, MergeOrder, true, true>(L, g, S, E);
    }
#endif
    grid.sync();

#if !defined(SKIP_P5)
    {
        pg8::Gemm g{MERGED, WO, MTOK, 1024, 1024, (size_t)256 * 1024 * 2}; pg8::StaticOrder S; S.init(MTOK, 1024, G, (int)blockIdx.x);
        pg8::EpiRes E{x, MOD + 2048, H1};
        pg8::gemm_phase<pg8::EpiRes, pg8::StaticOrder, true, true>(L, g, S, E);
    }
#endif
    grid.sync();

#if !defined(SKIP_P6)
    for (int blk = gw; blk < MTOK / 32; blk += NGW) {
        const int m0 = blk * 32, b = m0 >> 13; const float* mb = MOD + (size_t)b * 6144;
        f32x4 sc[4], sh[4], lg[4], lb[4];
#pragma unroll
        for (int j = 0; j < 4; ++j) { sh[j] = *(const f32x4*)(mb + 3072 + 4 * lane + 256 * j); sc[j] = *(const f32x4*)(mb + 4096 + 4 * lane + 256 * j) + 1.0f;
            lg[j] = *(const f32x4*)(ln1_g + 4 * lane + 256 * j); lb[j] = *(const f32x4*)(ln1_b + 4 * lane + 256 * j); }
        for (int r = 0; r < 32; ++r) {
            const int m = m0 + r; f32x4* hr = (f32x4*)(H1 + (size_t)m * 1024) + lane; unsigned long long* o8 = (unsigned long long*)(U + (size_t)m * 1024) + lane;
            f32x4 v[4]; float s = 0.f;
#pragma unroll
            for (int j = 0; j < 4; ++j) { v[j] = hr[64 * j]; s += (v[j][0] + v[j][1]) + (v[j][2] + v[j][3]); }
            const float mean = wave_sum(s) * (1.f / 1024.f); float s2 = 0.f;
#pragma unroll
            for (int j = 0; j < 4; ++j) { v[j] = v[j] - mean; s2 += (v[j][0] * v[j][0] + v[j][1] * v[j][1]) + (v[j][2] * v[j][2] + v[j][3] * v[j][3]); }
            const float rstd = 1.f / sqrtf(wave_sum(s2) * (1.f / 1024.f) + LN_EPS);
#pragma unroll
            for (int j = 0; j < 4; ++j) { const f32x4 x1 = v[j] * rstd * lg[j] + lb[j]; hr[64 * j] = x1; const f32x4 u2 = x1 * sc[j] + sh[j];
                o8[64 * j] = (unsigned long long)pk2(u2[0], u2[1]) | ((unsigned long long)pk2(u2[2], u2[3]) << 32); }
        }
    }
#endif
    grid.sync();

#if !defined(SKIP_P7)
    {
        pg8::Gemm g{U - 2 * 1024, WUP, MTOK, 2 * DFF, 1024, (size_t)254 * 1024 * 2}; pg8::StaticOrder S; S.init_tiles(259, 22, G, (int)blockIdx.x);
        pg8::EpiUpConv E{conv_w, conv_b, ACT, (LAS f32x4*)(L + XCH_OFF)};
        pg8::gemm_phase<pg8::EpiUpConv, pg8::StaticOrder, true, true>(L, g, S, E);
    }
#endif
    grid.sync();

#if !defined(SKIP_P8)
    {
        pg8::Gemm g{ACT, WDN, MTOK, 1024, DFF, (size_t)256 * DFF * 2}; pg8::StaticOrder S; S.init(MTOK, 1024, G, (int)blockIdx.x);
        pg8::EpiRes E{H1, MOD + 5120, args.out};
        pg8::gemm_phase<pg8::EpiRes, pg8::StaticOrder, true, true>(L, g, S, E);
    }
#endif
    grid.sync();

#if !defined(SKIP_P9)
    {
        f32x4 lg[4], lb[4];
#pragma unroll
        for (int j = 0; j < 4; ++j) { lg[j] = *(const f32x4*)(ln2_g + 4 * lane + 256 * j); lb[j] = *(const f32x4*)(ln2_b + 4 * lane + 256 * j); }
        for (int m = gw; m < MTOK; m += NGW) {
            f32x4* hr = (f32x4*)(args.out + (size_t)m * 1024) + lane; f32x4 v[4]; float s = 0.f;
#pragma unroll
            for (int j = 0; j < 4; ++j) { v[j] = hr[64 * j]; s += (v[j][0] + v[j][1]) + (v[j][2] + v[j][3]); }
            const float mean = wave_sum(s) * (1.f / 1024.f); float s2 = 0.f;
#pragma unroll
            for (int j = 0; j < 4; ++j) { v[j] = v[j] - mean; s2 += (v[j][0] * v[j][0] + v[j][1] * v[j][1]) + (v[j][2] * v[j][2] + v[j][3] * v[j][3]); }
            const float rstd = 1.f / sqrtf(wave_sum(s2) * (1.f / 1024.f) + LN_EPS);
#pragma unroll
            for (int j = 0; j < 4; ++j) hr[64 * j] = v[j] * rstd * lg[j] + lb[j];
        }
    }
#endif
}

extern "C" void kernel_launch(void* const* d_in, const int* in_sizes, int n_in, void* d_out, int out_size, void* d_ws, size_t ws_size, hipStream_t stream) {
    static int grid = 0;
    if (grid == 0) {
        if (n_in != 17 || out_size != MTOK * 1024 || ws_size < WS_END) { fprintf(stderr, "kernel_launch: unexpected shapes (n_in %d out %d ws %zu)\n", n_in, out_size, ws_size); grid = -1; return; }
        int dev = 0, cus = 0, per_cu = 0;
        hipGetDevice(&dev); hipDeviceGetAttribute(&cus, hipDeviceAttributeMultiprocessorCount, dev);
        if (hipFuncSetAttribute((const void*)fwd_mega, hipFuncAttributeMaxDynamicSharedMemorySize, LDS_BYTES) != hipSuccess) { fprintf(stderr, "kernel_launch: hipFuncSetAttribute failed\n"); grid = -1; return; }
        hipOccupancyMaxActiveBlocksPerMultiprocessor(&per_cu, (const void*)fwd_mega, NWAVES * 64, LDS_BYTES);
        (void)hipGetLastError();
        if (per_cu < 1) per_cu = 1;
        grid = cus * 1;
    }
    if (grid < 0) return;
    Args a{};
    for (int i = 0; i < 17; ++i) a.in[i] = (const float*)d_in[i];
    a.out = (float*)d_out; a.ws = (unsigned char*)d_ws;
    void* kargs[] = {&a};
    hipError_t e = hipLaunchCooperativeKernel((const void*)fwd_mega, dim3(grid), dim3(NWAVES * 64), kargs, LDS_BYTES, stream);
    if (e != hipSuccess) fprintf(stderr, "cooperative launch failed: %s (grid %d)\n", hipGetErrorString(e), grid);
}
```

```cpp
#include <hip/hip_runtime.h>
#include <hip/hip_cooperative_groups.h>
#include <cstdio>
#include <cstdint>
constexpr int MTOK = 65536;
constexpr float DN_ALPHA = 1.189207115002721f;
#ifndef SKIP_LOG2
#define SKIP_LOG2 68.0f
#endif
namespace pg8 {
#define PG8_LAS __attribute__((address_space(3)))
typedef unsigned short bf16_t;
typedef short bf16x8 __attribute__((ext_vector_type(8)));
typedef float f32x4 __attribute__((ext_vector_type(4)));
typedef unsigned u32x4 __attribute__((ext_vector_type(4)));
constexpr int BM = 256, BK = 64, HALF = 128, HTB = HALF * BK * 2  , STAGE_BYTES = 8 * HTB, NXCD = 8, WGM = 8;

__host__ __device__ __forceinline__ int lds_byte(int r, int c) { const int st = (r >> 4) * 2 + (c >> 5), rr = r & 15, cc = c & 31, ob = rr * 64 + cc * 2; return st * 1024 + (ob ^ (((ob >> 9) & 1) << 5)); }
__host__ __device__ __forceinline__ void stage_rc(int b, int& R, int& C) { const int st = b / 1024, sb = b % 1024, swz = sb ^ (((sb >> 9) & 1) << 5); R = (st >> 1) * 16 + swz / 64; C = (st & 1) * 32 + (swz % 64) / 2; }
__host__ __device__ __forceinline__ int perm32(int rho) { const int n = rho >> 4, i = rho & 15; return 8 * (i >> 2) + 4 * n + (i & 3); }

struct Unit { int pm, pn; };
struct Gemm { const bf16_t* A; const bf16_t* Bt; int M, N, K; size_t a_tstep; };

struct StaticOrder {
    int nM, nN, nwg, G, c, wgm = WGM;
    __host__ __device__ void init(int M, int N, int G_, int c_) { nM = M / BM; nN = N / BM; nwg = nM * nN; G = G_; c = c_; }
    __host__ __device__ void init_tiles(int nM_, int nN_, int G_, int c_) { nM = nM_; nN = nN_; nwg = nM * nN; G = G_; c = c_; }
    __host__ __device__ bool next(int i, Unit& u) const {
        const long L = (long)i * G + c; if (L >= nwg) return false;
        int wgid = (int)L; { const int q = nwg / NXCD, r = nwg % NXCD, xcd = wgid % NXCD, off = wgid / NXCD; wgid = (xcd < r ? xcd * (q + 1) : r * (q + 1) + (xcd - r) * q) + off; }
        const int nig = wgm * nN, gid = wgid / nig, fm = gid * wgm, gsz = (nM - fm) < wgm ? (nM - fm) : wgm;
        u.pm = fm + ((wgid % nig) % gsz); u.pn = (wgid % nig) / gsz; return true;
    }
    __device__ __forceinline__ void a_ready(const Unit&) const {}
    __device__ __forceinline__ void done(const Unit&) const {}
};

__device__ __forceinline__ unsigned cvt_pk_bf16(float lo, float hi) { unsigned r; asm volatile("v_cvt_pk_bf16_f32 %0, %1, %2" : "=v"(r) : "v"(lo), "v"(hi)); return r; }
typedef float f32x2 __attribute__((ext_vector_type(2)));
constexpr float C2f = 0.125f * 1.4426950408889634f;
constexpr float LOG2E = 1.4426950408889634f;
__device__ __forceinline__ float sigm(float v) { return __builtin_amdgcn_rcpf(1.0f + __builtin_amdgcn_exp2f(-LOG2E * v)); }
__device__ __forceinline__ float bflo(unsigned w) { return __builtin_bit_cast(float, w << 16); }
__device__ __forceinline__ float bfhi(unsigned w) { return __builtin_bit_cast(float, w & 0xffff0000u); }

struct EpiInProj {
    static constexpr bool PERM = true, AFTER_DRAIN = false, HAS_MID = false;
    bf16_t* qkv; bf16_t* gates; unsigned* nrm;
    __device__ __forceinline__ void operator()(const f32x4 (&acc)[2][2][4][2], const Unit& u, int wr, int wc, int fr, int fq) const {
        const int pn = u.pn; bf16_t* base; int ldc, colt; float sc = 1.f; bool sg = false;
        if (pn < 12) { const int t = pn >> 1, slot = (0x541320 >> (4 * t)) & 7; base = qkv + (size_t)slot * ((size_t)MTOK * 512); ldc = 512; colt = (pn & 1) * 256; if (t == 0 || t == 3) sc = C2f; }
        else { base = gates; ldc = 1024; colt = (pn - 12) * 128; sg = true; }
        const int row0 = u.pm * BM + wr * 64 + fr, col0 = colt + wc * 32 + 8 * fq;
        float nmx[2] = {0.f, 0.f};
#pragma unroll
        for (int ai = 0; ai < 2; ++ai)
#pragma unroll
            for (int m = 0; m < 4; ++m) { bf16_t* rowp = base + (size_t)(row0 + ai * HALF + m * 16) * ldc + col0;
                if (sg) {
                    f32x4 rr[2], gg[2];
#pragma unroll
                    for (int n = 0; n < 2; ++n) {
                        const f32x4 xa = acc[ai][0][m][n] * (-LOG2E), xb = acc[ai][1][m][n] * (-LOG2E);
                        const f32x4 da = (f32x4){__builtin_amdgcn_exp2f(xa[0]), __builtin_amdgcn_exp2f(xa[1]), __builtin_amdgcn_exp2f(xa[2]), __builtin_amdgcn_exp2f(xa[3])} + 1.0f;
                        const f32x4 db = (f32x4){__builtin_fminf(__builtin_amdgcn_exp2f(xb[0]), 1e30f), __builtin_fminf(__builtin_amdgcn_exp2f(xb[1]), 1e30f), __builtin_fminf(__builtin_amdgcn_exp2f(xb[2]), 1e30f), __builtin_fminf(__builtin_amdgcn_exp2f(xb[3]), 1e30f)} + 1.0f;
                        gg[n] = (f32x4){__builtin_amdgcn_rcpf(db[0]), __builtin_amdgcn_rcpf(db[1]), __builtin_amdgcn_rcpf(db[2]), __builtin_amdgcn_rcpf(db[3])};
                        rr[n] = db * (f32x4){__builtin_amdgcn_rcpf(da[0]), __builtin_amdgcn_rcpf(da[1]), __builtin_amdgcn_rcpf(da[2]), __builtin_amdgcn_rcpf(da[3])}; }
                    u32x4 w; w.x = cvt_pk_bf16(rr[0][0], rr[0][1]); w.y = cvt_pk_bf16(rr[0][2], rr[0][3]); w.z = cvt_pk_bf16(rr[1][0], rr[1][1]); w.w = cvt_pk_bf16(rr[1][2], rr[1][3]);
                    *(u32x4*)rowp = w;
                    w.x = cvt_pk_bf16(gg[0][0], gg[0][1]); w.y = cvt_pk_bf16(gg[0][2], gg[0][3]); w.z = cvt_pk_bf16(gg[1][0], gg[1][1]); w.w = cvt_pk_bf16(gg[1][2], gg[1][3]);
                    *(u32x4*)(rowp + (size_t)MTOK * 1024) = w;
                    continue; }
#pragma unroll
                for (int bj = 0; bj < 2; ++bj) { f32x4 v0 = acc[ai][bj][m][0], v1 = acc[ai][bj][m][1];
                    if (pn < 4) { const float a0 = bflo(cvt_pk_bf16(v0[0] * sc, 0.f)), a1 = bflo(cvt_pk_bf16(v0[1] * sc, 0.f)), a2 = bflo(cvt_pk_bf16(v0[2] * sc, 0.f)), a3 = bflo(cvt_pk_bf16(v0[3] * sc, 0.f)),
                                      a4 = bflo(cvt_pk_bf16(v1[0] * sc, 0.f)), a5 = bflo(cvt_pk_bf16(v1[1] * sc, 0.f)), a6 = bflo(cvt_pk_bf16(v1[2] * sc, 0.f)), a7 = bflo(cvt_pk_bf16(v1[3] * sc, 0.f));
                        float s = (a0 * a0 + a1 * a1) + (a2 * a2 + a3 * a3) + (a4 * a4 + a5 * a5) + (a6 * a6 + a7 * a7);
                        s += __shfl_xor(s, 16); s += __shfl_xor(s, 32); nmx[bj] = __builtin_fmaxf(nmx[bj], s); }
                    v0 = v0 * sc; v1 = v1 * sc;
                    u32x4 w; w.x = cvt_pk_bf16(v0[0], v0[1]); w.y = cvt_pk_bf16(v0[2], v0[3]); w.z = cvt_pk_bf16(v1[0], v1[1]); w.w = cvt_pk_bf16(v1[2], v1[3]);
                    *(u32x4*)(rowp + bj * HALF) = w; } }
        if (pn < 4) {
#pragma unroll
            for (int bj = 0; bj < 2; ++bj) { float s = nmx[bj] * 1.0001f;
#pragma unroll
                for (int o = 1; o < 16; o <<= 1) s = __builtin_fmaxf(s, __shfl_xor(s, o));
                if (fr == 0 && fq == 0) atomicMax(nrm + (((u.pm >> 5) * 8 + (pn & 1) * 4 + bj * 2 + (wc >> 1)) * 2 + (pn >> 1)) * 2 + (wc & 1), __builtin_bit_cast(unsigned, s)); }
        }
    }
};

struct EpiMerge {
    static constexpr bool PERM = true, AFTER_DRAIN = false, HAS_MID = true;
    const bf16_t* gates; bf16_t* merged;
    __device__ __forceinline__ void mid(f32x4 (&acc)[2][2][4][2], const Unit& u, int wr, int wc, int, int) const {
        int t_ = threadIdx.x; asm volatile("" : "+v"(t_)); const int fr = t_ & 15, fq = (t_ >> 4) & 3;
        const int row0 = u.pm * BM + wr * 64 + fr, col0 = u.pn * BM + wc * 32 + 8 * fq; const bf16_t* R = gates;
#pragma unroll
        for (int ai = 0; ai < 2; ++ai)
#pragma unroll
            for (int m = 0; m < 4; ++m)
#pragma unroll
                for (int bj = 0; bj < 2; ++bj) { const size_t off = (size_t)(row0 + ai * HALF + m * 16) * 1024 + col0 + bj * HALF;
                    const u32x4 a = *(const u32x4*)(R + off);
                    acc[ai][bj][m][0] = acc[ai][bj][m][0] * (f32x4){bflo(a.x), bfhi(a.x), bflo(a.y), bfhi(a.y)};
                    acc[ai][bj][m][1] = acc[ai][bj][m][1] * (f32x4){bflo(a.z), bfhi(a.z), bflo(a.w), bfhi(a.w)}; }
    }
    __device__ __forceinline__ void operator()(const f32x4 (&acc)[2][2][4][2], const Unit& u, int wr, int wc, int fr, int fq) const {
        const bf16_t* GB = gates + (size_t)MTOK * 1024;
        const int row0 = u.pm * BM + wr * 64 + fr, col0 = u.pn * BM + wc * 32 + 8 * fq;
#pragma unroll
        for (int ai = 0; ai < 2; ++ai)
#pragma unroll
            for (int m = 0; m < 4; ++m)
#pragma unroll
                for (int bj = 0; bj < 2; ++bj) { const size_t off = (size_t)(row0 + ai * HALF + m * 16) * 1024 + col0 + bj * HALF;
                    const u32x4 b = *(const u32x4*)(GB + off);
#define PG8_CL(x, f) f(x)
                    const f32x4 v0 = acc[ai][bj][m][0] * (f32x4){PG8_CL(b.x, bflo), PG8_CL(b.x, bfhi), PG8_CL(b.y, bflo), PG8_CL(b.y, bfhi)};
                    const f32x4 v1 = acc[ai][bj][m][1] * (f32x4){PG8_CL(b.z, bflo), PG8_CL(b.z, bfhi), PG8_CL(b.w, bflo), PG8_CL(b.w, bfhi)};
#undef PG8_CL
                    u32x4 w; w.x = cvt_pk_bf16(v0[0], v0[1]); w.y = cvt_pk_bf16(v0[2], v0[3]); w.z = cvt_pk_bf16(v1[0], v1[1]); w.w = cvt_pk_bf16(v1[2], v1[3]);
                    *(u32x4*)(merged + off) = w; }
    }
};

struct EpiBranch {
    static constexpr bool PERM = true, AFTER_DRAIN = false, HAS_MID = false;
    const float* gt; bf16_t* out;
    __device__ __forceinline__ void operator()(const f32x4 (&acc)[2][2][4][2], const Unit& u, int wr, int wc, int fr, int fq) const {
        const int row0 = u.pm * BM + wr * 64 + fr, col0 = u.pn * BM + wc * 32 + 8 * fq; const float* g = gt + (size_t)(u.pm >> 5) * 6144 + col0;
#pragma unroll
        for (int bj = 0; bj < 2; ++bj) { const f32x4 g0 = *(const f32x4*)(g + bj * HALF) + 1.0f, g1 = *(const f32x4*)(g + bj * HALF + 4) + 1.0f;
#pragma unroll
            for (int ai = 0; ai < 2; ++ai)
#pragma unroll
                for (int m = 0; m < 4; ++m) { const f32x4 v0 = g0 * acc[ai][bj][m][0], v1 = g1 * acc[ai][bj][m][1];
                    u32x4 w; w.x = cvt_pk_bf16(v0[0], v0[1]); w.y = cvt_pk_bf16(v0[2], v0[3]); w.z = cvt_pk_bf16(v1[0], v1[1]); w.w = cvt_pk_bf16(v1[2], v1[3]);
                    *(u32x4*)(out + (size_t)(row0 + ai * HALF + m * 16) * 1024 + col0 + bj * HALF) = w; } }
    }
};

struct EpiUpConv {
    static constexpr bool PERM = true, AFTER_DRAIN = false, HAS_MID = false;
    const float* cw; const float* cb; bf16_t* act; PG8_LAS f32x4* xch; PG8_LAS float* wl; float* halo;
    template <int CTRL> static __device__ __forceinline__ float ror_d(float x) { return __builtin_bit_cast(float, __builtin_amdgcn_update_dpp(0, __builtin_bit_cast(int, x), CTRL, 0xf, 0xf, true)); }
    template <bool SEQ0> __device__ __forceinline__ f32x4 conv1(const f32x4 cur, const f32x4 prv, const f32x4 w0, const f32x4 w1, const f32x4 w2, const f32x4 bb, int fr, int s1, int s2, int tseq) const {
        const f32x4 a1 = (fr >= 15) ? prv : cur, a2 = (fr >= 14) ? prv : cur;
        f32x4 p1, p2;
        p1 = (f32x4){ror_d<0x121>(a1[0]), ror_d<0x121>(a1[1]), ror_d<0x121>(a1[2]), ror_d<0x121>(a1[3])};
        p2 = (f32x4){ror_d<0x122>(a2[0]), ror_d<0x122>(a2[1]), ror_d<0x122>(a2[2]), ror_d<0x122>(a2[3])};
        if (SEQ0) { if (tseq < 1) p1 = (f32x4){0.f, 0.f, 0.f, 0.f}; if (tseq < 2) p2 = (f32x4){0.f, 0.f, 0.f, 0.f}; }
        return bb + w0 * p2 + w1 * p1 + w2 * cur;
    }
    __device__ __forceinline__ void operator()(const f32x4 (&acc)[2][2][4][2], const Unit& u, int wr, int wc, int, int) const { run<false>(acc, u, wr, wc); }
    template <bool SEQ0> __device__ __forceinline__ void run(const f32x4 (&acc)[2][2][4][2], const Unit& u, int wr, int wc) const {
        int t_ = threadIdx.x; asm volatile("" : "+v"(t_));
        const int fr = t_ & 15, fq = (t_ >> 4) & 3, lane = t_ & 63;
        const int R0 = 256 * u.pm, ch0 = 128 * u.pn + 32 * wc + 8 * fq;
        if ((wr == 0 && fr < 2) || (wr == 1 && fr >= 14)) {
#pragma unroll
            for (int bj = 0; bj < 2; ++bj)
#pragma unroll
                for (int n = 0; n < 2; ++n) { const f32x4 hv = (wr == 0) ? acc[0][bj][0][n] : acc[1][bj][3][n];
                    *(f32x4*)(halo + ((size_t)u.pm * 4 + (wr == 0 ? fr : fr - 12)) * 5632 + 256 * u.pn + 128 * bj + 32 * wc + 8 * fq + 4 * n) = hv; }
        }
        const int xi = fq * 2 + (fr - 14);
        { const int idx = (t_ & 511) * 2, p = idx >> 8, bjw = (idx >> 7) & 1, cc = idx & 127; const float* src = (p < 3 ? cw + p * 5632 : cb) + bjw * 2816 + 128 * u.pn + cc;
          typedef float f32x2w __attribute__((ext_vector_type(2))); *(PG8_LAS f32x2w*)(wl + idx) = *(const f32x2w*)src; }
        if (fr >= 14) {
#pragma unroll
            for (int ai = 0; ai < 2; ++ai)
#pragma unroll
                for (int bj = 0; bj < 2; ++bj)
#pragma unroll
                    for (int n = 0; n < 2; ++n) xch[(((((ai * 2 + wr) * 4 + wc) * 2 + bj) * 2 + n) * 8) + xi] = acc[ai][bj][3][n];
        }
        asm volatile("s_waitcnt lgkmcnt(0)\n\ts_barrier" ::: "memory");
        const int s1 = (lane & 48) | ((fr - 1) & 15), s2 = (lane & 48) | ((fr - 2) & 15);
#pragma unroll
        for (int ai = 0; ai < 2; ++ai) {
            typedef unsigned u32x2 __attribute__((ext_vector_type(2))); u32x2 wq[2][4];
#pragma unroll
            for (int n = 0; n < 2; ++n) {
                asm volatile("" ::: "memory");
                const bool hasup = (fr >= 14) && ((ai * 2 + wr) >= 1);
                const int upi = (((((ai * 2 + wr - 1) * 4 + wc) * 2 + 0) * 2 + n) * 8) + xi;
                f32x4 cg[4];
                {   int cl = 32 * wc + 8 * fq + 4 * n; asm volatile("" : "+v"(cl));
                    const f32x4 w0 = *(const PG8_LAS f32x4*)(wl + cl), w1 = *(const PG8_LAS f32x4*)(wl + 256 + cl), w2 = *(const PG8_LAS f32x4*)(wl + 512 + cl), bb = *(const PG8_LAS f32x4*)(wl + 768 + cl);
                    f32x4 up = (f32x4){0.f, 0.f, 0.f, 0.f}; if (hasup) up = xch[upi];
#pragma unroll
                    for (int m = 0; m < 4; ++m) cg[m] = conv1<SEQ0>(acc[ai][0][m][n], (m == 0) ? up : acc[ai][0][m > 0 ? m - 1 : 0][n], w0, w1, w2, bb, fr, s1, s2, (R0 + 128 * ai + 64 * wr + 16 * m + fr) & 8191);
                }
                {   int cl = 128 + 32 * wc + 8 * fq + 4 * n; asm volatile("" : "+v"(cl));
                    const f32x4 w0 = *(const PG8_LAS f32x4*)(wl + cl), w1 = *(const PG8_LAS f32x4*)(wl + 256 + cl), w2 = *(const PG8_LAS f32x4*)(wl + 512 + cl), bb = *(const PG8_LAS f32x4*)(wl + 768 + cl);
                    f32x4 up = (f32x4){0.f, 0.f, 0.f, 0.f}; if (hasup) up = xch[upi + 16];
#pragma unroll
                    for (int m = 0; m < 4; ++m) {
                        const int rr = 128 * ai + 64 * wr + 16 * m + fr, grow = R0 + rr;
                        const f32x4 vl = conv1<SEQ0>(acc[ai][1][m][n], (m == 0) ? up : acc[ai][1][m > 0 ? m - 1 : 0][n], w0, w1, w2, bb, fr, s1, s2, grow & 8191);
                        const f32x4 gt = cg[m];
                        const f32x4 ex = gt * (-LOG2E); f32x4 dn = (f32x4){__builtin_amdgcn_exp2f(ex[0]), __builtin_amdgcn_exp2f(ex[1]), __builtin_amdgcn_exp2f(ex[2]), __builtin_amdgcn_exp2f(ex[3])} + 1.0f;
                        const f32x4 rc = (f32x4){__builtin_amdgcn_rcpf(dn[0]), __builtin_amdgcn_rcpf(dn[1]), __builtin_amdgcn_rcpf(dn[2]), __builtin_amdgcn_rcpf(dn[3])};
                        const f32x4 ov = (gt * vl) * rc;
                        wq[n][m].x = cvt_pk_bf16(ov[0], ov[1]); wq[n][m].y = cvt_pk_bf16(ov[2], ov[3]);
                    }
                }
            }
#pragma unroll
            for (int m = 0; m < 4; ++m) { const int rr = 128 * ai + 64 * wr + 16 * m + fr, grow = R0 + rr;
                if (rr >= 2) { u32x4 w; w.x = wq[0][m].x; w.y = wq[0][m].y; w.z = wq[1][m].x; w.w = wq[1][m].y; *(u32x4*)(act + (size_t)grow * 2816 + ch0) = w; } }
        }
    }
};
template <class Epi, class Sched, bool ALIGN_EPI = false, bool SP2 = false>
__device__ __forceinline__ void gemm_phase(PG8_LAS unsigned char* lds, const Gemm g, const Sched& S, const Epi& E) {
    int tid_ = threadIdx.x; asm volatile("" : "+v"(tid_));
    const int tid = tid_, wid = __builtin_amdgcn_readfirstlane(tid >> 6), lane = tid & 63, wr = wid >> 2, wc = wid & 3, fr = lane & 15, fq = lane >> 4;
    const int K = g.K, nt = K / BK;
    unsigned voffA[2], voffB[2];
#pragma unroll
    for (int i = 0; i < 2; ++i) { int R, C; stage_rc(tid * 16 + i * 8192, R, C); const int Rb = Epi::PERM ? ((R & ~31) + perm32(R & 31)) : R;
        voffA[i] = (unsigned)(R * K + C) * 2u; voffB[i] = (unsigned)(Rb * K + C) * 2u; }
    const size_t kstep = (size_t)(BK * 2);
    const size_t hstep = (size_t)HALF * K * 2;
    const size_t tstep = 2 * hstep;
    const unsigned ldsw = (unsigned)wid * 1024u;
    const int aoff = lds_byte(wr * 64 + fr, fq * 8), boff = lds_byte(wc * 32 + fr, fq * 8);
#define PG8_SA(b, h) (((b) * 2 + (h)) * HTB)
#define PG8_SB(b, h) ((4 + (b) * 2 + (h)) * HTB)
#define PG8_STAGE(bufoff, gbase, voff) do { _Pragma("unroll") for (int _i = 0; _i < 2; ++_i) \
        __builtin_amdgcn_global_load_lds((const unsigned*)((const char*)(gbase) + (voff)[_i]), (PG8_LAS unsigned*)(lds + (bufoff) + ldsw + _i * 8192), 16, 0, 0); } while (0)
#define PG8_LDA(dst, b, h) do { _Pragma("unroll") for (int m = 0; m < 4; ++m) _Pragma("unroll") for (int k = 0; k < 2; ++k) dst[m][k] = *(const PG8_LAS bf16x8*)(lds + PG8_SA(b, h) + aoff + m * 2048 + k * 1024); } while (0)
#define PG8_LDB(dst, b, h) do { _Pragma("unroll") for (int n = 0; n < 2; ++n) _Pragma("unroll") for (int k = 0; k < 2; ++k) dst[n][k] = *(const PG8_LAS bf16x8*)(lds + PG8_SB(b, h) + boff + n * 2048 + k * 1024); } while (0)
#define PG8_MMA(ai, bj, At, Bt) do { __builtin_amdgcn_s_setprio(1); _Pragma("unroll") for (int m = 0; m < 4; ++m) _Pragma("unroll") for (int n = 0; n < 2; ++n) _Pragma("unroll") for (int k = 0; k < 2; ++k) \
        acc[ai][bj][m][n] = __builtin_amdgcn_mfma_f32_16x16x32_bf16(Bt[n][k], At[m][k], acc[ai][bj][m][n], 0, 0, 0); __builtin_amdgcn_s_setprio(0); } while (0)
#define PG8_WAIT_V(n) asm volatile("s_waitcnt vmcnt(" #n ")" ::: "memory")
#define PG8_WAIT_L(n) asm volatile("s_waitcnt lgkmcnt(" #n ")" ::: "memory")
#define PG8_BAR __builtin_amdgcn_s_barrier()
#define PG8_SCHED __builtin_amdgcn_sched_barrier(0)
    Unit cur, nxt; int ui = 0;
    if (!S.next(0, cur)) return;
    f32x4 acc[2][2][4][2];
#pragma unroll
    for (int a = 0; a < 2; ++a)
#pragma unroll
        for (int b = 0; b < 2; ++b)
#pragma unroll
            for (int m = 0; m < 4; ++m)
#pragma unroll
                for (int n = 0; n < 2; ++n) acc[a][b][m][n] = (f32x4){0.f, 0.f, 0.f, 0.f};
    bf16x8 At[4][2], B0[2][2], B1[2][2];
    const char* cA = (const char*)g.A + (size_t)cur.pm * g.a_tstep; const char* cB = (const char*)g.Bt + (size_t)cur.pn * tstep;
    S.a_ready(cur);
    if constexpr (SP2) {
        PG8_STAGE(PG8_SB(0, 0), cB, voffB); PG8_STAGE(PG8_SB(0, 1), cB + hstep, voffB); PG8_STAGE(PG8_SA(0, 0), cA, voffA); PG8_STAGE(PG8_SA(0, 1), cA + hstep, voffA);
        if (wr == 1) PG8_BAR;
        PG8_WAIT_V(2); PG8_BAR;
        PG8_STAGE(PG8_SB(1, 0), cB + kstep, voffB); PG8_STAGE(PG8_SA(1, 0), cA + kstep, voffA); PG8_STAGE(PG8_SB(1, 1), cB + hstep + kstep, voffB);
        PG8_WAIT_V(6); PG8_BAR;
    } else {
        PG8_STAGE(PG8_SB(0, 0), cB, voffB); PG8_STAGE(PG8_SA(0, 0), cA, voffA); PG8_STAGE(PG8_SB(0, 1), cB + hstep, voffB); PG8_STAGE(PG8_SA(0, 1), cA + hstep, voffA);
        if (wr == 1) PG8_BAR;
        PG8_WAIT_V(4); PG8_BAR;
        PG8_STAGE(PG8_SB(1, 0), cB + kstep, voffB); PG8_STAGE(PG8_SA(1, 0), cA + kstep, voffA); PG8_STAGE(PG8_SB(1, 1), cB + hstep + kstep, voffB);
        PG8_WAIT_V(6); PG8_BAR;
    }
    for (;;) {
        const bool has_next = S.next(ui + 1, nxt);
        const char* nA = has_next ? (const char*)g.A + (size_t)nxt.pm * g.a_tstep : cA; const char* nB = has_next ? (const char*)g.Bt + (size_t)nxt.pn * tstep : cB;
        for (int t = 0; t < nt; t += 2) {
            const bool last = (t == nt - 2);
            const char* a1 = cA + (size_t)(t + 1) * kstep;
            const char* a2 = last ? nA : cA + (size_t)(t + 2) * kstep; const char* b2 = last ? nB : cB + (size_t)(t + 2) * kstep;
            const char* a3 = a2 + kstep; const char* b3 = b2 + kstep;
            if (last && has_next) S.a_ready(nxt);
            if constexpr (SP2) {
            PG8_LDB(B0, 0, 0); PG8_LDB(B1, 0, 1); PG8_SCHED; PG8_LDA(At, 0, 0); PG8_STAGE(PG8_SA(1, 1), a1 + hstep, voffA);
            PG8_WAIT_V(8); PG8_WAIT_L(0); PG8_BAR; PG8_MMA(0, 0, At, B0); PG8_MMA(0, 1, At, B1); PG8_BAR; PG8_SCHED;
            PG8_LDA(At, 0, 1); PG8_STAGE(PG8_SB(0, 0), b2, voffB); PG8_STAGE(PG8_SB(0, 1), b2 + hstep, voffB); PG8_STAGE(PG8_SA(0, 0), a2, voffA);
            PG8_WAIT_V(8); PG8_WAIT_L(0); PG8_BAR; PG8_MMA(1, 0, At, B0); PG8_MMA(1, 1, At, B1); PG8_BAR; PG8_SCHED;
            PG8_LDB(B0, 1, 0); PG8_LDB(B1, 1, 1); PG8_SCHED; PG8_LDA(At, 1, 0); PG8_STAGE(PG8_SA(0, 1), a2 + hstep, voffA);
            PG8_WAIT_V(8); PG8_WAIT_L(0); PG8_BAR; PG8_MMA(0, 0, At, B0); PG8_MMA(0, 1, At, B1); PG8_BAR; PG8_SCHED;
            PG8_LDA(At, 1, 1); PG8_STAGE(PG8_SB(1, 0), b3, voffB); PG8_STAGE(PG8_SB(1, 1), b3 + hstep, voffB); PG8_STAGE(PG8_SA(1, 0), a3, voffA);
            PG8_WAIT_V(8); PG8_WAIT_L(0); PG8_BAR; PG8_MMA(1, 0, At, B0); PG8_MMA(1, 1, At, B1); PG8_BAR; PG8_SCHED;
            } else {
            PG8_LDB(B0, 0, 0); PG8_SCHED; PG8_LDA(At, 0, 0); PG8_STAGE(PG8_SA(1, 1), a1 + hstep, voffA);
            PG8_WAIT_L(8); PG8_BAR; PG8_WAIT_L(0); PG8_MMA(0, 0, At, B0); PG8_BAR; PG8_SCHED;
            PG8_LDB(B1, 0, 1); PG8_STAGE(PG8_SB(0, 0), b2, voffB);
            PG8_BAR; PG8_WAIT_L(0); PG8_MMA(0, 1, At, B1); PG8_BAR;
            PG8_LDA(At, 0, 1); PG8_STAGE(PG8_SA(0, 0), a2, voffA);
            PG8_BAR; PG8_WAIT_L(0); PG8_MMA(1, 0, At, B0); PG8_BAR; PG8_SCHED;
            PG8_STAGE(PG8_SB(0, 1), b2 + hstep, voffB);
            PG8_WAIT_V(6); PG8_BAR; PG8_MMA(1, 1, At, B1); PG8_BAR;
            PG8_LDB(B0, 1, 0); PG8_SCHED; PG8_LDA(At, 1, 0); PG8_STAGE(PG8_SA(0, 1), a2 + hstep, voffA);
            PG8_WAIT_L(8); PG8_BAR; PG8_WAIT_L(0); PG8_MMA(0, 0, At, B0); PG8_BAR; PG8_SCHED;
            PG8_LDB(B1, 1, 1); PG8_STAGE(PG8_SB(1, 0), b3, voffB);
            PG8_BAR; PG8_WAIT_L(0); PG8_MMA(0, 1, At, B1); PG8_BAR;
            PG8_LDA(At, 1, 1); PG8_STAGE(PG8_SA(1, 0), a3, voffA);
            PG8_BAR; PG8_WAIT_L(0); PG8_MMA(1, 0, At, B0); PG8_BAR; PG8_SCHED;
            PG8_STAGE(PG8_SB(1, 1), b3 + hstep, voffB);
            PG8_WAIT_V(6); PG8_BAR; PG8_MMA(1, 1, At, B1); PG8_BAR;
            }
            if constexpr (Epi::HAS_MID) { if (t == nt / 2 - 2) E.mid(acc, cur, wr, wc, fr, fq); }
        }
        if constexpr (ALIGN_EPI) { if (wr == 0) PG8_BAR; }
        if constexpr (!Epi::AFTER_DRAIN) { E(acc, cur, wr, wc, fr, fq); S.done(cur); }
        if (!has_next) break;
#pragma unroll
        for (int a = 0; a < 2; ++a)
#pragma unroll
            for (int b = 0; b < 2; ++b)
#pragma unroll
                for (int m = 0; m < 4; ++m)
#pragma unroll
                    for (int n = 0; n < 2; ++n) acc[a][b][m][n] = (f32x4){0.f, 0.f, 0.f, 0.f};
        cur = nxt; cA = nA; cB = nB; ++ui;
        if constexpr (ALIGN_EPI) { if (wr == 1) PG8_BAR; }
    }
    PG8_WAIT_V(0);
    if constexpr (!ALIGN_EPI) { if (wr == 0) PG8_BAR; }
    PG8_BAR;
    if constexpr (Epi::AFTER_DRAIN) { E.fused(acc, cur, wr, wc, fr, fq, lds, wid, lane); S.done(cur); }
#undef PG8_SA
#undef PG8_SB
#undef PG8_STAGE
#undef PG8_LDA
#undef PG8_LDB
#undef PG8_MMA
#undef PG8_WAIT_V
#undef PG8_WAIT_L
#undef PG8_BAR
#undef PG8_SCHED
}
}
#include <hip/hip_bf16.h>
#include <cmath>
namespace attn_body {
using bf16=__hip_bfloat16;
using bf16x8=__attribute__((ext_vector_type(8)))short;
using s16x4=__attribute__((ext_vector_type(4)))short;
using f32x16=__attribute__((ext_vector_type(16)))float;
using u32x4=__attribute__((ext_vector_type(4)))unsigned;
constexpr int BATCH=8,NHEAD=8,SEQ=8192,D=64,DM=NHEAD*D;
constexpr int NW=8,QBLK=32,QB=QBLK*NW,KVBLK=64,NQB=SEQ/QB;
constexpr int ATTN_PITCH=DM, ATTN_UNIT_ROWS=QB, ODM=1024;
constexpr float ATTN_SKIP_LOG2=SKIP_LOG2;
__device__ __forceinline__ int crow(int r,int hi){return (r&3)+8*(r>>2)+4*hi;}
#define SBAR() __builtin_amdgcn_sched_barrier(0)
__device__ __forceinline__ void cmask(f32x16&p0,f32x16&p1,int jb,int qrel,int hi){
  const float NEG=-INFINITY; int kb=64*jb+4*hi;
  #pragma unroll
  for(int r=0;r<16;++r){int kv=kb+(r&3)+8*(r>>2); if(kv>qrel)p0[r]=NEG; if(kv+32>qrel)p1[r]=NEG;}
}

constexpr int NSLOT=3, SLOTB=8192;
constexpr int LDS_K=0, LDS_V=NSLOT*SLOTB, LDS_WS=2*NSLOT*SLOTB, LDS_OST=LDS_WS+NW*64*4, LDS_CK=LDS_OST+NW*4096, LDS_T0=LDS_CK+SEQ*4, LDS_BYTES=LDS_T0+64;
constexpr float C2=0.125f*1.4426950408889634f;
__device__ __forceinline__ void glds16(const void*gsrc,unsigned lds_dst){unsigned keep;
  asm volatile("s_mov_b32 %0, m0\n\ts_mov_b32 m0, %2\n\ts_nop 0\n\tglobal_load_lds_dwordx4 %1, off\n\ts_mov_b32 m0, %0":"=&s"(keep):"v"(gsrc),"s"(lds_dst):"memory");}
__device__ __forceinline__ float max3f(float a,float b,float c){float r;asm("v_max3_f32 %0, %1, %2, %3":"=v"(r):"v"(a),"v"(b),"v"(c));return r;}
__device__ __forceinline__ float max2f(float a,float b){float r;asm("v_max_f32_e32 %0, %1, %2":"=v"(r):"v"(a),"v"(b));return r;}
__device__ __forceinline__ float fadd_s(float a,float b){float r;asm("v_add_f32_e32 %0, %1, %2":"=v"(r):"v"(a),"v"(b));return r;}
__device__ __forceinline__ float fsub_s(float a,float b){float r;asm("v_sub_f32_e32 %0, %1, %2":"=v"(r):"v"(a),"v"(b));return r;}
typedef float f32x2_t __attribute__((ext_vector_type(2))); typedef __bf16 bf16x2_t __attribute__((ext_vector_type(2)));
__device__ __forceinline__ unsigned cvtpk_s(float lo,float hi){f32x2_t v={lo,hi};bf16x2_t b=__builtin_convertvector(v,bf16x2_t);return __builtin_bit_cast(unsigned,b);}
#define WAIT_BAR(N) asm volatile("s_waitcnt vmcnt(" #N ") lgkmcnt(0)\n\ts_barrier":::"memory")

__device__ __forceinline__ void qkt(f32x16&p0,f32x16&p1,const char*Kslot,const bf16x8*qr,int r32,int hi){
  const char*kb=Kslot+hi*1024+r32*16;
  #pragma unroll
  for(int d0=0;d0<4;++d0){
    const bf16x8 b0=*reinterpret_cast<const bf16x8*>(kb+d0*2048);
    const bf16x8 b1=*reinterpret_cast<const bf16x8*>(kb+d0*2048+512);
    {p0=__builtin_amdgcn_mfma_f32_32x32x16_bf16(b0,qr[d0],p0,0,0,0);p1=__builtin_amdgcn_mfma_f32_32x32x16_bf16(b1,qr[d0],p1,0,0,0);}}
}
typedef __attribute__((address_space(3))) const char* lds_cptr;
typedef short v4i16_t __attribute__((ext_vector_type(4)));
__device__ __forceinline__ void kload8(bf16x8*kf,lds_cptr kp){
  kf[0]=*(const __attribute__((address_space(3))) bf16x8*)(kp);      kf[1]=*(const __attribute__((address_space(3))) bf16x8*)(kp+512);
  kf[2]=*(const __attribute__((address_space(3))) bf16x8*)(kp+2048); kf[3]=*(const __attribute__((address_space(3))) bf16x8*)(kp+2560);
  kf[4]=*(const __attribute__((address_space(3))) bf16x8*)(kp+4096); kf[5]=*(const __attribute__((address_space(3))) bf16x8*)(kp+4608);
  kf[6]=*(const __attribute__((address_space(3))) bf16x8*)(kp+6144); kf[7]=*(const __attribute__((address_space(3))) bf16x8*)(kp+6656);
}
__device__ __forceinline__ void kload2(bf16x8*kf,lds_cptr kp,int j){ kf[2*j]=*(const __attribute__((address_space(3))) bf16x8*)(kp+j*2048); kf[2*j+1]=*(const __attribute__((address_space(3))) bf16x8*)(kp+j*2048+512); }
__device__ __forceinline__ s16x4 vtr(lds_cptr p){ return __builtin_bit_cast(s16x4,__builtin_amdgcn_ds_read_tr16_b64_v4i16((__attribute__((address_space(3))) v4i16_t*)p)); }
__device__ __forceinline__ float rowmax(const f32x16&p0,const f32x16&p1){
  float a=max3f(p0[0],p0[1],p1[0]),b=max3f(p0[2],p0[3],p1[1]);a=max3f(a,p1[2],p1[3]);
  #pragma unroll
  for(int r=4;r<16;r+=4){a=max3f(a,p0[r],p0[r+1]);b=max3f(b,p0[r+2],p0[r+3]);a=max3f(a,p1[r],p1[r+1]);b=max3f(b,p1[r+2],p1[r+3]);}
  const float m=max2f(a,b);
  auto rr=__builtin_amdgcn_permlane32_swap(__float_as_uint(m),__float_as_uint(m),false,false);
  return max2f(__uint_as_float(rr[0]),__uint_as_float(rr[1]));
}
__device__ __forceinline__ void pv(f32x16*o,int vb,bf16x8 pa0,bf16x8 pa1,bf16x8 pa2,bf16x8 pa3){
  #pragma unroll
  for(int d0=0;d0<2;++d0){s16x4 lo[4],hi[4];
    #pragma unroll
    for(int ks=0;ks<4;++ks){
      asm volatile("ds_read_b64_tr_b16 %0,%1 offset:%c2":"=&v"(lo[ks]):"v"(vb),"i"(d0*4096+ks*1024):"memory");
      asm volatile("ds_read_b64_tr_b16 %0,%1 offset:%c2":"=&v"(hi[ks]):"v"(vb),"i"(d0*4096+ks*1024+512):"memory");}
    asm volatile("s_waitcnt lgkmcnt(0)":::"memory");SBAR();
    #define PK(k) (bf16x8){lo[k][0],lo[k][1],lo[k][2],lo[k][3],hi[k][0],hi[k][1],hi[k][2],hi[k][3]}
    o[d0]=__builtin_amdgcn_mfma_f32_32x32x16_bf16(pa0,PK(0),o[d0],0,0,0);
    o[d0]=__builtin_amdgcn_mfma_f32_32x32x16_bf16(pa1,PK(1),o[d0],0,0,0);
    o[d0]=__builtin_amdgcn_mfma_f32_32x32x16_bf16(pa2,PK(2),o[d0],0,0,0);
    o[d0]=__builtin_amdgcn_mfma_f32_32x32x16_bf16(pa3,PK(3),o[d0],0,0,0);
    #undef PK
  }
}

typedef __attribute__((address_space(3))) const float* lds_fptr;
typedef float f32x4_t __attribute__((ext_vector_type(4)));
__device__ __forceinline__ void biasinit(f32x16&c0,f32x16&c1,lds_fptr ckt,float aq){
  #pragma unroll
  for(int g=0;g<4;++g){ const f32x4_t v=*(const __attribute__((address_space(3))) f32x4_t*)(ckt+8*g); const f32x4_t w=*(const __attribute__((address_space(3))) f32x4_t*)(ckt+32+8*g);
    c0[4*g]=aq-v[0];c0[4*g+1]=aq-v[1];c0[4*g+2]=aq-v[2];c0[4*g+3]=aq-v[3]; c1[4*g]=aq-w[0];c1[4*g+1]=aq-w[1];c1[4*g+2]=aq-w[2];c1[4*g+3]=aq-w[3]; }
}
#ifndef ATTN_STORE16
#define ATTN_STORE16(p,v) (*(u32x4*)(p)=(v))
#endif
template<int THRL> __device__ __forceinline__ void attn_unit(int b,int h,int qb,const bf16*Q,const bf16*__restrict__ K,const bf16*__restrict__ V,bf16*O,char*shm,const float*__restrict__ CKg,const float Tskip){
  int tid_=threadIdx.x; asm volatile("":"+v"(tid_)); const int tid=tid_,lane=tid&63,r32=lane&31,hi=lane>>5; const int wid=__builtin_amdgcn_readfirstlane(tid>>6);
  const long rowbase=(long)b*SEQ; const int q0=qb*QB; const lds_cptr shm3=(lds_cptr)shm;
  const float*ckh=CKg+(long)(b*NHEAD+h)*SEQ; int t0;
  { __attribute__((address_space(3))) int*cw=(__attribute__((address_space(3))) int*)((__attribute__((address_space(3))) char*)shm3+LDS_T0);
    const int ntf=(q0+QB)/KVBLK; bool ok=false; if(tid>=1&&tid<=ntf-4) ok=(ckh[64*tid-1]-ckh[q0])>=Tskip;
    const unsigned long long bm=__ballot(ok); if(lane==0)cw[wid]=__popcll(bm);
    asm volatile("s_waitcnt vmcnt(0) lgkmcnt(0)\n\ts_barrier":::"memory");
    t0=__builtin_amdgcn_readfirstlane((cw[0]+cw[1])&~1); }
  const bf16*Qw=Q+(rowbase+q0+wid*QBLK)*DM+h*D;
  const bf16*Kh=K+(rowbase+64*t0)*DM+h*D,*Vh=V+(rowbase+64*t0)*DM+h*D;
  const unsigned lds0=(unsigned)(uintptr_t)shm;
  float*wsf=(float*)(shm+LDS_WS)+wid*64;
  const bf16*ksrc=Kh+(long)lane*DM+wid*8;
  const bf16*vsrc=Vh+(long)(16*(wid&3)+(lane>>2))*DM+(wid>>2)*32+(lane&3)*8;
  const unsigned kdst=lds0+LDS_K+wid*1024, vdst=lds0+LDS_V+wid*1024;
  #define DMA_K(t,slot) glds16(ksrc+(long)(t)*KVBLK*DM,(unsigned)__builtin_amdgcn_readfirstlane(kdst+(slot)))
  #define DMA_V(t,slot) glds16(vsrc+(long)(t)*KVBLK*DM,(unsigned)__builtin_amdgcn_readfirstlane(vdst+(slot)))
  const int vb0=(int)(lds0+LDS_V)+((lane>>4)&1)*32+(lane&3)*8+(4*hi+((lane&15)>>2))*64;
  const char*Kbase=shm+LDS_K; bf16x8 kf[8];
  const lds_cptr kp0=shm3+LDS_K+hi*1024+r32*16; const lds_cptr vp0=shm3+LDS_V+((lane>>4)&1)*32+(lane&3)*8+(4*hi+((lane&15)>>2))*64;
  const int NT=(q0+QB)/KVBLK-t0;
  { __attribute__((address_space(3))) f32x4_t*ckd=(__attribute__((address_space(3))) f32x4_t*)((__attribute__((address_space(3))) char*)shm3+LDS_CK);
    for(int i=tid;i<(q0+QB-64*t0)/4;i+=NW*64) ckd[i]=*(const f32x4_t*)(ckh+64*t0+4*i);
    asm volatile("s_waitcnt vmcnt(0) lgkmcnt(0)\n\ts_barrier":::"memory"); }
  const lds_fptr ckl=(lds_fptr)(shm3+LDS_CK);
  const float cq=ckl[q0-64*t0+wid*QBLK+r32]; float aq=cq;
  DMA_K(0,0);DMA_V(0,0);DMA_K(1,SLOTB);
  bf16x8 qr[4];
  #pragma unroll
  for(int d0=0;d0<4;++d0)qr[d0]=*reinterpret_cast<const bf16x8*>(&Qw[(long)r32*DM+d0*16+hi*8]);
  float mhat=0.f,l_reg=0.f;f32x16 o[2];o[0]=f32x16{};o[1]=f32x16{};
  const int qrel=wid*QBLK+r32;
  #define CMASK(P0,P1,t) do{int jb_=(t)-(NT-4); if(jb_>=0)cmask(P0,P1,jb_,qrel,hi);}while(0)
  bool resc=false;
  #define START(P0,P1) do{ const float rm=rowmax(P0,P1); resc=false; \
    { const float dl=rm; mhat=fadd_s(mhat,dl); \
      _Pragma("unroll") for(int r=0;r<16;++r){P0[r]=fsub_s(P0[r],dl);P1[r]=fsub_s(P1[r],dl);} \
      aq=cq-mhat; } \
    _Pragma("unroll") for(int r=0;r<16;++r)P0[r]=__builtin_amdgcn_exp2f(P0[r]); }while(0)
  #define RESC() do{ if(resc){ asm volatile("s_waitcnt lgkmcnt(0)":::"memory"); \
      _Pragma("unroll") for(int d_=0;d_<2;++d_) _Pragma("unroll") for(int r=0;r<16;++r)o[d_][r]*=wsf[crow(r,hi)]; } }while(0)
  f32x16 pA0,pA1,pB0,pB1;
  int sl_prev=0,sl_cur=0,sl_next=SLOTB;
  #define ROT() do{sl_prev=sl_cur;sl_cur=sl_next;sl_next=(sl_next==(NSLOT-1)*SLOTB)?0:sl_next+SLOTB;}while(0)
  DMA_K(2,2*SLOTB);
  WAIT_BAR(3);
  biasinit(pA0,pA1,ckl+4*hi,aq); qkt(pA0,pA1,Kbase,qr,r32,hi);asm volatile("s_nop 15\n\ts_nop 7":"+v"(pA0),"+v"(pA1));CMASK(pA0,pA1,0);
  START(pA0,pA1);
  _Pragma("unroll") for(int r=0;r<16;++r)pA1[r]=__builtin_amdgcn_exp2f(pA1[r]);
  WAIT_BAR(0);
  DMA_K(3,0);DMA_V(1,SLOTB);
  ROT();
  kload8(kf,kp0+sl_cur);
  WAIT_BAR(2);
  s16x4 vlo[8],vhi[8]; u32x4 pw0,pw1,pw2,pw3;
  #define PKW(P,B) cvtpk_s(P[B],P[B+1])
  #define PAF(k) __builtin_bit_cast(bf16x8,pw##k)
  #define VFR(i) (bf16x8){vlo[i][0],vlo[i][1],vlo[i][2],vlo[i][3],vhi[i][0],vhi[i][1],vhi[i][2],vhi[i][3]}
  #define PIN(x) asm volatile("":"+v"(x))
  #define MX3(a,b,c) __builtin_fmaxf(__builtin_fmaxf((a),(b)),(c))
  #define GAPA(MF,A0,A1,A2,A3,W0,W1,PW) do{ MF; sacc+=A0; sacc+=A1; sacc+=A2; sacc+=A3; PIN(sacc); W0; W1; PIN(PW); SBAR(); }while(0)
  #define EX(v) __builtin_amdgcn_exp2f(v)
  #define GAPB(MF,X,B) do{ MF; X[B]=EX(X[B]); X[B+1]=EX(X[B+1]); X[B+2]=EX(X[B+2]); X[B+3]=EX(X[B+3]); PIN(X); SBAR(); }while(0)
  #define VRD(i) do{ vlo[i]=vtr(vp_+(((i)>>2)*4096+((i)&3)*1024)); vhi[i]=vtr(vp_+(((i)>>2)*4096+((i)&3)*1024+512)); }while(0)
  #define KRD(G,j) do{ if(G){ kload2(kf,kp0+sl_next,j); SBAR(); } }while(0)
  #define STEP(C0,C1,P0,P1,t,GK,GV,GL) do{ SBAR(); biasinit(C0,C1,ckl+64*(t)+4*hi,aq); SBAR(); \
    const lds_cptr vp_=vp0+sl_prev; \
    VRD(0); SBAR(); float sacc=(P0[0]+P0[1]); \
    GAPA(C0=__builtin_amdgcn_mfma_f32_32x32x16_bf16(kf[0],qr[0],C0,0,0,0), P0[2],P0[3],P0[4],P0[5],     pw0[0]=PKW(P0,0), pw0[1]=PKW(P0,2), pw0); \
    VRD(4); SBAR(); GAPA(C1=__builtin_amdgcn_mfma_f32_32x32x16_bf16(kf[1],qr[0],C1,0,0,0), P0[6],P0[7],P0[8],P0[9],     pw0[2]=PKW(P0,4), pw0[3]=PKW(P0,6), pw0); \
    VRD(1); SBAR(); GAPA(C0=__builtin_amdgcn_mfma_f32_32x32x16_bf16(kf[2],qr[1],C0,0,0,0),   P0[10],P0[11],P0[12],P0[13], pw1[0]=PKW(P0,8), pw1[1]=PKW(P0,10), pw1); \
    VRD(5); SBAR(); GAPA(C1=__builtin_amdgcn_mfma_f32_32x32x16_bf16(kf[3],qr[1],C1,0,0,0),   P0[14],P0[15],P1[0],P1[1],   pw1[2]=PKW(P0,12),pw1[3]=PKW(P0,14), pw1); \
    VRD(2); SBAR(); GAPA(C0=__builtin_amdgcn_mfma_f32_32x32x16_bf16(kf[4],qr[2],C0,0,0,0),   P1[2],P1[3],P1[4],P1[5],     pw2[0]=PKW(P1,0), pw2[1]=PKW(P1,2), pw2); \
    VRD(6); SBAR(); GAPA(C1=__builtin_amdgcn_mfma_f32_32x32x16_bf16(kf[5],qr[2],C1,0,0,0),   P1[6],P1[7],P1[8],P1[9],     pw2[2]=PKW(P1,4), pw2[3]=PKW(P1,6), pw2); \
    VRD(3); SBAR(); GAPA(C0=__builtin_amdgcn_mfma_f32_32x32x16_bf16(kf[6],qr[3],C0,0,0,0),   P1[10],P1[11],P1[12],P1[13], pw3[0]=PKW(P1,8), pw3[1]=PKW(P1,10), pw3); \
    VRD(7); SBAR(); GAPA(C1=__builtin_amdgcn_mfma_f32_32x32x16_bf16(kf[7],qr[3],C1,0,0,0),   P1[14],P1[15],0.f,0.f,       pw3[2]=PKW(P1,12),pw3[3]=PKW(P1,14), pw3); \
    l_reg+=sacc; \
    if(GK){DMA_K((t)+3,sl_cur);} if(GV){DMA_V((t)+1,sl_next);} \
    CMASK(C0,C1,t); \
    { float a=MX3(C0[0],C0[1],C1[0]),b=MX3(C0[2],C0[3],C1[1]); a=MX3(a,C1[2],C1[3]); \
      _Pragma("unroll") for(int r=4;r<16;r+=4){a=MX3(a,C0[r],C0[r+1]);b=MX3(b,C0[r+2],C0[r+3]);a=MX3(a,C1[r],C1[r+1]);b=MX3(b,C1[r+2],C1[r+3]);} \
      float rm=__builtin_fmaxf(a,b); { auto rr=__builtin_amdgcn_permlane32_swap(__float_as_uint(rm),__float_as_uint(rm),false,false); rm=__builtin_fmaxf(__uint_as_float(rr[0]),__uint_as_float(rr[1])); } \
      resc=false; \
      if(__builtin_expect(__any(rm>(float)THRL),0)){ const float dl=__builtin_fmaxf(rm,0.f); mhat+=dl; \
        _Pragma("unroll") for(int r=0;r<16;++r){C0[r]-=dl;C1[r]-=dl;} \
        aq=cq-mhat; \
        const float f=__builtin_amdgcn_exp2f(-dl); l_reg*=f; if(hi==0)wsf[r32]=f; resc=true; } } \
    SBAR(); \
    GAPB(o[0]=__builtin_amdgcn_mfma_f32_32x32x16_bf16(PAF(0),VFR(0),o[0],0,0,0), C0,0); \
    GAPB(o[1]=__builtin_amdgcn_mfma_f32_32x32x16_bf16(PAF(0),VFR(4),o[1],0,0,0), C0,4); \
    KRD(GL,0); GAPB(o[0]=__builtin_amdgcn_mfma_f32_32x32x16_bf16(PAF(1),VFR(1),o[0],0,0,0), C0,8); \
    KRD(GL,1); GAPB(o[1]=__builtin_amdgcn_mfma_f32_32x32x16_bf16(PAF(1),VFR(5),o[1],0,0,0), C0,12); \
    KRD(GL,2); GAPB(o[0]=__builtin_amdgcn_mfma_f32_32x32x16_bf16(PAF(2),VFR(2),o[0],0,0,0), C1,0); \
    KRD(GL,3); GAPB(o[1]=__builtin_amdgcn_mfma_f32_32x32x16_bf16(PAF(2),VFR(6),o[1],0,0,0), C1,4); \
    GAPB(o[0]=__builtin_amdgcn_mfma_f32_32x32x16_bf16(PAF(3),VFR(3),o[0],0,0,0), C1,8); \
    GAPB(o[1]=__builtin_amdgcn_mfma_f32_32x32x16_bf16(PAF(3),VFR(7),o[1],0,0,0), C1,12); \
    }while(0)
  int t=1;
  #undef CMASK
  #define CMASK(P0,P1,t) do{}while(0)
  for(;t+5<NT;t+=2){
    STEP(pB0,pB1,pA0,pA1,t,true,true,true);     WAIT_BAR(2); RESC(); ROT();
    STEP(pA0,pA1,pB0,pB1,t+1,true,true,true);   WAIT_BAR(2); RESC(); ROT();
  }
  #undef CMASK
  #define CMASK(P0,P1,t) do{int jb_=(t)-(NT-4); if(jb_>=0)cmask(P0,P1,jb_,qrel,hi);}while(0)
  #define ENDW(tt) do{ if((tt)+3<NT){WAIT_BAR(2);} else if((tt)+2<NT){WAIT_BAR(1);} else {WAIT_BAR(0);} }while(0)
  for(;t+1<NT;t+=2){
    STEP(pB0,pB1,pA0,pA1,t,(t+3<NT),(t+1<NT),(t+1<NT));       ENDW(t);   RESC(); ROT();
    STEP(pA0,pA1,pB0,pB1,t+1,(t+4<NT),(t+2<NT),(t+2<NT));     ENDW(t+1); RESC(); ROT();
  }
  STEP(pB0,pB1,pA0,pA1,NT-1,false,false,false); RESC();
  { float sacc=pB0[0]+pB0[1]; _Pragma("unroll") for(int r=2;r<16;++r)sacc+=pB0[r]; _Pragma("unroll") for(int r=0;r<16;++r)sacc+=pB1[r]; l_reg+=sacc;
    pw0=(u32x4){PKW(pB0,0),PKW(pB0,2),PKW(pB0,4),PKW(pB0,6)};pw1=(u32x4){PKW(pB0,8),PKW(pB0,10),PKW(pB0,12),PKW(pB0,14)};pw2=(u32x4){PKW(pB1,0),PKW(pB1,2),PKW(pB1,4),PKW(pB1,6)};pw3=(u32x4){PKW(pB1,8),PKW(pB1,10),PKW(pB1,12),PKW(pB1,14)};
    SBAR(); pv(o,vb0+sl_cur,PAF(0),PAF(1),PAF(2),PAF(3)); }
  #undef PKW
  #undef PAF
  #undef VFR
  #undef PIN
  #undef MX3
  #undef GAPA
  #undef GAPB
  #undef EX
  #undef VRD
  #undef KRD
  #undef STEP
  #undef ENDW
  {auto rr=__builtin_amdgcn_permlane32_swap(__float_as_uint(l_reg),__float_as_uint(l_reg),false,false);l_reg=__uint_as_float(rr[0])+__uint_as_float(rr[1]);}
  if(hi==0)wsf[32+r32]=l_reg;asm volatile("s_waitcnt lgkmcnt(0)":::"memory");
  float rli[16];
  #pragma unroll
  for(int r=0;r<16;++r)rli[r]=__builtin_amdgcn_rcpf(wsf[32+crow(r,hi)]);
  bf16*Ow=O+(rowbase+q0+wid*QBLK)*ODM+h*D;
  { bf16*stg=(bf16*)(shm+LDS_OST)+wid*2048;
    #pragma unroll
    for(int r=0;r<16;++r){const int orow=crow(r,hi);
      #pragma unroll
      for(int d0=0;d0<2;++d0)stg[orow*64+d0*32+r32]=__float2bfloat16(o[d0][r]*rli[r]);}
    asm volatile("s_waitcnt lgkmcnt(0)":::"memory");
    #pragma unroll
    for(int i=0;i<4;++i){const int row=i*8+(lane>>3),ch=lane&7; const u32x4 v=*(const u32x4*)(stg+row*64+ch*8); ATTN_STORE16(Ow+(long)row*ODM+ch*8,v);} }
  asm volatile("s_waitcnt lgkmcnt(0)\n\ts_barrier":::"memory");
  #undef DMA_K
  #undef DMA_V
  #undef CMASK
  #undef START
  #undef RESC
  #undef ROT
}
constexpr int ATTN_LDS_BYTES=LDS_BYTES;
struct AttnTensors { const bf16* Q; const bf16* K; const bf16* V; bf16* O; const float* CK; const float* NRM; };
struct AttnUnit { int bh; int qb; };
struct StaticOrder {
  int vcu;
  __device__ __forceinline__ explicit StaticOrder(int grid,int block):vcu((block%8)*(grid/8)+block/8){}
  __device__ __forceinline__ bool next(int i,AttnUnit&u)const{ if(i>=8)return false; const int s=vcu&7,j=i&3; u.bh=(vcu>>3)+32*(i>>2); u.qb=(j==0)?s:(j==1)?15-s:(j==2)?16+s:31-s; return true; }
  __device__ __forceinline__ void a_ready(const AttnUnit&)const{}
  __device__ __forceinline__ void done(const AttnUnit&)const{}
};
struct DynOrder {
  unsigned*ctr; volatile __attribute__((address_space(3))) unsigned*slot; int x;
  __device__ __forceinline__ bool next(int,AttnUnit&u)const{
    if(threadIdx.x==0)*slot=atomicAdd(ctr+64*x,1u);
    __syncthreads(); const unsigned n=*slot; __syncthreads();
    if(n>=256u)return false; const int hs=7-(int)(n>>5), j=(x-hs)&7; u.bh=j*8+hs; u.qb=31-(int)(n&31u); return true; }
  __device__ __forceinline__ void a_ready(const AttnUnit&)const{}
  __device__ __forceinline__ void done(const AttnUnit&)const{}
};
template<class Sched,int THRL=32> __device__ __forceinline__ void attn_phase(char*lds,const AttnTensors&T,const Sched&S){
  AttnUnit u;
  for(int i=0;S.next(i,u);++i){ S.a_ready(u); { const float*nr=T.NRM+u.bh*4; const float tsk=ATTN_SKIP_LOG2+2.f+2.002f*sqrtf((nr[0]+nr[1])*(nr[2]+nr[3])); attn_unit<THRL>(u.bh/NHEAD,u.bh%NHEAD,u.qb,T.Q,T.K,T.V,T.O,lds,T.CK,tsk); } S.done(u); }
}
#undef SBAR
#undef WAIT_BAR
}
namespace cg = cooperative_groups;
#define LAS __attribute__((address_space(3)))
typedef unsigned v4u __attribute__((ext_vector_type(4)));
typedef unsigned v2u __attribute__((ext_vector_type(2)));
typedef float f32x4 __attribute__((ext_vector_type(4)));
using pg8::bf16_t;
#ifndef WGM_WIDE
#define WGM_WIDE 4
#endif
#ifndef WGM_NARROW
#define WGM_NARROW 2
#endif
constexpr int NWAVES = 8, SEQ = 8192, DM = 1024, NB = 8, DFF = 2816, NIN = 5128;
constexpr float LN_EPS = 1e-5f, LOG2E_F = 1.4426950408889634f;
constexpr size_t MiB = 1u << 20;
constexpr size_t WS_MOD = 0, WS_WFT = 512 * 1024, WS_NRM = 768 * 1024, WS_CTR = 772 * 1024, WS_BAR = 800 * 1024, WS_LF = 1 * MiB, WS_CK = 3 * MiB;
constexpr size_t WS_WIN = 6 * MiB, WS_WFS = 16 * MiB, WS_WO = 18 * MiB, WS_WUP = 20 * MiB, WS_WDN = 31 * MiB;
constexpr size_t WS_U = 40 * MiB;
constexpr size_t WS_QKV = 168 * MiB;
constexpr size_t WS_MERGED = WS_QKV + 128 * MiB;
constexpr size_t WS_ACT = WS_QKV;
constexpr size_t WS_G = 552 * MiB;
constexpr size_t WS_H1 = WS_G;
constexpr size_t WS_HALO = 808 * MiB;
constexpr size_t WS_END = 832 * MiB;
constexpr int RING_BYTES = 131072, XCH_OFF = RING_BYTES, MISC_OFF = XCH_OFF + 8192, LDS_BYTES = 147456;

#define LDS_WAIT() asm volatile("s_waitcnt lgkmcnt(0)" ::: "memory")
#define XB_TMO      128
#define XB_XCNT(j)  (256  + 64 * (j))
#define XB_XSUB(j)  (1280 + 64 * (j))
#define XB_XGEN(j)  (2304 + 64 * (j))
#define XB_TOP      3328
#define XB_TOPGEN   3392
#define XCD_BAR_WORDS 3456
#define XB_SPIN_CAP (1u << 18)

__device__ __forceinline__ unsigned xb_ld(unsigned* p)              { return __hip_atomic_load(p, __ATOMIC_RELAXED, __HIP_MEMORY_SCOPE_AGENT); }
__device__ __forceinline__ unsigned xb_add(unsigned* p, unsigned v) { return __hip_atomic_fetch_add(p, v, __ATOMIC_RELAXED, __HIP_MEMORY_SCOPE_AGENT); }
__device__ __forceinline__ unsigned xb_xcc_id() { return (unsigned)__builtin_amdgcn_s_getreg((3 << 11) | 20) & 0xFu; }
#define XB_SPIN(cond, bar) do { unsigned _sp = 0; while (cond) { __builtin_amdgcn_s_sleep(1); \
    if ((++_sp & 255u) == 0u) { if (xb_ld(&(bar)[XB_TMO])) break; if (_sp > XB_SPIN_CAP) { atomicAdd(&(bar)[XB_TMO], 1u); break; } } } } while (0)

struct XcdBarrier {
    unsigned* bar; unsigned x;
    volatile LAS unsigned* st;
};

__device__ __forceinline__ XcdBarrier xcd_barrier_post(unsigned* bar, volatile LAS unsigned* st) {
    XcdBarrier b; b.bar = bar; b.x = xb_xcc_id(); b.st = st;
    if (threadIdx.x == 0) (void)xb_add(&bar[XB_XCNT(b.x)], 1u);
    return b;
}
__device__ __forceinline__ void xcd_barrier_complete(unsigned* bar, unsigned x, unsigned& nloc, unsigned& nx) {
    const unsigned G = gridDim.x * gridDim.y * gridDim.z;
    unsigned sum, cnt, mine, sp = 0u;
    for (;;) {
        sum = 0u; cnt = 0u; mine = 0u;
#pragma unroll
        for (unsigned j = 0; j < 16; ++j) { const unsigned c = xb_ld(&bar[XB_XCNT(j)]); sum += c; cnt += (c > 0u) ? 1u : 0u; mine = (j == x) ? c : mine; }
        if (sum == G) break;
        __builtin_amdgcn_s_sleep(1);
        if ((++sp & 255u) == 0u) { if (xb_ld(&bar[XB_TMO])) break; if (sp > XB_SPIN_CAP) { atomicAdd(&bar[XB_TMO], 1u); break; } }
    }
    nloc = mine > 0u ? mine : 1u; nx = cnt > 0u ? cnt : 1u;
}

__device__ __forceinline__ void xcd_barrier(const XcdBarrier& b) {
    asm volatile("s_waitcnt vmcnt(0)" ::: "memory");
    __syncthreads();
    if (threadIdx.x == 0) {
        unsigned* bar = b.bar;
        __builtin_amdgcn_s_waitcnt(0);
        unsigned nloc = b.st[0], nx = b.st[1];
        if (nloc == 0u) { xcd_barrier_complete(bar, b.x, nloc, nx); b.st[0] = nloc; b.st[1] = nx; }
        const unsigned old = xb_add(&bar[XB_XSUB(b.x)], 1u);
        const unsigned gen = old / nloc;
        if (old + 1u == (gen + 1u) * nloc) {
            __builtin_amdgcn_fence(__ATOMIC_RELEASE, "agent");
            asm volatile("s_waitcnt vmcnt(0)" ::: "memory");
            const unsigned og = xb_add(&bar[XB_TOP], 1u);
            const unsigned tg = og / nx;
            if (og + 1u == (tg + 1u) * nx) xb_add(&bar[XB_TOPGEN], 1u);
            else XB_SPIN(xb_ld(&bar[XB_TOPGEN]) == tg, bar);
            __builtin_amdgcn_fence(__ATOMIC_ACQUIRE, "agent");
            xb_add(&bar[XB_XGEN(b.x)], 1u);
            asm volatile("s_waitcnt vmcnt(0)" ::: "memory");
        } else {
            XB_SPIN(xb_ld(&bar[XB_XGEN(b.x)]) == gen, bar);
            __builtin_amdgcn_fence(__ATOMIC_ACQUIRE, "agent");
            asm volatile("s_waitcnt vmcnt(0)" ::: "memory");
        }
    }
    __syncthreads();
}
__device__ __forceinline__ unsigned f2bf(float f) { unsigned u = __builtin_bit_cast(unsigned, f); return (u + 0x7fffu + ((u >> 16) & 1u)) >> 16; }
__device__ __forceinline__ unsigned pk2(float lo, float hi) { return f2bf(lo) | (f2bf(hi) << 16); }
__device__ __forceinline__ float wave_sum(float v) {
#pragma unroll
    for (int o = 1; o < 64; o <<= 1) v += __shfl_xor(v, o);
    return v;
}
__device__ __forceinline__ void wave_sum4(float (&s)[4]) {
#pragma unroll
    for (int o = 1; o < 64; o <<= 1) {
#pragma unroll
        for (int i = 0; i < 4; ++i) s[i] += __shfl_xor(s[i], o); }
}
__device__ __forceinline__ void tr_item(const float* W, int ldw, int srcc0, int k0, bf16_t* WT, int ldk, int dstr0, LAS float* scr, int lane, int dk0 = 0) {
#pragma unroll 8
    for (int i = 0; i < 32; ++i) { const int kk = 2 * i + (lane >> 5); scr[kk * 33 + (lane & 31)] = W[(size_t)(k0 + kk) * ldw + srcc0 + (lane & 31)]; }
    LDS_WAIT();
    const int c = lane & 7;
#pragma unroll
    for (int j = 0; j < 4; ++j) { const int n = (lane >> 3) + 8 * j; const LAS float* s = scr + (8 * c) * 33 + n;
        v4u o; o.x = pk2(s[0 * 33], s[1 * 33]); o.y = pk2(s[2 * 33], s[3 * 33]); o.z = pk2(s[4 * 33], s[5 * 33]); o.w = pk2(s[6 * 33], s[7 * 33]);
        *(v4u*)(WT + (size_t)(dstr0 + n) * ldk + dk0 + k0 + 8 * c) = o; }
    LDS_WAIT();
}

constexpr float SB_STICK_MIN = 3.3881318e-21f;
typedef short s16x8 __attribute__((ext_vector_type(8)));
typedef float f32x16 __attribute__((ext_vector_type(16)));
__device__ __forceinline__ int crow16(int r, int hi) { return (r & 3) + 8 * (r >> 2) + 4 * hi; }
template <bool DIAG> __device__ __forceinline__ float sb_weights(const f32x16& s, int k0, int q, int hi, float C, float (&av)[16]) {
    float uv[16], bt[16], sfx[16], own[4], oth[4], sufg[4];
#pragma unroll
    for (int r = 0; r < 16; ++r) { const float zz = __builtin_fminf(s[r], 100.f), ex = __builtin_amdgcn_exp2f(zz), ui = __builtin_amdgcn_rcpf(1.0f + ex);
        if (DIAG) { const bool valid = (k0 + crow16(r, hi)) < q; uv[r] = valid ? ui : 1.0f; bt[r] = valid ? ex * ui : 0.f; } else { uv[r] = ui; bt[r] = ex * ui; } }
#pragma unroll
    for (int i = 0; i < 4; ++i) { const float a3 = uv[4 * i + 3], a2 = a3 * uv[4 * i + 2], a1 = a2 * uv[4 * i + 1]; own[i] = a1 * uv[4 * i];
        sfx[4 * i + 3] = bt[4 * i + 3]; sfx[4 * i + 2] = bt[4 * i + 2] * a3; sfx[4 * i + 1] = bt[4 * i + 1] * a2; sfx[4 * i] = bt[4 * i] * a1; }
#pragma unroll
    for (int i = 0; i < 4; ++i) oth[i] = __shfl_xor(own[i], 32);
    float accs = C;
#pragma unroll
    for (int i = 3; i >= 0; --i) { sufg[i] = (hi == 0) ? accs * oth[i] : accs; accs *= own[i] * oth[i]; }
#pragma unroll
    for (int r = 0; r < 16; ++r) av[r] = sfx[r] * sufg[r >> 2];
    return accs;
}
__device__ __forceinline__ void sb_unit(int b, int h, int qblk, const bf16_t* Q, const bf16_t* __restrict__ K, const bf16_t* __restrict__ V, bf16_t* O, LAS unsigned char* vst, int lane_) {
    int lane = lane_; asm volatile("" : "+v"(lane));
    const int r32 = lane & 31, hi = lane >> 5; const size_t rowbase = (size_t)b * SEQ; const int qw0 = qblk * 32, q = qw0 + r32;
    const bf16_t* Qw = Q + (rowbase + qw0) * 512 + h * 64;
    s16x8 qr[4];
#pragma unroll
    for (int d0 = 0; d0 < 4; ++d0) qr[d0] = *(const s16x8*)(Qw + (size_t)r32 * 512 + d0 * 16 + hi * 8);
    f32x16 o0 = {}, o1 = {}; float C = 1.f;
    s16x8 kn[4]; v4u vn[4];
    { const bf16_t* Kp = K + (rowbase + qblk * 32 + r32) * 512 + h * 64 + hi * 8;
#pragma unroll
      for (int d0 = 0; d0 < 4; ++d0) kn[d0] = *(const s16x8*)(Kp + d0 * 16);
#pragma unroll
      for (int i = 0; i < 4; ++i) { const int c = lane + 64 * i; vn[i] = *(const v4u*)(V + (rowbase + qblk * 32 + (c >> 3)) * 512 + h * 64 + (c & 7) * 8); } }
    for (int jt = qblk; jt >= 0; --jt) {
        const int k0 = jt * 32;
        s16x8 kf[4];
#pragma unroll
        for (int d0 = 0; d0 < 4; ++d0) kf[d0] = kn[d0];
#pragma unroll
        for (int i = 0; i < 4; ++i) { const int c = lane + 64 * i, key = c >> 3, part = c & 7; *(LAS v4u*)(vst + key * 144 + part * 16) = vn[i]; }
        if (jt > 0) { const bf16_t* Kp = K + (rowbase + k0 - 32 + r32) * 512 + h * 64 + hi * 8;
#pragma unroll
            for (int d0 = 0; d0 < 4; ++d0) kn[d0] = *(const s16x8*)(Kp + d0 * 16);
#pragma unroll
            for (int i = 0; i < 4; ++i) { const int c = lane + 64 * i; vn[i] = *(const v4u*)(V + (rowbase + k0 - 32 + (c >> 3)) * 512 + h * 64 + (c & 7) * 8); } }
        f32x16 s = {};
#pragma unroll
        for (int d0 = 0; d0 < 4; ++d0) s = __builtin_amdgcn_mfma_f32_32x32x16_bf16(kf[d0], qr[d0], s, 0, 0, 0);
        float av[16];
        if (jt == qblk) C = sb_weights<true>(s, k0, q, hi, C, av); else C = sb_weights<false>(s, k0, q, hi, C, av);
        v4u pa0, pa1;
        pa0.x = pg8::cvt_pk_bf16(av[0], av[1]); pa0.y = pg8::cvt_pk_bf16(av[2], av[3]); pa0.z = pg8::cvt_pk_bf16(av[4], av[5]); pa0.w = pg8::cvt_pk_bf16(av[6], av[7]);
        pa1.x = pg8::cvt_pk_bf16(av[8], av[9]); pa1.y = pg8::cvt_pk_bf16(av[10], av[11]); pa1.z = pg8::cvt_pk_bf16(av[12], av[13]); pa1.w = pg8::cvt_pk_bf16(av[14], av[15]);
        LDS_WAIT();
#pragma unroll
        for (int ks = 0; ks < 2; ++ks)
#pragma unroll
            for (int d0 = 0; d0 < 2; ++d0) { unsigned short e[8];
#pragma unroll
                for (int j = 0; j < 8; ++j) e[j] = *(const LAS unsigned short*)(vst + (16 * ks + 8 * (j >> 2) + 4 * hi + (j & 3)) * 144 + (32 * d0 + r32) * 2);
                v4u vb; vb.x = e[0] | ((unsigned)e[1] << 16); vb.y = e[2] | ((unsigned)e[3] << 16); vb.z = e[4] | ((unsigned)e[5] << 16); vb.w = e[6] | ((unsigned)e[7] << 16);
                const s16x8 pa = __builtin_bit_cast(s16x8, ks == 0 ? pa0 : pa1), vf = __builtin_bit_cast(s16x8, vb);
                if (d0 == 0) o0 = __builtin_amdgcn_mfma_f32_32x32x16_bf16(pa, vf, o0, 0, 0, 0); else o1 = __builtin_amdgcn_mfma_f32_32x32x16_bf16(pa, vf, o1, 0, 0, 0); }
        LDS_WAIT();
        if (__all((SKIP_LOG2 >= 149.f) ? (C == 0.f) : (C < SB_STICK_MIN))) break;
    }
    bf16_t* Ow = O + (rowbase + qw0) * 1024 + 512 + h * 64;
#pragma unroll
    for (int r = 0; r < 16; ++r) { const int orow = crow16(r, hi);
        Ow[(size_t)orow * 1024 + r32] = (bf16_t)f2bf(o0[r]); Ow[(size_t)orow * 1024 + 32 + r32] = (bf16_t)f2bf(o1[r]); }
}

struct Args { const float* in[17]; float* out; unsigned char* ws; };

__global__ void __launch_bounds__(NWAVES * 64, 2) fwd_mega(Args args) {
    extern __shared__ __attribute__((aligned(16))) unsigned char lds[];
    cg::grid_group grid = cg::this_grid();
    LAS unsigned char* L = (LAS unsigned char*)lds;
    const int tid = threadIdx.x, lane = tid & 63, wave = __builtin_amdgcn_readfirstlane(tid >> 6);
    const int G = gridDim.x, gw = blockIdx.x * NWAVES + wave, NGW = G * NWAVES;
    unsigned char* ws = args.ws;
    volatile LAS unsigned* xst = (volatile LAS unsigned*)(L + MISC_OFF + 512);
    if (tid == 0) { xst[0] = 0u; xst[1] = 0u; }
    __syncthreads();
    const XcdBarrier xbar = xcd_barrier_post((unsigned*)(ws + WS_BAR), xst);
#if defined(PROBE_AT)
    if (blockIdx.x == 0 && tid == 0) { *(volatile LAS unsigned long long*)(L + MISC_OFF + 256) = __builtin_amdgcn_s_memrealtime(); }
#define PROBE_MARK(k) do { if ((k) == PROBE_AT && blockIdx.x == 0 && tid == 0) { *(volatile LAS unsigned long long*)(L + MISC_OFF + 264) = __builtin_amdgcn_s_memrealtime(); } } while (0)
#else
#define PROBE_MARK(k) do {} while (0)
#endif
    const float* x = args.in[0]; const float* cvec = args.in[1]; const float* w_ada = args.in[2]; const float* b_ada = args.in[3]; const float* w_in = args.in[4];
    const float* b_forget = args.in[5]; const float* w_fox = args.in[6]; const float* w_sb = args.in[7]; const float* w_o = args.in[8];
    const float* ln1_g = args.in[9]; const float* ln1_b = args.in[10]; const float* w_up = args.in[11]; const float* conv_w = args.in[12]; const float* conv_b = args.in[13];
    const float* w_dn = args.in[14]; const float* ln2_g = args.in[15]; const float* ln2_b = args.in[16];
    float* MOD = (float*)(ws + WS_MOD); float* WFT = (float*)(ws + WS_WFT); float* LF = (float*)(ws + WS_LF); float* CK = (float*)(ws + WS_CK);
    bf16_t* WIN = (bf16_t*)(ws + WS_WIN); bf16_t* WFS = (bf16_t*)(ws + WS_WFS); bf16_t* WO = (bf16_t*)(ws + WS_WO); bf16_t* WUP = (bf16_t*)(ws + WS_WUP); bf16_t* WDN = (bf16_t*)(ws + WS_WDN);
    bf16_t* U = (bf16_t*)(ws + WS_U); bf16_t* QKV = (bf16_t*)(ws + WS_QKV); bf16_t* MERGED = (bf16_t*)(ws + WS_MERGED); bf16_t* ACT = (bf16_t*)(ws + WS_ACT);
    bf16_t* GATES = (bf16_t*)(ws + WS_G); float* H1 = (float*)(ws + WS_H1);
    const size_t SLOT = (size_t)MTOK * 512;
    bf16_t* QA = QKV; bf16_t* QB = QKV + SLOT; bf16_t* KA = QKV + 2 * SLOT; bf16_t* VA = QKV + 3 * SLOT; bf16_t* KB = QKV + 4 * SLOT; bf16_t* VB = QKV + 5 * SLOT;

#if !defined(SKIP_P0)
    {
        LAS float* scr = (LAS float*)(L + wave * 16384);
        constexpr int I_IN = 16 * 160, I_FS = 8 * 32, I_O = 16 * 32, I_UP = 16 * 176, I_DN = 44 * 32, I_MOD = 768;
        constexpr int NIT = I_MOD + I_IN + 2 * I_FS + I_O + I_UP + I_DN;
        for (int it = gw; it < NIT; it += NGW) {
            int r = it;
            if (r < I_MOD) {
                const int j0 = 8 * r; float a[8][8];
#pragma unroll
                for (int bb = 0; bb < 8; ++bb)
#pragma unroll
                    for (int j = 0; j < 8; ++j) a[bb][j] = 0.f;
#pragma unroll 4
                for (int i = 0; i < 16; ++i) { const int k = lane + 64 * i; const f32x4 w0 = *(const f32x4*)(w_ada + (size_t)k * 6144 + j0), w1 = *(const f32x4*)(w_ada + (size_t)k * 6144 + j0 + 4);
#pragma unroll
                    for (int bb = 0; bb < 8; ++bb) { const float cb = cvec[bb * 1024 + k];
                        a[bb][0] += cb * w0[0]; a[bb][1] += cb * w0[1]; a[bb][2] += cb * w0[2]; a[bb][3] += cb * w0[3]; a[bb][4] += cb * w1[0]; a[bb][5] += cb * w1[1]; a[bb][6] += cb * w1[2]; a[bb][7] += cb * w1[3]; } }
                float mine = 0.f;
#pragma unroll
                for (int bb = 0; bb < 8; ++bb)
#pragma unroll
                    for (int j = 0; j < 8; ++j) { const float s = wave_sum(a[bb][j]); if (lane == bb * 8 + j) mine = s; }
                MOD[(lane >> 3) * 6144 + j0 + (lane & 7)] = mine + b_ada[j0 + (lane & 7)];
                continue;
            }
            r -= I_MOD;
            if (r < I_IN) { const int kb = r / 160, nb = r % 160, n0 = 32 * nb; const int t = n0 - 3072;
                const int src = (n0 < 1536) ? n0 : (n0 < 3072) ? n0 + 8 : 3080 + ((t >> 7) & 1) * 1024 + 128 * (t >> 8) + (t & 127);
                tr_item(w_in, NIN, src, 64 * kb, WIN, 1024, n0, scr, lane); continue; } r -= I_IN;
            if (r < I_FS) { const int kb = r / 32, nb = r % 32; tr_item(w_fox, 1024, 32 * nb, 64 * kb, WFS, 1024, 32 * nb, scr, lane, 0); continue; } r -= I_FS;
            if (r < I_FS) { const int kb = r / 32, nb = r % 32; tr_item(w_sb, 1024, 32 * nb, 64 * kb, WFS, 1024, 32 * nb, scr, lane, 512); continue; } r -= I_FS;
            if (r < I_O) { const int kb = r / 32, nb = r % 32; tr_item(w_o, 1024, 32 * nb, 64 * kb, WO, 1024, 32 * nb, scr, lane); continue; } r -= I_O;
            if (r < I_UP) { const int kb = r / 176, nb = r % 176, nn0 = 32 * nb; const int src = ((nn0 >> 7) & 1) * DFF + 128 * (nn0 >> 8) + (nn0 & 127);
                tr_item(w_up, 2 * DFF, src, 64 * kb, WUP, 1024, nn0, scr, lane); continue; } r -= I_UP;
            { const int kb = r / 32, nb = r % 32; tr_item(w_dn, 1024, 32 * nb, 64 * kb, WDN, DFF, 32 * nb, scr, lane); }
        }
        if (blockIdx.x == 0) { ((float*)(ws + WS_NRM))[tid & 255] = 0.f; ((unsigned*)(ws + WS_CTR))[tid] = 0u; }
        for (int e = blockIdx.x * (NWAVES * 64) + tid; e < 8192; e += G * NWAVES * 64) WFT[e] = w_in[(size_t)(e & 1023) * NIN + 1536 + (e >> 10)];
    }
#endif
    if (G == 0x7fffffff) grid.sync();
    xcd_barrier(xbar);
    PROBE_MARK(0);

#if !defined(SKIP_P1)
    LAS f32x4* wfl = (LAS f32x4*)L;
    for (int i = tid; i < 2048; i += NWAVES * 64) wfl[i] = ((const f32x4*)WFT)[i];
    __syncthreads();
    for (int blk = gw; blk < MTOK / 32; blk += NGW) {
        const int m0 = blk * 32, b = m0 >> 13; const float* mb = MOD + (size_t)b * 6144;
        const float bf = b_forget[lane & 7];
        f32x4 xn[4];
#pragma unroll
        for (int j = 0; j < 4; ++j) xn[j] = ((const f32x4*)(x + (size_t)m0 * 1024) + lane)[64 * j];
        for (int r = 0; r < 32; ++r) {
            const int m = m0 + r; unsigned long long* o8 = (unsigned long long*)(U + (size_t)m * 1024) + lane;
            f32x4 u[4], xc[4];
#pragma unroll
            for (int j = 0; j < 4; ++j) xc[j] = xn[j];
            if (r < 31) {
#pragma unroll
                for (int j = 0; j < 4; ++j) xn[j] = ((const f32x4*)(x + (size_t)(m + 1) * 1024) + lane)[64 * j]; }
#pragma unroll
            for (int j = 0; j < 4; ++j) { const f32x4 shj = *(const f32x4*)(mb + 4 * lane + 256 * j), scj = *(const f32x4*)(mb + 1024 + 4 * lane + 256 * j) + 1.0f; u[j] = xc[j] * scj + shj; o8[64 * j] = (unsigned long long)pk2(u[j][0], u[j][1]) | ((unsigned long long)pk2(u[j][2], u[j][3]) << 32); }
            float mine = 0.f;
#pragma unroll
            for (int hh = 0; hh < 8; ++hh) { float s = 0.f;
#pragma unroll
                for (int j = 0; j < 4; ++j) { const f32x4 p = u[j] * wfl[hh * 256 + lane + 64 * j]; s += (p[0] + p[1]) + (p[2] + p[3]); }
                s = wave_sum(s); if ((lane & 7) == hh) mine = s; }
            if (lane < 8) { const float f = mine + bf; const float ls = (f >= 0.f) ? -log1pf(expf(-f)) : (f - log1pf(expf(f)));
                LF[((size_t)(b * 8 + lane)) * SEQ + (m & (SEQ - 1))] = ls * LOG2E_F; }
        }
    }
#endif
    xcd_barrier(xbar);
    PROBE_MARK(1);

#if !defined(SKIP_P2)
    if (blockIdx.x < 64) {
        LAS double* sm = (LAS double*)(L + MISC_OFF);
        const float* src = LF + (size_t)blockIdx.x * SEQ + 16 * tid; float* dst = CK + (size_t)blockIdx.x * SEQ + 16 * tid;
        f32x4 v[4]; double loc[16]; double run = 0.0;
#pragma unroll
        for (int j = 0; j < 4; ++j) v[j] = *(const f32x4*)(src + 4 * j);
#pragma unroll
        for (int i = 0; i < 16; ++i) { run += (double)v[i >> 2][i & 3]; loc[i] = run; }
        double inc = run;
#pragma unroll
        for (int o = 1; o < 64; o <<= 1) { const double t = __shfl_up(inc, o); if (lane >= o) inc += t; }
        if (lane == 63) sm[wave] = inc;
        __syncthreads();
        double woff = 0.0;
        for (int w = 0; w < wave; ++w) woff += sm[w];
        const double excl = woff + inc - run;
#pragma unroll
        for (int j = 0; j < 4; ++j) *(f32x4*)(dst + 4 * j) = (f32x4){(float)(excl + loc[4 * j]), (float)(excl + loc[4 * j + 1]), (float)(excl + loc[4 * j + 2]), (float)(excl + loc[4 * j + 3])};
        __syncthreads();
    }
    {
        pg8::Gemm g{U, WIN, MTOK, 5120, 1024, (size_t)256 * 1024 * 2}; pg8::StaticOrder S; S.init(MTOK, 5120, G, (int)blockIdx.x); S.wgm = WGM_WIDE;
        pg8::EpiInProj E{QKV, GATES, (unsigned*)(ws + WS_NRM)};
        pg8::gemm_phase<pg8::EpiInProj, pg8::StaticOrder, true, true>(L, g, S, E);
    }
#endif
    xcd_barrier(xbar);
    PROBE_MARK(2);

#if !defined(SKIP_P3)
    {
        LAS unsigned char* vst = L + wave * 4608;
        for (int i = 0; i < (64 * 256) / NGW + 1; ++i) { const int uid = i * NGW + gw; if (uid >= 64 * 256) break; const int bh = uid >> 8, qblk = uid & 255;
            sb_unit(bh >> 3, bh & 7, qblk, QB, KB, VB, U, vst, lane); }
        __syncthreads();
        PROBE_MARK(20);
        const attn_body::AttnTensors AT{(const attn_body::bf16*)QA, (const attn_body::bf16*)KA, (const attn_body::bf16*)VA, (attn_body::bf16*)U, CK, (const float*)(ws + WS_NRM)};
        const attn_body::DynOrder S{(unsigned*)(ws + WS_CTR), (volatile LAS unsigned*)(L + MISC_OFF + 128), (int)(blockIdx.x & 7)};
        attn_body::attn_phase<attn_body::DynOrder>((char*)lds, AT, S);
    }
#endif
    xcd_barrier(xbar);
    PROBE_MARK(3);

#if !defined(SKIP_P4)
    {
        pg8::Gemm g{U, WFS, MTOK, 1024, 1024, (size_t)256 * 1024 * 2}; pg8::StaticOrder S; S.init(MTOK, 1024, G, (int)blockIdx.x); S.wgm = WGM_NARROW;
        pg8::EpiMerge E{GATES, MERGED};
        pg8::gemm_phase<pg8::EpiMerge, pg8::StaticOrder, true, true>(L, g, S, E);
    }
#endif
    xcd_barrier(xbar);
    PROBE_MARK(4);

#if !defined(SKIP_P5)
    {
        pg8::Gemm g{MERGED, WO, MTOK, 1024, 1024, (size_t)256 * 1024 * 2}; pg8::StaticOrder S; S.init(MTOK, 1024, G, (int)blockIdx.x); S.wgm = WGM_NARROW;
        pg8::EpiBranch E{MOD + 2048, U};
        pg8::gemm_phase<pg8::EpiBranch, pg8::StaticOrder, true, true>(L, g, S, E);
    }
#endif
    xcd_barrier(xbar);
    PROBE_MARK(5);

#if !defined(SKIP_P6)
    for (int blk = gw; blk < MTOK / 32; blk += NGW) {
        const int m0 = blk * 32, b = m0 >> 13; const float* mb = MOD + (size_t)b * 6144;
        f32x4 sc[4], sh[4], lg[4], lb[4];
#pragma unroll
        for (int j = 0; j < 4; ++j) { sh[j] = *(const f32x4*)(mb + 3072 + 4 * lane + 256 * j); sc[j] = *(const f32x4*)(mb + 4096 + 4 * lane + 256 * j) + 1.0f;
            lg[j] = *(const f32x4*)(ln1_g + 4 * lane + 256 * j); lb[j] = *(const f32x4*)(ln1_b + 4 * lane + 256 * j); }
        for (int g4 = 0; g4 < 8; ++g4) {
            const int mg = m0 + 4 * g4;
            f32x4 v[4][4]; unsigned long long bb[4][4];
#pragma unroll
            for (int i = 0; i < 4; ++i)
#pragma unroll
                for (int j = 0; j < 4; ++j) { v[i][j] = ((const f32x4*)(x + (size_t)(mg + i) * 1024) + lane)[64 * j]; bb[i][j] = ((const unsigned long long*)(U + (size_t)(mg + i) * 1024) + lane)[64 * j]; }
            float s[4], s2[4];
#pragma unroll
            for (int i = 0; i < 4; ++i) { s[i] = 0.f;
#pragma unroll
                for (int j = 0; j < 4; ++j) { const unsigned blo = (unsigned)bb[i][j], bhi = (unsigned)(bb[i][j] >> 32);
                    v[i][j] = v[i][j] * DN_ALPHA + (f32x4){pg8::bflo(blo), pg8::bfhi(blo), pg8::bflo(bhi), pg8::bfhi(bhi)}; s[i] += (v[i][j][0] + v[i][j][1]) + (v[i][j][2] + v[i][j][3]); } }
            wave_sum4(s);
#pragma unroll
            for (int i = 0; i < 4; ++i) { const float mean = s[i] * (1.f / 1024.f); s2[i] = 0.f;
#pragma unroll
                for (int j = 0; j < 4; ++j) { v[i][j] = v[i][j] - mean; s2[i] += (v[i][j][0] * v[i][j][0] + v[i][j][1] * v[i][j][1]) + (v[i][j][2] * v[i][j][2] + v[i][j][3] * v[i][j][3]); } }
            wave_sum4(s2);
#pragma unroll
            for (int i = 0; i < 4; ++i) { const float rstd = 1.f / sqrtf(s2[i] * (1.f / 1024.f) + LN_EPS);
                unsigned long long* hr = (unsigned long long*)((bf16_t*)H1 + (size_t)(mg + i) * 1024) + lane; unsigned long long* o8 = (unsigned long long*)(U + (size_t)(mg + i) * 1024) + lane;
#pragma unroll
                for (int j = 0; j < 4; ++j) { const f32x4 x1 = v[i][j] * rstd * lg[j] + lb[j]; hr[64 * j] = (unsigned long long)pk2(x1[0], x1[1]) | ((unsigned long long)pk2(x1[2], x1[3]) << 32);
                    const f32x4 u2 = x1 * sc[j] + sh[j]; o8[64 * j] = (unsigned long long)pk2(u2[0], u2[1]) | ((unsigned long long)pk2(u2[2], u2[3]) << 32); } }
        }
    }
#endif
    xcd_barrier(xbar);
    PROBE_MARK(6);

#if !defined(SKIP_P7)
    {
        pg8::Gemm g{U, WUP, MTOK, 2 * DFF, 1024, (size_t)256 * 1024 * 2}; pg8::StaticOrder S; S.init(MTOK, 2 * DFF, G, (int)blockIdx.x); S.wgm = WGM_WIDE;
        pg8::EpiUpConv E{conv_w, conv_b, ACT, (LAS f32x4*)(L + XCH_OFF), (LAS float*)(L + MISC_OFF + 1024), (float*)(ws + WS_HALO)};
        pg8::gemm_phase<pg8::EpiUpConv, pg8::StaticOrder, true, true>(L, g, S, E);
    }
    xcd_barrier(xbar);
    {
        const float* HALO = (const float*)(ws + WS_HALO);
        for (int idx = blockIdx.x * (NWAVES * 64) + tid; idx < 43 * DFF; idx += G * NWAVES * 64) {
            const int pg = idx / DFF, ch = idx - pg * DFF, nng = 256 * (ch >> 7) + (ch & 127);
            float w0[2], w1[2], w2[2], bb[2];
#pragma unroll
            for (int v = 0; v < 2; ++v) { const int cc = ch + DFF * v; w0[v] = conv_w[cc]; w1[v] = conv_w[5632 + cc]; w2[v] = conv_w[2 * 5632 + cc]; bb[v] = conv_b[cc]; }
            float h0[6][2], h1[6][2], hm2[6][2], hm1[6][2];
#pragma unroll
            for (int k = 0; k < 6; ++k) { const int p = 6 * pg + k; const bool in = p < 256, s0 = (p & 31) == 0;
                const float* Hc = HALO + (size_t)(in ? p : 0) * 4 * 5632; const float* Hp = Hc - (s0 ? 0 : 4 * 5632);
#pragma unroll
                for (int v = 0; v < 2; ++v) { const int nn = nng + 128 * v; h0[k][v] = Hc[nn]; h1[k][v] = Hc[5632 + nn]; hm2[k][v] = Hp[2 * 5632 + nn]; hm1[k][v] = Hp[3 * 5632 + nn]; } }
#pragma unroll
            for (int k = 0; k < 6; ++k) { const int p = 6 * pg + k; if (p >= 256) break; const bool s0 = (p & 31) == 0; float cr0[2], cr1[2];
#pragma unroll
                for (int v = 0; v < 2; ++v) { const float a2 = s0 ? 0.f : hm2[k][v], a1 = s0 ? 0.f : hm1[k][v];
                    cr0[v] = bb[v] + w0[v] * a2 + w1[v] * a1 + w2[v] * h0[k][v]; cr1[v] = bb[v] + w0[v] * a1 + w1[v] * h0[k][v] + w2[v] * h1[k][v]; }
                ACT[(size_t)(256 * p) * DFF + ch] = (bf16_t)f2bf(cr0[0] * pg8::sigm(cr0[0]) * cr0[1]);
                ACT[(size_t)(256 * p + 1) * DFF + ch] = (bf16_t)f2bf(cr1[0] * pg8::sigm(cr1[0]) * cr1[1]); }
        }
    }
#endif
    xcd_barrier(xbar);
    PROBE_MARK(7);

#if !defined(SKIP_P8)
    {
        pg8::Gemm g{ACT, WDN, MTOK, 1024, DFF, (size_t)256 * DFF * 2}; pg8::StaticOrder S; S.init(MTOK, 1024, G, (int)blockIdx.x); S.wgm = WGM_NARROW;
        pg8::EpiBranch E{MOD + 5120, U};
        pg8::gemm_phase<pg8::EpiBranch, pg8::StaticOrder, true, true>(L, g, S, E);
    }
#endif
    xcd_barrier(xbar);
    PROBE_MARK(8);

#if !defined(SKIP_P9)
    {
        f32x4 lg[4], lb[4]; const bf16_t* X1B = (const bf16_t*)H1;
#pragma unroll
        for (int j = 0; j < 4; ++j) { lg[j] = *(const f32x4*)(ln2_g + 4 * lane + 256 * j); lb[j] = *(const f32x4*)(ln2_b + 4 * lane + 256 * j); }
        for (int blk = gw; blk < MTOK / 32; blk += NGW)
        for (int g4 = 0; g4 < 8; ++g4) {
            const int mg = blk * 32 + 4 * g4;
            unsigned long long xb[4][4], bb[4][4];
#pragma unroll
            for (int i = 0; i < 4; ++i)
#pragma unroll
                for (int j = 0; j < 4; ++j) { xb[i][j] = ((const unsigned long long*)(X1B + (size_t)(mg + i) * 1024) + lane)[64 * j]; bb[i][j] = ((const unsigned long long*)(U + (size_t)(mg + i) * 1024) + lane)[64 * j]; }
            f32x4 v[4][4]; float s[4], s2[4];
#pragma unroll
            for (int i = 0; i < 4; ++i) { s[i] = 0.f;
#pragma unroll
                for (int j = 0; j < 4; ++j) { const unsigned xlo = (unsigned)xb[i][j], xhi = (unsigned)(xb[i][j] >> 32), blo = (unsigned)bb[i][j], bhi = (unsigned)(bb[i][j] >> 32);
                    v[i][j] = (f32x4){pg8::bflo(xlo), pg8::bfhi(xlo), pg8::bflo(xhi), pg8::bfhi(xhi)} * DN_ALPHA + (f32x4){pg8::bflo(blo), pg8::bfhi(blo), pg8::bflo(bhi), pg8::bfhi(bhi)};
                    s[i] += (v[i][j][0] + v[i][j][1]) + (v[i][j][2] + v[i][j][3]); } }
            wave_sum4(s);
#pragma unroll
            for (int i = 0; i < 4; ++i) { const float mean = s[i] * (1.f / 1024.f); s2[i] = 0.f;
#pragma unroll
                for (int j = 0; j < 4; ++j) { v[i][j] = v[i][j] - mean; s2[i] += (v[i][j][0] * v[i][j][0] + v[i][j][1] * v[i][j][1]) + (v[i][j][2] * v[i][j][2] + v[i][j][3] * v[i][j][3]); } }
            wave_sum4(s2);
#pragma unroll
            for (int i = 0; i < 4; ++i) { const float rstd = 1.f / sqrtf(s2[i] * (1.f / 1024.f) + LN_EPS); f32x4* hr = (f32x4*)(args.out + (size_t)(mg + i) * 1024) + lane;
#pragma unroll
                for (int j = 0; j < 4; ++j) hr[64 * j] = v[i][j] * rstd * lg[j] + lb[j]; }
        }
    }
#endif
#if defined(PROBE_AT)
    if (blockIdx.x == 0 && tid == 0) { const unsigned long long a = *(volatile LAS unsigned long long*)(L + MISC_OFF + 256), b = *(volatile LAS unsigned long long*)(L + MISC_OFF + 264);
        const unsigned long long t1 = __builtin_amdgcn_s_memrealtime(); while (__builtin_amdgcn_s_memrealtime() - t1 < 2 * (b - a)) __builtin_amdgcn_s_sleep(8); }
#endif
}

extern "C" void kernel_launch(void* const* d_in, const int* in_sizes, int n_in, void* d_out, int out_size, void* d_ws, size_t ws_size, hipStream_t stream) {
    static int grid = 0;
    if (grid == 0) {
        if (n_in != 17 || out_size != MTOK * 1024 || ws_size < WS_END) { fprintf(stderr, "kernel_launch: unexpected shapes (n_in %d out %d ws %zu)\n", n_in, out_size, ws_size); grid = -1; return; }
        int dev = 0, cus = 0, per_cu = 0;
        hipGetDevice(&dev); hipDeviceGetAttribute(&cus, hipDeviceAttributeMultiprocessorCount, dev);
        if (hipFuncSetAttribute((const void*)fwd_mega, hipFuncAttributeMaxDynamicSharedMemorySize, LDS_BYTES) != hipSuccess) { fprintf(stderr, "kernel_launch: hipFuncSetAttribute failed\n"); grid = -1; return; }
        hipOccupancyMaxActiveBlocksPerMultiprocessor(&per_cu, (const void*)fwd_mega, NWAVES * 64, LDS_BYTES);
        (void)hipGetLastError();
        if (per_cu < 1) per_cu = 1;
        grid = cus * 1;
    }
    if (grid < 0) return;
    if (hipMemsetAsync((char*)d_ws + WS_BAR, 0, XCD_BAR_WORDS * 4, stream) != hipSuccess) { fprintf(stderr, "kernel_launch: memset of the barrier words failed\n"); return; }
    Args a{};
    for (int i = 0; i < 17; ++i) a.in[i] = (const float*)d_in[i];
    a.out = (float*)d_out; a.ws = (unsigned char*)d_ws;
    void* kargs[] = {&a};
    hipError_t e = hipLaunchCooperativeKernel((const void*)fwd_mega, dim3(grid), dim3(NWAVES * 64), kargs, LDS_BYTES, stream);
    if (e != hipSuccess) fprintf(stderr, "cooperative launch failed: %s (grid %d)\n", hipGetErrorString(e), grid);
}
```

```cpp
#include <hip/hip_runtime.h>
#include <hip/hip_cooperative_groups.h>
#include <cstdio>
#include <cstdint>
constexpr int MTOK = 65536;
constexpr float DN_ALPHA = 1.189207115002721f;
#ifndef SKIP_LOG2
#define SKIP_LOG2 68.0f
#endif
namespace pg8 {
#define PG8_LAS __attribute__((address_space(3)))
typedef unsigned short bf16_t;
typedef short bf16x8 __attribute__((ext_vector_type(8)));
typedef float f32x4 __attribute__((ext_vector_type(4)));
typedef unsigned u32x4 __attribute__((ext_vector_type(4)));
constexpr int BM = 256, BK = 64, HALF = 128, HTB = HALF * BK * 2  , STAGE_BYTES = 8 * HTB, NXCD = 8, WGM = 8;

__host__ __device__ __forceinline__ int lds_byte(int r, int c) { const int st = (r >> 4) * 2 + (c >> 5), rr = r & 15, cc = c & 31, ob = rr * 64 + cc * 2; return st * 1024 + (ob ^ (((ob >> 9) & 1) << 5)); }
__host__ __device__ __forceinline__ void stage_rc(int b, int& R, int& C) { const int st = b / 1024, sb = b % 1024, swz = sb ^ (((sb >> 9) & 1) << 5); R = (st >> 1) * 16 + swz / 64; C = (st & 1) * 32 + (swz % 64) / 2; }
__host__ __device__ __forceinline__ int perm32(int rho) { const int n = rho >> 4, i = rho & 15; return 8 * (i >> 2) + 4 * n + (i & 3); }

struct Unit { int pm, pn; };
struct Gemm { const bf16_t* A; const bf16_t* Bt; int M, N, K; size_t a_tstep; };

struct StaticOrder {
    int nM, nN, nwg, G, c, wgm = WGM;
    __host__ __device__ void init(int M, int N, int G_, int c_) { nM = M / BM; nN = N / BM; nwg = nM * nN; G = G_; c = c_; }
    __host__ __device__ void init_tiles(int nM_, int nN_, int G_, int c_) { nM = nM_; nN = nN_; nwg = nM * nN; G = G_; c = c_; }
    __host__ __device__ bool next(int i, Unit& u) const {
        const long L = (long)i * G + c; if (L >= nwg) return false;
        int wgid = (int)L; { const int q = nwg / NXCD, r = nwg % NXCD, xcd = wgid % NXCD, off = wgid / NXCD; wgid = (xcd < r ? xcd * (q + 1) : r * (q + 1) + (xcd - r) * q) + off; }
        const int nig = wgm * nN, gid = wgid / nig, fm = gid * wgm, gsz = (nM - fm) < wgm ? (nM - fm) : wgm;
        u.pm = fm + ((wgid % nig) % gsz); u.pn = (wgid % nig) / gsz; return true;
    }
    __device__ __forceinline__ void a_ready(const Unit&) const {}
    __device__ __forceinline__ void done(const Unit&) const {}
};

__device__ __forceinline__ unsigned cvt_pk_bf16(float lo, float hi) { unsigned r; asm volatile("v_cvt_pk_bf16_f32 %0, %1, %2" : "=v"(r) : "v"(lo), "v"(hi)); return r; }
typedef float f32x2 __attribute__((ext_vector_type(2)));
constexpr float C2f = 0.125f * 1.4426950408889634f;
constexpr float LOG2E = 1.4426950408889634f;
__device__ __forceinline__ float sigm(float v) { return __builtin_amdgcn_rcpf(1.0f + __builtin_amdgcn_exp2f(-LOG2E * v)); }
__device__ __forceinline__ float bflo(unsigned w) { return __builtin_bit_cast(float, w << 16); }
__device__ __forceinline__ float bfhi(unsigned w) { return __builtin_bit_cast(float, w & 0xffff0000u); }

struct EpiInProj {
    static constexpr bool PERM = true, AFTER_DRAIN = false, HAS_MID = false;
    bf16_t* qkv; bf16_t* gates; unsigned* nrm;
    __device__ __forceinline__ void operator()(const f32x4 (&acc)[2][2][4][2], const Unit& u, int wr, int wc, int fr, int fq) const {
        const int pn = u.pn; bf16_t* base; int ldc, colt; float sc = 1.f; bool sg = false;
        if (pn < 12) { const int t = pn >> 1, slot = (0x541320 >> (4 * t)) & 7; base = qkv + (size_t)slot * ((size_t)MTOK * 512); ldc = 512; colt = (pn & 1) * 256; if (t == 0 || t == 3) sc = C2f; }
        else { base = gates; ldc = 1024; colt = (pn - 12) * 128; sg = true; }
        const int row0 = u.pm * BM + wr * 64 + fr, col0 = colt + wc * 32 + 8 * fq;
        float nmx[2] = {0.f, 0.f};
#pragma unroll
        for (int ai = 0; ai < 2; ++ai)
#pragma unroll
            for (int m = 0; m < 4; ++m) { bf16_t* rowp = base + (size_t)(row0 + ai * HALF + m * 16) * ldc + col0;
                if (sg) {
                    f32x4 rr[2], gg[2];
#pragma unroll
                    for (int n = 0; n < 2; ++n)
#pragma unroll
                        for (int j = 0; j < 4; ++j) { const float ea = __builtin_amdgcn_exp2f(-LOG2E * acc[ai][0][m][n][j]), eb = __builtin_fminf(__builtin_amdgcn_exp2f(-LOG2E * acc[ai][1][m][n][j]), 1e30f);
                            gg[n][j] = __builtin_amdgcn_rcpf(1.0f + eb); rr[n][j] = (1.0f + eb) * __builtin_amdgcn_rcpf(1.0f + ea); }
                    u32x4 w; w.x = cvt_pk_bf16(rr[0][0], rr[0][1]); w.y = cvt_pk_bf16(rr[0][2], rr[0][3]); w.z = cvt_pk_bf16(rr[1][0], rr[1][1]); w.w = cvt_pk_bf16(rr[1][2], rr[1][3]);
                    *(u32x4*)rowp = w;
                    w.x = cvt_pk_bf16(gg[0][0], gg[0][1]); w.y = cvt_pk_bf16(gg[0][2], gg[0][3]); w.z = cvt_pk_bf16(gg[1][0], gg[1][1]); w.w = cvt_pk_bf16(gg[1][2], gg[1][3]);
                    *(u32x4*)(rowp + (size_t)MTOK * 1024) = w;
                    continue; }
#pragma unroll
                for (int bj = 0; bj < 2; ++bj) { f32x4 v0 = acc[ai][bj][m][0], v1 = acc[ai][bj][m][1];
                    if (pn < 4) { const float a0 = bflo(cvt_pk_bf16(v0[0] * sc, 0.f)), a1 = bflo(cvt_pk_bf16(v0[1] * sc, 0.f)), a2 = bflo(cvt_pk_bf16(v0[2] * sc, 0.f)), a3 = bflo(cvt_pk_bf16(v0[3] * sc, 0.f)),
                                      a4 = bflo(cvt_pk_bf16(v1[0] * sc, 0.f)), a5 = bflo(cvt_pk_bf16(v1[1] * sc, 0.f)), a6 = bflo(cvt_pk_bf16(v1[2] * sc, 0.f)), a7 = bflo(cvt_pk_bf16(v1[3] * sc, 0.f));
                        float s = (a0 * a0 + a1 * a1) + (a2 * a2 + a3 * a3) + (a4 * a4 + a5 * a5) + (a6 * a6 + a7 * a7);
                        s += __shfl_xor(s, 16); s += __shfl_xor(s, 32); nmx[bj] = __builtin_fmaxf(nmx[bj], s); }
                    v0 = v0 * sc; v1 = v1 * sc;
                    u32x4 w; w.x = cvt_pk_bf16(v0[0], v0[1]); w.y = cvt_pk_bf16(v0[2], v0[3]); w.z = cvt_pk_bf16(v1[0], v1[1]); w.w = cvt_pk_bf16(v1[2], v1[3]);
                    *(u32x4*)(rowp + bj * HALF) = w; } }
        if (pn < 4) {
#pragma unroll
            for (int bj = 0; bj < 2; ++bj) { float s = nmx[bj] * 1.0001f;
#pragma unroll
                for (int o = 1; o < 16; o <<= 1) s = __builtin_fmaxf(s, __shfl_xor(s, o));
                if (fr == 0 && fq == 0) atomicMax(nrm + (((u.pm >> 5) * 8 + (pn & 1) * 4 + bj * 2 + (wc >> 1)) * 2 + (pn >> 1)) * 2 + (wc & 1), __builtin_bit_cast(unsigned, s)); }
        }
    }
};

struct EpiMerge {
    static constexpr bool PERM = true, AFTER_DRAIN = false, HAS_MID = true;
    const bf16_t* gates; bf16_t* merged;
    __device__ __forceinline__ void mid(f32x4 (&acc)[2][2][4][2], const Unit& u, int wr, int wc, int, int) const {
        int t_ = threadIdx.x; asm volatile("" : "+v"(t_)); const int fr = t_ & 15, fq = (t_ >> 4) & 3;
        const int row0 = u.pm * BM + wr * 64 + fr, col0 = u.pn * BM + wc * 32 + 8 * fq; const bf16_t* R = gates;
#pragma unroll
        for (int ai = 0; ai < 2; ++ai)
#pragma unroll
            for (int m = 0; m < 4; ++m)
#pragma unroll
                for (int bj = 0; bj < 2; ++bj) { const size_t off = (size_t)(row0 + ai * HALF + m * 16) * 1024 + col0 + bj * HALF;
                    const u32x4 a = *(const u32x4*)(R + off);
                    acc[ai][bj][m][0] = acc[ai][bj][m][0] * (f32x4){bflo(a.x), bfhi(a.x), bflo(a.y), bfhi(a.y)};
                    acc[ai][bj][m][1] = acc[ai][bj][m][1] * (f32x4){bflo(a.z), bfhi(a.z), bflo(a.w), bfhi(a.w)}; }
    }
    __device__ __forceinline__ void operator()(const f32x4 (&acc)[2][2][4][2], const Unit& u, int wr, int wc, int fr, int fq) const {
        const bf16_t* GB = gates + (size_t)MTOK * 1024;
        const int row0 = u.pm * BM + wr * 64 + fr, col0 = u.pn * BM + wc * 32 + 8 * fq;
#pragma unroll
        for (int ai = 0; ai < 2; ++ai)
#pragma unroll
            for (int m = 0; m < 4; ++m)
#pragma unroll
                for (int bj = 0; bj < 2; ++bj) { const size_t off = (size_t)(row0 + ai * HALF + m * 16) * 1024 + col0 + bj * HALF;
                    const u32x4 b = *(const u32x4*)(GB + off);
#define PG8_CL(x, f) f(x)
                    const f32x4 v0 = acc[ai][bj][m][0] * (f32x4){PG8_CL(b.x, bflo), PG8_CL(b.x, bfhi), PG8_CL(b.y, bflo), PG8_CL(b.y, bfhi)};
                    const f32x4 v1 = acc[ai][bj][m][1] * (f32x4){PG8_CL(b.z, bflo), PG8_CL(b.z, bfhi), PG8_CL(b.w, bflo), PG8_CL(b.w, bfhi)};
#undef PG8_CL
                    u32x4 w; w.x = cvt_pk_bf16(v0[0], v0[1]); w.y = cvt_pk_bf16(v0[2], v0[3]); w.z = cvt_pk_bf16(v1[0], v1[1]); w.w = cvt_pk_bf16(v1[2], v1[3]);
                    *(u32x4*)(merged + off) = w; }
    }
};

struct EpiBranch {
    static constexpr bool PERM = true, AFTER_DRAIN = false, HAS_MID = false;
    const float* gt; bf16_t* out;
    __device__ __forceinline__ void operator()(const f32x4 (&acc)[2][2][4][2], const Unit& u, int wr, int wc, int fr, int fq) const {
        const int row0 = u.pm * BM + wr * 64 + fr, col0 = u.pn * BM + wc * 32 + 8 * fq; const float* g = gt + (size_t)(u.pm >> 5) * 6144 + col0;
#pragma unroll
        for (int bj = 0; bj < 2; ++bj) { const f32x4 g0 = *(const f32x4*)(g + bj * HALF) + 1.0f, g1 = *(const f32x4*)(g + bj * HALF + 4) + 1.0f;
#pragma unroll
            for (int ai = 0; ai < 2; ++ai)
#pragma unroll
                for (int m = 0; m < 4; ++m) { const f32x4 v0 = g0 * acc[ai][bj][m][0], v1 = g1 * acc[ai][bj][m][1];
                    u32x4 w; w.x = cvt_pk_bf16(v0[0], v0[1]); w.y = cvt_pk_bf16(v0[2], v0[3]); w.z = cvt_pk_bf16(v1[0], v1[1]); w.w = cvt_pk_bf16(v1[2], v1[3]);
                    *(u32x4*)(out + (size_t)(row0 + ai * HALF + m * 16) * 1024 + col0 + bj * HALF) = w; } }
    }
};

struct EpiUpConv {
    static constexpr bool PERM = true, AFTER_DRAIN = false, HAS_MID = false;
    const float* cw; const float* cb; bf16_t* act; PG8_LAS f32x4* xch; PG8_LAS float* wl; float* halo;
    template <int CTRL> static __device__ __forceinline__ float ror_d(float x) { return __builtin_bit_cast(float, __builtin_amdgcn_update_dpp(0, __builtin_bit_cast(int, x), CTRL, 0xf, 0xf, true)); }
    template <bool SEQ0> __device__ __forceinline__ f32x4 conv1(const f32x4 cur, const f32x4 prv, const f32x4 w0, const f32x4 w1, const f32x4 w2, const f32x4 bb, int fr, int s1, int s2, int tseq) const {
        const f32x4 a1 = (fr >= 15) ? prv : cur, a2 = (fr >= 14) ? prv : cur;
        f32x4 p1, p2;
        p1 = (f32x4){ror_d<0x121>(a1[0]), ror_d<0x121>(a1[1]), ror_d<0x121>(a1[2]), ror_d<0x121>(a1[3])};
        p2 = (f32x4){ror_d<0x122>(a2[0]), ror_d<0x122>(a2[1]), ror_d<0x122>(a2[2]), ror_d<0x122>(a2[3])};
        if (SEQ0) { if (tseq < 1) p1 = (f32x4){0.f, 0.f, 0.f, 0.f}; if (tseq < 2) p2 = (f32x4){0.f, 0.f, 0.f, 0.f}; }
        return bb + w0 * p2 + w1 * p1 + w2 * cur;
    }
    __device__ __forceinline__ void operator()(const f32x4 (&acc)[2][2][4][2], const Unit& u, int wr, int wc, int, int) const { run<false>(acc, u, wr, wc); }
    template <bool SEQ0> __device__ __forceinline__ void run(const f32x4 (&acc)[2][2][4][2], const Unit& u, int wr, int wc) const {
        int t_ = threadIdx.x; asm volatile("" : "+v"(t_));
        const int fr = t_ & 15, fq = (t_ >> 4) & 3, lane = t_ & 63;
        const int R0 = 256 * u.pm, ch0 = 128 * u.pn + 32 * wc + 8 * fq;
        if ((wr == 0 && fr < 2) || (wr == 1 && fr >= 14)) {
#pragma unroll
            for (int bj = 0; bj < 2; ++bj)
#pragma unroll
                for (int n = 0; n < 2; ++n) { const f32x4 hv = (wr == 0) ? acc[0][bj][0][n] : acc[1][bj][3][n];
                    *(f32x4*)(halo + ((size_t)u.pm * 4 + (wr == 0 ? fr : fr - 12)) * 5632 + 256 * u.pn + 128 * bj + 32 * wc + 8 * fq + 4 * n) = hv; }
        }
        const int xi = fq * 2 + (fr - 14);
        { const int idx = (t_ & 511) * 2, p = idx >> 8, bjw = (idx >> 7) & 1, cc = idx & 127; const float* src = (p < 3 ? cw + p * 5632 : cb) + bjw * 2816 + 128 * u.pn + cc;
          typedef float f32x2w __attribute__((ext_vector_type(2))); *(PG8_LAS f32x2w*)(wl + idx) = *(const f32x2w*)src; }
        if (fr >= 14) {
#pragma unroll
            for (int ai = 0; ai < 2; ++ai)
#pragma unroll
                for (int bj = 0; bj < 2; ++bj)
#pragma unroll
                    for (int n = 0; n < 2; ++n) xch[(((((ai * 2 + wr) * 4 + wc) * 2 + bj) * 2 + n) * 8) + xi] = acc[ai][bj][3][n];
        }
        asm volatile("s_waitcnt lgkmcnt(0)\n\ts_barrier" ::: "memory");
        const int s1 = (lane & 48) | ((fr - 1) & 15), s2 = (lane & 48) | ((fr - 2) & 15);
#pragma unroll
        for (int ai = 0; ai < 2; ++ai) {
            typedef unsigned u32x2 __attribute__((ext_vector_type(2))); u32x2 wq[2][4];
#pragma unroll
            for (int n = 0; n < 2; ++n) {
                asm volatile("" ::: "memory");
                const bool hasup = (fr >= 14) && ((ai * 2 + wr) >= 1);
                const int upi = (((((ai * 2 + wr - 1) * 4 + wc) * 2 + 0) * 2 + n) * 8) + xi;
                f32x4 cg[4];
                {   int cl = 32 * wc + 8 * fq + 4 * n; asm volatile("" : "+v"(cl));
                    const f32x4 w0 = *(const PG8_LAS f32x4*)(wl + cl), w1 = *(const PG8_LAS f32x4*)(wl + 256 + cl), w2 = *(const PG8_LAS f32x4*)(wl + 512 + cl), bb = *(const PG8_LAS f32x4*)(wl + 768 + cl);
                    f32x4 up = (f32x4){0.f, 0.f, 0.f, 0.f}; if (hasup) up = xch[upi];
#pragma unroll
                    for (int m = 0; m < 4; ++m) cg[m] = conv1<SEQ0>(acc[ai][0][m][n], (m == 0) ? up : acc[ai][0][m > 0 ? m - 1 : 0][n], w0, w1, w2, bb, fr, s1, s2, (R0 + 128 * ai + 64 * wr + 16 * m + fr) & 8191);
                }
                {   int cl = 128 + 32 * wc + 8 * fq + 4 * n; asm volatile("" : "+v"(cl));
                    const f32x4 w0 = *(const PG8_LAS f32x4*)(wl + cl), w1 = *(const PG8_LAS f32x4*)(wl + 256 + cl), w2 = *(const PG8_LAS f32x4*)(wl + 512 + cl), bb = *(const PG8_LAS f32x4*)(wl + 768 + cl);
                    f32x4 up = (f32x4){0.f, 0.f, 0.f, 0.f}; if (hasup) up = xch[upi + 16];
#pragma unroll
                    for (int m = 0; m < 4; ++m) {
                        const int rr = 128 * ai + 64 * wr + 16 * m + fr, grow = R0 + rr;
                        const f32x4 vl = conv1<SEQ0>(acc[ai][1][m][n], (m == 0) ? up : acc[ai][1][m > 0 ? m - 1 : 0][n], w0, w1, w2, bb, fr, s1, s2, grow & 8191);
                        const f32x4 gt = cg[m];
                        const f32x4 ex = gt * (-LOG2E); f32x4 dn = (f32x4){__builtin_amdgcn_exp2f(ex[0]), __builtin_amdgcn_exp2f(ex[1]), __builtin_amdgcn_exp2f(ex[2]), __builtin_amdgcn_exp2f(ex[3])} + 1.0f;
                        const f32x4 rc = (f32x4){__builtin_amdgcn_rcpf(dn[0]), __builtin_amdgcn_rcpf(dn[1]), __builtin_amdgcn_rcpf(dn[2]), __builtin_amdgcn_rcpf(dn[3])};
                        const f32x4 ov = (gt * vl) * rc;
                        wq[n][m].x = cvt_pk_bf16(ov[0], ov[1]); wq[n][m].y = cvt_pk_bf16(ov[2], ov[3]);
                    }
                }
            }
#pragma unroll
            for (int m = 0; m < 4; ++m) { const int rr = 128 * ai + 64 * wr + 16 * m + fr, grow = R0 + rr;
                if (rr >= 2) { u32x4 w; w.x = wq[0][m].x; w.y = wq[0][m].y; w.z = wq[1][m].x; w.w = wq[1][m].y; *(u32x4*)(act + (size_t)grow * 2816 + ch0) = w; } }
        }
    }
};
template <class Epi, class Sched, bool ALIGN_EPI = false, bool SP2 = false>
__device__ __forceinline__ void gemm_phase(PG8_LAS unsigned char* lds, const Gemm g, const Sched& S, const Epi& E) {
    int tid_ = threadIdx.x; asm volatile("" : "+v"(tid_));
    const int tid = tid_, wid = __builtin_amdgcn_readfirstlane(tid >> 6), lane = tid & 63, wr = wid >> 2, wc = wid & 3, fr = lane & 15, fq = lane >> 4;
    const int K = g.K, nt = K / BK;
    unsigned voffA[2], voffB[2];
#pragma unroll
    for (int i = 0; i < 2; ++i) { int R, C; stage_rc(tid * 16 + i * 8192, R, C); const int Rb = Epi::PERM ? ((R & ~31) + perm32(R & 31)) : R;
        voffA[i] = (unsigned)(R * K + C) * 2u; voffB[i] = (unsigned)(Rb * K + C) * 2u; }
    const size_t kstep = (size_t)(BK * 2);
    const size_t hstep = (size_t)HALF * K * 2;
    const size_t tstep = 2 * hstep;
    const unsigned ldsw = (unsigned)wid * 1024u;
    const int aoff = lds_byte(wr * 64 + fr, fq * 8), boff = lds_byte(wc * 32 + fr, fq * 8);
#define PG8_SA(b, h) (((b) * 2 + (h)) * HTB)
#define PG8_SB(b, h) ((4 + (b) * 2 + (h)) * HTB)
#define PG8_STAGE(bufoff, gbase, voff) do { _Pragma("unroll") for (int _i = 0; _i < 2; ++_i) \
        __builtin_amdgcn_global_load_lds((const unsigned*)((const char*)(gbase) + (voff)[_i]), (PG8_LAS unsigned*)(lds + (bufoff) + ldsw + _i * 8192), 16, 0, 0); } while (0)
#define PG8_LDA(dst, b, h) do { _Pragma("unroll") for (int m = 0; m < 4; ++m) _Pragma("unroll") for (int k = 0; k < 2; ++k) dst[m][k] = *(const PG8_LAS bf16x8*)(lds + PG8_SA(b, h) + aoff + m * 2048 + k * 1024); } while (0)
#define PG8_LDB(dst, b, h) do { _Pragma("unroll") for (int n = 0; n < 2; ++n) _Pragma("unroll") for (int k = 0; k < 2; ++k) dst[n][k] = *(const PG8_LAS bf16x8*)(lds + PG8_SB(b, h) + boff + n * 2048 + k * 1024); } while (0)
#define PG8_MMA(ai, bj, At, Bt) do { __builtin_amdgcn_s_setprio(1); _Pragma("unroll") for (int m = 0; m < 4; ++m) _Pragma("unroll") for (int n = 0; n < 2; ++n) _Pragma("unroll") for (int k = 0; k < 2; ++k) \
        acc[ai][bj][m][n] = __builtin_amdgcn_mfma_f32_16x16x32_bf16(Bt[n][k], At[m][k], acc[ai][bj][m][n], 0, 0, 0); __builtin_amdgcn_s_setprio(0); } while (0)
#define PG8_WAIT_V(n) asm volatile("s_waitcnt vmcnt(" #n ")" ::: "memory")
#define PG8_WAIT_L(n) asm volatile("s_waitcnt lgkmcnt(" #n ")" ::: "memory")
#define PG8_BAR __builtin_amdgcn_s_barrier()
#define PG8_SCHED __builtin_amdgcn_sched_barrier(0)
    Unit cur, nxt; int ui = 0;
    if (!S.next(0, cur)) return;
    f32x4 acc[2][2][4][2];
#pragma unroll
    for (int a = 0; a < 2; ++a)
#pragma unroll
        for (int b = 0; b < 2; ++b)
#pragma unroll
            for (int m = 0; m < 4; ++m)
#pragma unroll
                for (int n = 0; n < 2; ++n) acc[a][b][m][n] = (f32x4){0.f, 0.f, 0.f, 0.f};
    bf16x8 At[4][2], B0[2][2], B1[2][2];
    const char* cA = (const char*)g.A + (size_t)cur.pm * g.a_tstep; const char* cB = (const char*)g.Bt + (size_t)cur.pn * tstep;
    S.a_ready(cur);
    if constexpr (SP2) {
        PG8_STAGE(PG8_SB(0, 0), cB, voffB); PG8_STAGE(PG8_SB(0, 1), cB + hstep, voffB); PG8_STAGE(PG8_SA(0, 0), cA, voffA); PG8_STAGE(PG8_SA(0, 1), cA + hstep, voffA);
        if (wr == 1) PG8_BAR;
        PG8_WAIT_V(2); PG8_BAR;
        PG8_STAGE(PG8_SB(1, 0), cB + kstep, voffB); PG8_STAGE(PG8_SA(1, 0), cA + kstep, voffA); PG8_STAGE(PG8_SB(1, 1), cB + hstep + kstep, voffB);
        PG8_WAIT_V(6); PG8_BAR;
    } else {
        PG8_STAGE(PG8_SB(0, 0), cB, voffB); PG8_STAGE(PG8_SA(0, 0), cA, voffA); PG8_STAGE(PG8_SB(0, 1), cB + hstep, voffB); PG8_STAGE(PG8_SA(0, 1), cA + hstep, voffA);
        if (wr == 1) PG8_BAR;
        PG8_WAIT_V(4); PG8_BAR;
        PG8_STAGE(PG8_SB(1, 0), cB + kstep, voffB); PG8_STAGE(PG8_SA(1, 0), cA + kstep, voffA); PG8_STAGE(PG8_SB(1, 1), cB + hstep + kstep, voffB);
        PG8_WAIT_V(6); PG8_BAR;
    }
    for (;;) {
        const bool has_next = S.next(ui + 1, nxt);
        const char* nA = has_next ? (const char*)g.A + (size_t)nxt.pm * g.a_tstep : cA; const char* nB = has_next ? (const char*)g.Bt + (size_t)nxt.pn * tstep : cB;
        for (int t = 0; t < nt; t += 2) {
            const bool last = (t == nt - 2);
            const char* a1 = cA + (size_t)(t + 1) * kstep;
            const char* a2 = last ? nA : cA + (size_t)(t + 2) * kstep; const char* b2 = last ? nB : cB + (size_t)(t + 2) * kstep;
            const char* a3 = a2 + kstep; const char* b3 = b2 + kstep;
            if (last && has_next) S.a_ready(nxt);
            if constexpr (SP2) {
            PG8_LDB(B0, 0, 0); PG8_LDB(B1, 0, 1); PG8_SCHED; PG8_LDA(At, 0, 0); PG8_STAGE(PG8_SA(1, 1), a1 + hstep, voffA);
            PG8_WAIT_V(8); PG8_WAIT_L(0); PG8_BAR; PG8_MMA(0, 0, At, B0); PG8_MMA(0, 1, At, B1); PG8_BAR; PG8_SCHED;
            PG8_LDA(At, 0, 1); PG8_STAGE(PG8_SB(0, 0), b2, voffB); PG8_STAGE(PG8_SB(0, 1), b2 + hstep, voffB); PG8_STAGE(PG8_SA(0, 0), a2, voffA);
            PG8_WAIT_V(8); PG8_WAIT_L(0); PG8_BAR; PG8_MMA(1, 0, At, B0); PG8_MMA(1, 1, At, B1); PG8_BAR; PG8_SCHED;
            PG8_LDB(B0, 1, 0); PG8_LDB(B1, 1, 1); PG8_SCHED; PG8_LDA(At, 1, 0); PG8_STAGE(PG8_SA(0, 1), a2 + hstep, voffA);
            PG8_WAIT_V(8); PG8_WAIT_L(0); PG8_BAR; PG8_MMA(0, 0, At, B0); PG8_MMA(0, 1, At, B1); PG8_BAR; PG8_SCHED;
            PG8_LDA(At, 1, 1); PG8_STAGE(PG8_SB(1, 0), b3, voffB); PG8_STAGE(PG8_SB(1, 1), b3 + hstep, voffB); PG8_STAGE(PG8_SA(1, 0), a3, voffA);
            PG8_WAIT_V(8); PG8_WAIT_L(0); PG8_BAR; PG8_MMA(1, 0, At, B0); PG8_MMA(1, 1, At, B1); PG8_BAR; PG8_SCHED;
            } else {
            PG8_LDB(B0, 0, 0); PG8_SCHED; PG8_LDA(At, 0, 0); PG8_STAGE(PG8_SA(1, 1), a1 + hstep, voffA);
            PG8_WAIT_L(8); PG8_BAR; PG8_WAIT_L(0); PG8_MMA(0, 0, At, B0); PG8_BAR; PG8_SCHED;
            PG8_LDB(B1, 0, 1); PG8_STAGE(PG8_SB(0, 0), b2, voffB);
            PG8_BAR; PG8_WAIT_L(0); PG8_MMA(0, 1, At, B1); PG8_BAR;
            PG8_LDA(At, 0, 1); PG8_STAGE(PG8_SA(0, 0), a2, voffA);
            PG8_BAR; PG8_WAIT_L(0); PG8_MMA(1, 0, At, B0); PG8_BAR; PG8_SCHED;
            PG8_STAGE(PG8_SB(0, 1), b2 + hstep, voffB);
            PG8_WAIT_V(6); PG8_BAR; PG8_MMA(1, 1, At, B1); PG8_BAR;
            PG8_LDB(B0, 1, 0); PG8_SCHED; PG8_LDA(At, 1, 0); PG8_STAGE(PG8_SA(0, 1), a2 + hstep, voffA);
            PG8_WAIT_L(8); PG8_BAR; PG8_WAIT_L(0); PG8_MMA(0, 0, At, B0); PG8_BAR; PG8_SCHED;
            PG8_LDB(B1, 1, 1); PG8_STAGE(PG8_SB(1, 0), b3, voffB);
            PG8_BAR; PG8_WAIT_L(0); PG8_MMA(0, 1, At, B1); PG8_BAR;
            PG8_LDA(At, 1, 1); PG8_STAGE(PG8_SA(1, 0), a3, voffA);
            PG8_BAR; PG8_WAIT_L(0); PG8_MMA(1, 0, At, B0); PG8_BAR; PG8_SCHED;
            PG8_STAGE(PG8_SB(1, 1), b3 + hstep, voffB);
            PG8_WAIT_V(6); PG8_BAR; PG8_MMA(1, 1, At, B1); PG8_BAR;
            }
            if constexpr (Epi::HAS_MID) { if (t == nt / 2 - 2) E.mid(acc, cur, wr, wc, fr, fq); }
        }
        if constexpr (ALIGN_EPI) { if (wr == 0) PG8_BAR; }
        if constexpr (!Epi::AFTER_DRAIN) { E(acc, cur, wr, wc, fr, fq); S.done(cur); }
        if (!has_next) break;
#pragma unroll
        for (int a = 0; a < 2; ++a)
#pragma unroll
            for (int b = 0; b < 2; ++b)
#pragma unroll
                for (int m = 0; m < 4; ++m)
#pragma unroll
                    for (int n = 0; n < 2; ++n) acc[a][b][m][n] = (f32x4){0.f, 0.f, 0.f, 0.f};
        cur = nxt; cA = nA; cB = nB; ++ui;
        if constexpr (ALIGN_EPI) { if (wr == 1) PG8_BAR; }
    }
    PG8_WAIT_V(0);
    if constexpr (!ALIGN_EPI) { if (wr == 0) PG8_BAR; }
    PG8_BAR;
    if constexpr (Epi::AFTER_DRAIN) { E.fused(acc, cur, wr, wc, fr, fq, lds, wid, lane); S.done(cur); }
#undef PG8_SA
#undef PG8_SB
#undef PG8_STAGE
#undef PG8_LDA
#undef PG8_LDB
#undef PG8_MMA
#undef PG8_WAIT_V
#undef PG8_WAIT_L
#undef PG8_BAR
#undef PG8_SCHED
}
}
#include <hip/hip_bf16.h>
#include <cmath>
namespace attn_body {
using bf16=__hip_bfloat16;
using bf16x8=__attribute__((ext_vector_type(8)))short;
using s16x4=__attribute__((ext_vector_type(4)))short;
using f32x16=__attribute__((ext_vector_type(16)))float;
using u32x4=__attribute__((ext_vector_type(4)))unsigned;
constexpr int BATCH=8,NHEAD=8,SEQ=8192,D=64,DM=NHEAD*D;
constexpr int NW=8,QBLK=32,QB=QBLK*NW,KVBLK=64,NQB=SEQ/QB;
constexpr int ATTN_PITCH=DM, ATTN_UNIT_ROWS=QB, ODM=1024;
constexpr float ATTN_SKIP_LOG2=SKIP_LOG2;
__device__ __forceinline__ int crow(int r,int hi){return (r&3)+8*(r>>2)+4*hi;}
#define SBAR() __builtin_amdgcn_sched_barrier(0)
__device__ __forceinline__ void cmask(f32x16&p0,f32x16&p1,int jb,int qrel,int hi){
  const float NEG=-INFINITY; int kb=64*jb+4*hi;
  #pragma unroll
  for(int r=0;r<16;++r){int kv=kb+(r&3)+8*(r>>2); if(kv>qrel)p0[r]=NEG; if(kv+32>qrel)p1[r]=NEG;}
}

constexpr int NSLOT=3, SLOTB=8192;
constexpr int LDS_K=0, LDS_V=NSLOT*SLOTB, LDS_WS=2*NSLOT*SLOTB, LDS_OST=LDS_WS+NW*64*4, LDS_CK=LDS_OST+NW*4096, LDS_T0=LDS_CK+SEQ*4, LDS_BYTES=LDS_T0+64;
constexpr float C2=0.125f*1.4426950408889634f;
__device__ __forceinline__ void glds16(const void*gsrc,unsigned lds_dst){unsigned keep;
  asm volatile("s_mov_b32 %0, m0\n\ts_mov_b32 m0, %2\n\ts_nop 0\n\tglobal_load_lds_dwordx4 %1, off\n\ts_mov_b32 m0, %0":"=&s"(keep):"v"(gsrc),"s"(lds_dst):"memory");}
__device__ __forceinline__ float max3f(float a,float b,float c){float r;asm("v_max3_f32 %0, %1, %2, %3":"=v"(r):"v"(a),"v"(b),"v"(c));return r;}
__device__ __forceinline__ float max2f(float a,float b){float r;asm("v_max_f32_e32 %0, %1, %2":"=v"(r):"v"(a),"v"(b));return r;}
__device__ __forceinline__ float fadd_s(float a,float b){float r;asm("v_add_f32_e32 %0, %1, %2":"=v"(r):"v"(a),"v"(b));return r;}
__device__ __forceinline__ float fsub_s(float a,float b){float r;asm("v_sub_f32_e32 %0, %1, %2":"=v"(r):"v"(a),"v"(b));return r;}
typedef float f32x2_t __attribute__((ext_vector_type(2))); typedef __bf16 bf16x2_t __attribute__((ext_vector_type(2)));
__device__ __forceinline__ unsigned cvtpk_s(float lo,float hi){f32x2_t v={lo,hi};bf16x2_t b=__builtin_convertvector(v,bf16x2_t);return __builtin_bit_cast(unsigned,b);}
#define WAIT_BAR(N) asm volatile("s_waitcnt vmcnt(" #N ") lgkmcnt(0)\n\ts_barrier":::"memory")

__device__ __forceinline__ void qkt(f32x16&p0,f32x16&p1,const char*Kslot,const bf16x8*qr,int r32,int hi){
  const char*kb=Kslot+hi*1024+r32*16;
  #pragma unroll
  for(int d0=0;d0<4;++d0){
    const bf16x8 b0=*reinterpret_cast<const bf16x8*>(kb+d0*2048);
    const bf16x8 b1=*reinterpret_cast<const bf16x8*>(kb+d0*2048+512);
    {p0=__builtin_amdgcn_mfma_f32_32x32x16_bf16(b0,qr[d0],p0,0,0,0);p1=__builtin_amdgcn_mfma_f32_32x32x16_bf16(b1,qr[d0],p1,0,0,0);}}
}
typedef __attribute__((address_space(3))) const char* lds_cptr;
typedef short v4i16_t __attribute__((ext_vector_type(4)));
__device__ __forceinline__ void kload8(bf16x8*kf,lds_cptr kp){
  kf[0]=*(const __attribute__((address_space(3))) bf16x8*)(kp);      kf[1]=*(const __attribute__((address_space(3))) bf16x8*)(kp+512);
  kf[2]=*(const __attribute__((address_space(3))) bf16x8*)(kp+2048); kf[3]=*(const __attribute__((address_space(3))) bf16x8*)(kp+2560);
  kf[4]=*(const __attribute__((address_space(3))) bf16x8*)(kp+4096); kf[5]=*(const __attribute__((address_space(3))) bf16x8*)(kp+4608);
  kf[6]=*(const __attribute__((address_space(3))) bf16x8*)(kp+6144); kf[7]=*(const __attribute__((address_space(3))) bf16x8*)(kp+6656);
}
__device__ __forceinline__ void kload2(bf16x8*kf,lds_cptr kp,int j){ kf[2*j]=*(const __attribute__((address_space(3))) bf16x8*)(kp+j*2048); kf[2*j+1]=*(const __attribute__((address_space(3))) bf16x8*)(kp+j*2048+512); }
__device__ __forceinline__ s16x4 vtr(lds_cptr p){ return __builtin_bit_cast(s16x4,__builtin_amdgcn_ds_read_tr16_b64_v4i16((__attribute__((address_space(3))) v4i16_t*)p)); }
__device__ __forceinline__ float rowmax(const f32x16&p0,const f32x16&p1){
  float a=max3f(p0[0],p0[1],p1[0]),b=max3f(p0[2],p0[3],p1[1]);a=max3f(a,p1[2],p1[3]);
  #pragma unroll
  for(int r=4;r<16;r+=4){a=max3f(a,p0[r],p0[r+1]);b=max3f(b,p0[r+2],p0[r+3]);a=max3f(a,p1[r],p1[r+1]);b=max3f(b,p1[r+2],p1[r+3]);}
  const float m=max2f(a,b);
  auto rr=__builtin_amdgcn_permlane32_swap(__float_as_uint(m),__float_as_uint(m),false,false);
  return max2f(__uint_as_float(rr[0]),__uint_as_float(rr[1]));
}
__device__ __forceinline__ void pv(f32x16*o,int vb,bf16x8 pa0,bf16x8 pa1,bf16x8 pa2,bf16x8 pa3){
  #pragma unroll
  for(int d0=0;d0<2;++d0){s16x4 lo[4],hi[4];
    #pragma unroll
    for(int ks=0;ks<4;++ks){
      asm volatile("ds_read_b64_tr_b16 %0,%1 offset:%c2":"=&v"(lo[ks]):"v"(vb),"i"(d0*4096+ks*1024):"memory");
      asm volatile("ds_read_b64_tr_b16 %0,%1 offset:%c2":"=&v"(hi[ks]):"v"(vb),"i"(d0*4096+ks*1024+512):"memory");}
    asm volatile("s_waitcnt lgkmcnt(0)":::"memory");SBAR();
    #define PK(k) (bf16x8){lo[k][0],lo[k][1],lo[k][2],lo[k][3],hi[k][0],hi[k][1],hi[k][2],hi[k][3]}
    o[d0]=__builtin_amdgcn_mfma_f32_32x32x16_bf16(pa0,PK(0),o[d0],0,0,0);
    o[d0]=__builtin_amdgcn_mfma_f32_32x32x16_bf16(pa1,PK(1),o[d0],0,0,0);
    o[d0]=__builtin_amdgcn_mfma_f32_32x32x16_bf16(pa2,PK(2),o[d0],0,0,0);
    o[d0]=__builtin_amdgcn_mfma_f32_32x32x16_bf16(pa3,PK(3),o[d0],0,0,0);
    #undef PK
  }
}

typedef __attribute__((address_space(3))) const float* lds_fptr;
typedef float f32x4_t __attribute__((ext_vector_type(4)));
__device__ __forceinline__ void biasinit(f32x16&c0,f32x16&c1,lds_fptr ckt,float aq){
  #pragma unroll
  for(int g=0;g<4;++g){ const f32x4_t v=*(const __attribute__((address_space(3))) f32x4_t*)(ckt+8*g); const f32x4_t w=*(const __attribute__((address_space(3))) f32x4_t*)(ckt+32+8*g);
    c0[4*g]=aq-v[0];c0[4*g+1]=aq-v[1];c0[4*g+2]=aq-v[2];c0[4*g+3]=aq-v[3]; c1[4*g]=aq-w[0];c1[4*g+1]=aq-w[1];c1[4*g+2]=aq-w[2];c1[4*g+3]=aq-w[3]; }
}
#ifndef ATTN_STORE16
#define ATTN_STORE16(p,v) (*(u32x4*)(p)=(v))
#endif
template<int THRL> __device__ __forceinline__ void attn_unit(int b,int h,int qb,const bf16*Q,const bf16*__restrict__ K,const bf16*__restrict__ V,bf16*O,char*shm,const float*__restrict__ CKg,const float Tskip){
  int tid_=threadIdx.x; asm volatile("":"+v"(tid_)); const int tid=tid_,lane=tid&63,r32=lane&31,hi=lane>>5; const int wid=__builtin_amdgcn_readfirstlane(tid>>6);
  const long rowbase=(long)b*SEQ; const int q0=qb*QB; const lds_cptr shm3=(lds_cptr)shm;
  const float*ckh=CKg+(long)(b*NHEAD+h)*SEQ; int t0;
  { __attribute__((address_space(3))) int*cw=(__attribute__((address_space(3))) int*)((__attribute__((address_space(3))) char*)shm3+LDS_T0);
    const int ntf=(q0+QB)/KVBLK; bool ok=false; if(tid>=1&&tid<=ntf-4) ok=(ckh[64*tid-1]-ckh[q0])>=Tskip;
    const unsigned long long bm=__ballot(ok); if(lane==0)cw[wid]=__popcll(bm);
    asm volatile("s_waitcnt vmcnt(0) lgkmcnt(0)\n\ts_barrier":::"memory");
    t0=__builtin_amdgcn_readfirstlane((cw[0]+cw[1])&~1); }
  const bf16*Qw=Q+(rowbase+q0+wid*QBLK)*DM+h*D;
  const bf16*Kh=K+(rowbase+64*t0)*DM+h*D,*Vh=V+(rowbase+64*t0)*DM+h*D;
  const unsigned lds0=(unsigned)(uintptr_t)shm;
  float*wsf=(float*)(shm+LDS_WS)+wid*64;
  const bf16*ksrc=Kh+(long)lane*DM+wid*8;
  const bf16*vsrc=Vh+(long)(16*(wid&3)+(lane>>2))*DM+(wid>>2)*32+(lane&3)*8;
  const unsigned kdst=lds0+LDS_K+wid*1024, vdst=lds0+LDS_V+wid*1024;
  #define DMA_K(t,slot) glds16(ksrc+(long)(t)*KVBLK*DM,(unsigned)__builtin_amdgcn_readfirstlane(kdst+(slot)))
  #define DMA_V(t,slot) glds16(vsrc+(long)(t)*KVBLK*DM,(unsigned)__builtin_amdgcn_readfirstlane(vdst+(slot)))
  const int vb0=(int)(lds0+LDS_V)+((lane>>4)&1)*32+(lane&3)*8+(4*hi+((lane&15)>>2))*64;
  const char*Kbase=shm+LDS_K; bf16x8 kf[8];
  const lds_cptr kp0=shm3+LDS_K+hi*1024+r32*16; const lds_cptr vp0=shm3+LDS_V+((lane>>4)&1)*32+(lane&3)*8+(4*hi+((lane&15)>>2))*64;
  const int NT=(q0+QB)/KVBLK-t0;
  { __attribute__((address_space(3))) f32x4_t*ckd=(__attribute__((address_space(3))) f32x4_t*)((__attribute__((address_space(3))) char*)shm3+LDS_CK);
    for(int i=tid;i<(q0+QB-64*t0)/4;i+=NW*64) ckd[i]=*(const f32x4_t*)(ckh+64*t0+4*i);
    asm volatile("s_waitcnt vmcnt(0) lgkmcnt(0)\n\ts_barrier":::"memory"); }
  const lds_fptr ckl=(lds_fptr)(shm3+LDS_CK);
  const float cq=ckl[q0-64*t0+wid*QBLK+r32]; float aq=cq;
  DMA_K(0,0);DMA_V(0,0);DMA_K(1,SLOTB);
  bf16x8 qr[4];
  #pragma unroll
  for(int d0=0;d0<4;++d0)qr[d0]=*reinterpret_cast<const bf16x8*>(&Qw[(long)r32*DM+d0*16+hi*8]);
  float mhat=0.f,l_reg=0.f;f32x16 o[2];o[0]=f32x16{};o[1]=f32x16{};
  const int qrel=wid*QBLK+r32;
  #define CMASK(P0,P1,t) do{int jb_=(t)-(NT-4); if(jb_>=0)cmask(P0,P1,jb_,qrel,hi);}while(0)
  bool resc=false;
  #define START(P0,P1) do{ const float rm=rowmax(P0,P1); resc=false; \
    { const float dl=rm; mhat=fadd_s(mhat,dl); \
      _Pragma("unroll") for(int r=0;r<16;++r){P0[r]=fsub_s(P0[r],dl);P1[r]=fsub_s(P1[r],dl);} \
      aq=cq-mhat; } \
    _Pragma("unroll") for(int r=0;r<16;++r)P0[r]=__builtin_amdgcn_exp2f(P0[r]); }while(0)
  #define RESC() do{ if(resc){ asm volatile("s_waitcnt lgkmcnt(0)":::"memory"); \
      _Pragma("unroll") for(int d_=0;d_<2;++d_) _Pragma("unroll") for(int r=0;r<16;++r)o[d_][r]*=wsf[crow(r,hi)]; } }while(0)
  f32x16 pA0,pA1,pB0,pB1;
  int sl_prev=0,sl_cur=0,sl_next=SLOTB;
  #define ROT() do{sl_prev=sl_cur;sl_cur=sl_next;sl_next=(sl_next==(NSLOT-1)*SLOTB)?0:sl_next+SLOTB;}while(0)
  DMA_K(2,2*SLOTB);
  WAIT_BAR(3);
  biasinit(pA0,pA1,ckl+4*hi,aq); qkt(pA0,pA1,Kbase,qr,r32,hi);asm volatile("s_nop 15\n\ts_nop 7":"+v"(pA0),"+v"(pA1));CMASK(pA0,pA1,0);
  START(pA0,pA1);
  _Pragma("unroll") for(int r=0;r<16;++r)pA1[r]=__builtin_amdgcn_exp2f(pA1[r]);
  WAIT_BAR(0);
  DMA_K(3,0);DMA_V(1,SLOTB);
  ROT();
  kload8(kf,kp0+sl_cur);
  WAIT_BAR(2);
  s16x4 vlo[8],vhi[8]; u32x4 pw0,pw1,pw2,pw3;
  #define PKW(P,B) cvtpk_s(P[B],P[B+1])
  #define PAF(k) __builtin_bit_cast(bf16x8,pw##k)
  #define VFR(i) (bf16x8){vlo[i][0],vlo[i][1],vlo[i][2],vlo[i][3],vhi[i][0],vhi[i][1],vhi[i][2],vhi[i][3]}
  #define PIN(x) asm volatile("":"+v"(x))
  #define MX3(a,b,c) __builtin_fmaxf(__builtin_fmaxf((a),(b)),(c))
  #define GAPA(MF,A0,A1,A2,A3,W0,W1,PW) do{ MF; sacc+=A0; sacc+=A1; sacc+=A2; sacc+=A3; PIN(sacc); W0; W1; PIN(PW); SBAR(); }while(0)
  #define EX(v) __builtin_amdgcn_exp2f(v)
  #define GAPB(MF,X,B) do{ MF; X[B]=EX(X[B]); X[B+1]=EX(X[B+1]); X[B+2]=EX(X[B+2]); X[B+3]=EX(X[B+3]); PIN(X); SBAR(); }while(0)
  #define VRD(i) do{ vlo[i]=vtr(vp_+(((i)>>2)*4096+((i)&3)*1024)); vhi[i]=vtr(vp_+(((i)>>2)*4096+((i)&3)*1024+512)); }while(0)
  #define KRD(G,j) do{ if(G){ kload2(kf,kp0+sl_next,j); SBAR(); } }while(0)
  #define STEP(C0,C1,P0,P1,t,GK,GV,GL) do{ SBAR(); biasinit(C0,C1,ckl+64*(t)+4*hi,aq); SBAR(); \
    const lds_cptr vp_=vp0+sl_prev; \
    VRD(0); SBAR(); float sacc=(P0[0]+P0[1]); \
    GAPA(C0=__builtin_amdgcn_mfma_f32_32x32x16_bf16(kf[0],qr[0],C0,0,0,0), P0[2],P0[3],P0[4],P0[5],     pw0[0]=PKW(P0,0), pw0[1]=PKW(P0,2), pw0); \
    VRD(4); SBAR(); GAPA(C1=__builtin_amdgcn_mfma_f32_32x32x16_bf16(kf[1],qr[0],C1,0,0,0), P0[6],P0[7],P0[8],P0[9],     pw0[2]=PKW(P0,4), pw0[3]=PKW(P0,6), pw0); \
    VRD(1); SBAR(); GAPA(C0=__builtin_amdgcn_mfma_f32_32x32x16_bf16(kf[2],qr[1],C0,0,0,0),   P0[10],P0[11],P0[12],P0[13], pw1[0]=PKW(P0,8), pw1[1]=PKW(P0,10), pw1); \
    VRD(5); SBAR(); GAPA(C1=__builtin_amdgcn_mfma_f32_32x32x16_bf16(kf[3],qr[1],C1,0,0,0),   P0[14],P0[15],P1[0],P1[1],   pw1[2]=PKW(P0,12),pw1[3]=PKW(P0,14), pw1); \
    VRD(2); SBAR(); GAPA(C0=__builtin_amdgcn_mfma_f32_32x32x16_bf16(kf[4],qr[2],C0,0,0,0),   P1[2],P1[3],P1[4],P1[5],     pw2[0]=PKW(P1,0), pw2[1]=PKW(P1,2), pw2); \
    VRD(6); SBAR(); GAPA(C1=__builtin_amdgcn_mfma_f32_32x32x16_bf16(kf[5],qr[2],C1,0,0,0),   P1[6],P1[7],P1[8],P1[9],     pw2[2]=PKW(P1,4), pw2[3]=PKW(P1,6), pw2); \
    VRD(3); SBAR(); GAPA(C0=__builtin_amdgcn_mfma_f32_32x32x16_bf16(kf[6],qr[3],C0,0,0,0),   P1[10],P1[11],P1[12],P1[13], pw3[0]=PKW(P1,8), pw3[1]=PKW(P1,10), pw3); \
    VRD(7); SBAR(); GAPA(C1=__builtin_amdgcn_mfma_f32_32x32x16_bf16(kf[7],qr[3],C1,0,0,0),   P1[14],P1[15],0.f,0.f,       pw3[2]=PKW(P1,12),pw3[3]=PKW(P1,14), pw3); \
    l_reg+=sacc; \
    if(GK){DMA_K((t)+3,sl_cur);} if(GV){DMA_V((t)+1,sl_next);} \
    CMASK(C0,C1,t); \
    { float a=MX3(C0[0],C0[1],C1[0]),b=MX3(C0[2],C0[3],C1[1]); a=MX3(a,C1[2],C1[3]); \
      _Pragma("unroll") for(int r=4;r<16;r+=4){a=MX3(a,C0[r],C0[r+1]);b=MX3(b,C0[r+2],C0[r+3]);a=MX3(a,C1[r],C1[r+1]);b=MX3(b,C1[r+2],C1[r+3]);} \
      float rm=__builtin_fmaxf(a,b); { auto rr=__builtin_amdgcn_permlane32_swap(__float_as_uint(rm),__float_as_uint(rm),false,false); rm=__builtin_fmaxf(__uint_as_float(rr[0]),__uint_as_float(rr[1])); } \
      resc=false; \
      if(__builtin_expect(__any(rm>(float)THRL),0)){ const float dl=__builtin_fmaxf(rm,0.f); mhat+=dl; \
        _Pragma("unroll") for(int r=0;r<16;++r){C0[r]-=dl;C1[r]-=dl;} \
        aq=cq-mhat; \
        const float f=__builtin_amdgcn_exp2f(-dl); l_reg*=f; if(hi==0)wsf[r32]=f; resc=true; } } \
    SBAR(); \
    GAPB(o[0]=__builtin_amdgcn_mfma_f32_32x32x16_bf16(PAF(0),VFR(0),o[0],0,0,0), C0,0); \
    GAPB(o[1]=__builtin_amdgcn_mfma_f32_32x32x16_bf16(PAF(0),VFR(4),o[1],0,0,0), C0,4); \
    KRD(GL,0); GAPB(o[0]=__builtin_amdgcn_mfma_f32_32x32x16_bf16(PAF(1),VFR(1),o[0],0,0,0), C0,8); \
    KRD(GL,1); GAPB(o[1]=__builtin_amdgcn_mfma_f32_32x32x16_bf16(PAF(1),VFR(5),o[1],0,0,0), C0,12); \
    KRD(GL,2); GAPB(o[0]=__builtin_amdgcn_mfma_f32_32x32x16_bf16(PAF(2),VFR(2),o[0],0,0,0), C1,0); \
    KRD(GL,3); GAPB(o[1]=__builtin_amdgcn_mfma_f32_32x32x16_bf16(PAF(2),VFR(6),o[1],0,0,0), C1,4); \
    GAPB(o[0]=__builtin_amdgcn_mfma_f32_32x32x16_bf16(PAF(3),VFR(3),o[0],0,0,0), C1,8); \
    GAPB(o[1]=__builtin_amdgcn_mfma_f32_32x32x16_bf16(PAF(3),VFR(7),o[1],0,0,0), C1,12); \
    }while(0)
  int t=1;
  #undef CMASK
  #define CMASK(P0,P1,t) do{}while(0)
  for(;t+5<NT;t+=2){
    STEP(pB0,pB1,pA0,pA1,t,true,true,true);     WAIT_BAR(2); RESC(); ROT();
    STEP(pA0,pA1,pB0,pB1,t+1,true,true,true);   WAIT_BAR(2); RESC(); ROT();
  }
  #undef CMASK
  #define CMASK(P0,P1,t) do{int jb_=(t)-(NT-4); if(jb_>=0)cmask(P0,P1,jb_,qrel,hi);}while(0)
  #define ENDW(tt) do{ if((tt)+3<NT){WAIT_BAR(2);} else if((tt)+2<NT){WAIT_BAR(1);} else {WAIT_BAR(0);} }while(0)
  for(;t+1<NT;t+=2){
    STEP(pB0,pB1,pA0,pA1,t,(t+3<NT),(t+1<NT),(t+1<NT));       ENDW(t);   RESC(); ROT();
    STEP(pA0,pA1,pB0,pB1,t+1,(t+4<NT),(t+2<NT),(t+2<NT));     ENDW(t+1); RESC(); ROT();
  }
  STEP(pB0,pB1,pA0,pA1,NT-1,false,false,false); RESC();
  { float sacc=pB0[0]+pB0[1]; _Pragma("unroll") for(int r=2;r<16;++r)sacc+=pB0[r]; _Pragma("unroll") for(int r=0;r<16;++r)sacc+=pB1[r]; l_reg+=sacc;
    pw0=(u32x4){PKW(pB0,0),PKW(pB0,2),PKW(pB0,4),PKW(pB0,6)};pw1=(u32x4){PKW(pB0,8),PKW(pB0,10),PKW(pB0,12),PKW(pB0,14)};pw2=(u32x4){PKW(pB1,0),PKW(pB1,2),PKW(pB1,4),PKW(pB1,6)};pw3=(u32x4){PKW(pB1,8),PKW(pB1,10),PKW(pB1,12),PKW(pB1,14)};
    SBAR(); pv(o,vb0+sl_cur,PAF(0),PAF(1),PAF(2),PAF(3)); }
  #undef PKW
  #undef PAF
  #undef VFR
  #undef PIN
  #undef MX3
  #undef GAPA
  #undef GAPB
  #undef EX
  #undef VRD
  #undef KRD
  #undef STEP
  #undef ENDW
  {auto rr=__builtin_amdgcn_permlane32_swap(__float_as_uint(l_reg),__float_as_uint(l_reg),false,false);l_reg=__uint_as_float(rr[0])+__uint_as_float(rr[1]);}
  if(hi==0)wsf[32+r32]=l_reg;asm volatile("s_waitcnt lgkmcnt(0)":::"memory");
  float rli[16];
  #pragma unroll
  for(int r=0;r<16;++r)rli[r]=__builtin_amdgcn_rcpf(wsf[32+crow(r,hi)]);
  bf16*Ow=O+(rowbase+q0+wid*QBLK)*ODM+h*D;
  { bf16*stg=(bf16*)(shm+LDS_OST)+wid*2048;
    #pragma unroll
    for(int r=0;r<16;++r){const int orow=crow(r,hi);
      #pragma unroll
      for(int d0=0;d0<2;++d0)stg[orow*64+d0*32+r32]=__float2bfloat16(o[d0][r]*rli[r]);}
    asm volatile("s_waitcnt lgkmcnt(0)":::"memory");
    #pragma unroll
    for(int i=0;i<4;++i){const int row=i*8+(lane>>3),ch=lane&7; const u32x4 v=*(const u32x4*)(stg+row*64+ch*8); ATTN_STORE16(Ow+(long)row*ODM+ch*8,v);} }
  asm volatile("s_waitcnt lgkmcnt(0)\n\ts_barrier":::"memory");
  #undef DMA_K
  #undef DMA_V
  #undef CMASK
  #undef START
  #undef RESC
  #undef ROT
}
constexpr int ATTN_LDS_BYTES=LDS_BYTES;
struct AttnTensors { const bf16* Q; const bf16* K; const bf16* V; bf16* O; const float* CK; const float* NRM; };
struct AttnUnit { int bh; int qb; };
struct StaticOrder {
  int vcu;
  __device__ __forceinline__ explicit StaticOrder(int grid,int block):vcu((block%8)*(grid/8)+block/8){}
  __device__ __forceinline__ bool next(int i,AttnUnit&u)const{ if(i>=8)return false; const int s=vcu&7,j=i&3; u.bh=(vcu>>3)+32*(i>>2); u.qb=(j==0)?s:(j==1)?15-s:(j==2)?16+s:31-s; return true; }
  __device__ __forceinline__ void a_ready(const AttnUnit&)const{}
  __device__ __forceinline__ void done(const AttnUnit&)const{}
};
struct DynOrder {
  unsigned*ctr; volatile __attribute__((address_space(3))) unsigned*slot; int x;
  __device__ __forceinline__ bool next(int,AttnUnit&u)const{
    if(threadIdx.x==0)*slot=atomicAdd(ctr+64*x,1u);
    __syncthreads(); const unsigned n=*slot; __syncthreads();
    if(n>=256u)return false; const int hs=7-(int)(n>>5), j=(x-hs)&7; u.bh=j*8+hs; u.qb=31-(int)(n&31u); return true; }
  __device__ __forceinline__ void a_ready(const AttnUnit&)const{}
  __device__ __forceinline__ void done(const AttnUnit&)const{}
};
template<class Sched,int THRL=32> __device__ __forceinline__ void attn_phase(char*lds,const AttnTensors&T,const Sched&S){
  AttnUnit u;
  for(int i=0;S.next(i,u);++i){ S.a_ready(u); { const float*nr=T.NRM+u.bh*4; const float tsk=ATTN_SKIP_LOG2+2.f+2.002f*sqrtf((nr[0]+nr[1])*(nr[2]+nr[3])); attn_unit<THRL>(u.bh/NHEAD,u.bh%NHEAD,u.qb,T.Q,T.K,T.V,T.O,lds,T.CK,tsk); } S.done(u); }
}
#undef SBAR
#undef WAIT_BAR
}
namespace cg = cooperative_groups;
#define LAS __attribute__((address_space(3)))
typedef unsigned v4u __attribute__((ext_vector_type(4)));
typedef unsigned v2u __attribute__((ext_vector_type(2)));
typedef float f32x4 __attribute__((ext_vector_type(4)));
using pg8::bf16_t;
#ifndef WGM_WIDE
#define WGM_WIDE 4
#endif
#ifndef WGM_NARROW
#define WGM_NARROW 2
#endif
constexpr int NWAVES = 8, SEQ = 8192, DM = 1024, NB = 8, DFF = 2816, NIN = 5128;
constexpr float LN_EPS = 1e-5f, LOG2E_F = 1.4426950408889634f;
constexpr size_t MiB = 1u << 20;
constexpr size_t WS_MOD = 0, WS_WFT = 512 * 1024, WS_NRM = 768 * 1024, WS_CTR = 772 * 1024, WS_BAR = 800 * 1024, WS_LF = 1 * MiB, WS_CK = 3 * MiB;
constexpr size_t WS_WIN = 6 * MiB, WS_WFS = 16 * MiB, WS_WO = 18 * MiB, WS_WUP = 20 * MiB, WS_WDN = 31 * MiB;
constexpr size_t WS_U = 40 * MiB;
constexpr size_t WS_QKV = 168 * MiB;
constexpr size_t WS_MERGED = WS_QKV + 128 * MiB;
constexpr size_t WS_ACT = WS_QKV;
constexpr size_t WS_G = 552 * MiB;
constexpr size_t WS_H1 = WS_G;
constexpr size_t WS_HALO = 808 * MiB;
constexpr size_t WS_END = 832 * MiB;
constexpr int RING_BYTES = 131072, XCH_OFF = RING_BYTES, MISC_OFF = XCH_OFF + 8192, LDS_BYTES = 147456;

#define LDS_WAIT() asm volatile("s_waitcnt lgkmcnt(0)" ::: "memory")
#define XB_TMO      128
#define XB_XCNT(j)  (256  + 64 * (j))
#define XB_XSUB(j)  (1280 + 64 * (j))
#define XB_XGEN(j)  (2304 + 64 * (j))
#define XB_TOP      3328
#define XB_TOPGEN   3392
#define XCD_BAR_WORDS 3456
#define XB_SPIN_CAP (1u << 18)

__device__ __forceinline__ unsigned xb_ld(unsigned* p)              { return __hip_atomic_load(p, __ATOMIC_RELAXED, __HIP_MEMORY_SCOPE_AGENT); }
__device__ __forceinline__ unsigned xb_add(unsigned* p, unsigned v) { return __hip_atomic_fetch_add(p, v, __ATOMIC_RELAXED, __HIP_MEMORY_SCOPE_AGENT); }
__device__ __forceinline__ unsigned xb_xcc_id() { return (unsigned)__builtin_amdgcn_s_getreg((3 << 11) | 20) & 0xFu; }
#define XB_SPIN(cond, bar) do { unsigned _sp = 0; while (cond) { __builtin_amdgcn_s_sleep(1); \
    if ((++_sp & 255u) == 0u) { if (xb_ld(&(bar)[XB_TMO])) break; if (_sp > XB_SPIN_CAP) { atomicAdd(&(bar)[XB_TMO], 1u); break; } } } } while (0)

struct XcdBarrier {
    unsigned* bar; unsigned x;
    volatile LAS unsigned* st;
};

__device__ __forceinline__ XcdBarrier xcd_barrier_post(unsigned* bar, volatile LAS unsigned* st) {
    XcdBarrier b; b.bar = bar; b.x = xb_xcc_id(); b.st = st;
    if (threadIdx.x == 0) (void)xb_add(&bar[XB_XCNT(b.x)], 1u);
    return b;
}
__device__ __forceinline__ void xcd_barrier_complete(unsigned* bar, unsigned x, unsigned& nloc, unsigned& nx) {
    const unsigned G = gridDim.x * gridDim.y * gridDim.z;
    unsigned sum, cnt, mine, sp = 0u;
    for (;;) {
        sum = 0u; cnt = 0u; mine = 0u;
#pragma unroll
        for (unsigned j = 0; j < 16; ++j) { const unsigned c = xb_ld(&bar[XB_XCNT(j)]); sum += c; cnt += (c > 0u) ? 1u : 0u; mine = (j == x) ? c : mine; }
        if (sum == G) break;
        __builtin_amdgcn_s_sleep(1);
        if ((++sp & 255u) == 0u) { if (xb_ld(&bar[XB_TMO])) break; if (sp > XB_SPIN_CAP) { atomicAdd(&bar[XB_TMO], 1u); break; } }
    }
    nloc = mine > 0u ? mine : 1u; nx = cnt > 0u ? cnt : 1u;
}

__device__ __forceinline__ void xcd_barrier(const XcdBarrier& b) {
    asm volatile("s_waitcnt vmcnt(0)" ::: "memory");
    __syncthreads();
    if (threadIdx.x == 0) {
        unsigned* bar = b.bar;
        __builtin_amdgcn_s_waitcnt(0);
        unsigned nloc = b.st[0], nx = b.st[1];
        if (nloc == 0u) { xcd_barrier_complete(bar, b.x, nloc, nx); b.st[0] = nloc; b.st[1] = nx; }
        const unsigned old = xb_add(&bar[XB_XSUB(b.x)], 1u);
        const unsigned gen = old / nloc;
        if (old + 1u == (gen + 1u) * nloc) {
            __builtin_amdgcn_fence(__ATOMIC_RELEASE, "agent");
            asm volatile("s_waitcnt vmcnt(0)" ::: "memory");
            const unsigned og = xb_add(&bar[XB_TOP], 1u);
            const unsigned tg = og / nx;
            if (og + 1u == (tg + 1u) * nx) xb_add(&bar[XB_TOPGEN], 1u);
            else XB_SPIN(xb_ld(&bar[XB_TOPGEN]) == tg, bar);
            __builtin_amdgcn_fence(__ATOMIC_ACQUIRE, "agent");
            xb_add(&bar[XB_XGEN(b.x)], 1u);
            asm volatile("s_waitcnt vmcnt(0)" ::: "memory");
        } else {
            XB_SPIN(xb_ld(&bar[XB_XGEN(b.x)]) == gen, bar);
            __builtin_amdgcn_fence(__ATOMIC_ACQUIRE, "agent");
            asm volatile("s_waitcnt vmcnt(0)" ::: "memory");
        }
    }
    __syncthreads();
}
__device__ __forceinline__ unsigned f2bf(float f) { unsigned u = __builtin_bit_cast(unsigned, f); return (u + 0x7fffu + ((u >> 16) & 1u)) >> 16; }
__device__ __forceinline__ unsigned pk2(float lo, float hi) { return f2bf(lo) | (f2bf(hi) << 16); }
__device__ __forceinline__ float wave_sum(float v) {
#pragma unroll
    for (int o = 1; o < 64; o <<= 1) v += __shfl_xor(v, o);
    return v;
}
__device__ __forceinline__ void wave_sum4(float (&s)[4]) {
#pragma unroll
    for (int o = 1; o < 64; o <<= 1) {
#pragma unroll
        for (int i = 0; i < 4; ++i) s[i] += __shfl_xor(s[i], o); }
}
__device__ __forceinline__ void tr_item(const float* W, int ldw, int srcc0, int k0, bf16_t* WT, int ldk, int dstr0, LAS float* scr, int lane, int dk0 = 0) {
#pragma unroll 8
    for (int i = 0; i < 32; ++i) { const int kk = 2 * i + (lane >> 5); scr[kk * 33 + (lane & 31)] = W[(size_t)(k0 + kk) * ldw + srcc0 + (lane & 31)]; }
    LDS_WAIT();
    const int c = lane & 7;
#pragma unroll
    for (int j = 0; j < 4; ++j) { const int n = (lane >> 3) + 8 * j; const LAS float* s = scr + (8 * c) * 33 + n;
        v4u o; o.x = pk2(s[0 * 33], s[1 * 33]); o.y = pk2(s[2 * 33], s[3 * 33]); o.z = pk2(s[4 * 33], s[5 * 33]); o.w = pk2(s[6 * 33], s[7 * 33]);
        *(v4u*)(WT + (size_t)(dstr0 + n) * ldk + dk0 + k0 + 8 * c) = o; }
    LDS_WAIT();
}

constexpr float SB_STICK_MIN = 3.3881318e-21f;
typedef short s16x8 __attribute__((ext_vector_type(8)));
typedef float f32x16 __attribute__((ext_vector_type(16)));
__device__ __forceinline__ int crow16(int r, int hi) { return (r & 3) + 8 * (r >> 2) + 4 * hi; }
template <bool DIAG> __device__ __forceinline__ float sb_weights(const f32x16& s, int k0, int q, int hi, float C, float (&av)[16]) {
    f32x4 uv[4], sf[4]; float own[4], oth[4], sufg[4];
#pragma unroll
    for (int i = 0; i < 4; ++i) {
        const f32x4 ex = (f32x4){__builtin_amdgcn_exp2f(__builtin_amdgcn_fmed3f(s[4 * i], -1e30f, 100.f)), __builtin_amdgcn_exp2f(__builtin_amdgcn_fmed3f(s[4 * i + 1], -1e30f, 100.f)),
                                 __builtin_amdgcn_exp2f(__builtin_amdgcn_fmed3f(s[4 * i + 2], -1e30f, 100.f)), __builtin_amdgcn_exp2f(__builtin_amdgcn_fmed3f(s[4 * i + 3], -1e30f, 100.f))};
        const f32x4 dn = ex + 1.0f;
        f32x4 ui = (f32x4){__builtin_amdgcn_rcpf(dn[0]), __builtin_amdgcn_rcpf(dn[1]), __builtin_amdgcn_rcpf(dn[2]), __builtin_amdgcn_rcpf(dn[3])};
        f32x4 bt = ex * ui;
        if (DIAG) {
#pragma unroll
            for (int p = 0; p < 4; ++p) { const bool valid = (k0 + crow16(4 * i + p, hi)) < q; ui[p] = valid ? ui[p] : 1.0f; bt[p] = valid ? bt[p] : 0.f; } }
        const float a3 = ui[3], a2 = a3 * ui[2], a1 = a2 * ui[1]; own[i] = a1 * ui[0];
        uv[i] = ui; sf[i] = bt * (f32x4){a1, a2, a3, 1.0f};
    }
#pragma unroll
    for (int i = 0; i < 4; ++i) oth[i] = __shfl_xor(own[i], 32);
    float accs = C;
#pragma unroll
    for (int i = 3; i >= 0; --i) { sufg[i] = (hi == 0) ? accs * oth[i] : accs; accs *= own[i] * oth[i]; }
#pragma unroll
    for (int i = 0; i < 4; ++i) { const f32x4 a = sf[i] * sufg[i]; av[4 * i] = a[0]; av[4 * i + 1] = a[1]; av[4 * i + 2] = a[2]; av[4 * i + 3] = a[3]; }
    return accs;
}
__device__ __forceinline__ void sb_unit(int b, int h, int qblk, const bf16_t* Q, const bf16_t* __restrict__ K, const bf16_t* __restrict__ V, bf16_t* O, LAS unsigned char* vst, int lane_) {
    int lane = lane_; asm volatile("" : "+v"(lane));
    const int r32 = lane & 31, hi = lane >> 5; const size_t rowbase = (size_t)b * SEQ; const int qw0 = qblk * 32, q = qw0 + r32;
    const bf16_t* Qw = Q + (rowbase + qw0) * 512 + h * 64;
    s16x8 qr[4];
#pragma unroll
    for (int d0 = 0; d0 < 4; ++d0) qr[d0] = *(const s16x8*)(Qw + (size_t)r32 * 512 + d0 * 16 + hi * 8);
    f32x16 o0 = {}, o1 = {}; float C = 1.f;
    s16x8 kn[4]; v4u vn[4];
    { const bf16_t* Kp = K + (rowbase + qblk * 32 + r32) * 512 + h * 64 + hi * 8;
#pragma unroll
      for (int d0 = 0; d0 < 4; ++d0) kn[d0] = *(const s16x8*)(Kp + d0 * 16);
#pragma unroll
      for (int i = 0; i < 4; ++i) { const int c = lane + 64 * i; vn[i] = *(const v4u*)(V + (rowbase + qblk * 32 + (c >> 3)) * 512 + h * 64 + (c & 7) * 8); } }
    for (int jt = qblk; jt >= 0; --jt) {
        const int k0 = jt * 32;
        s16x8 kf[4];
#pragma unroll
        for (int d0 = 0; d0 < 4; ++d0) kf[d0] = kn[d0];
#pragma unroll
        for (int i = 0; i < 4; ++i) { const int c = lane + 64 * i, key = c >> 3, part = c & 7; *(LAS v4u*)(vst + key * 144 + part * 16) = vn[i]; }
        if (jt > 0) { const bf16_t* Kp = K + (rowbase + k0 - 32 + r32) * 512 + h * 64 + hi * 8;
#pragma unroll
            for (int d0 = 0; d0 < 4; ++d0) kn[d0] = *(const s16x8*)(Kp + d0 * 16);
#pragma unroll
            for (int i = 0; i < 4; ++i) { const int c = lane + 64 * i; vn[i] = *(const v4u*)(V + (rowbase + k0 - 32 + (c >> 3)) * 512 + h * 64 + (c & 7) * 8); } }
        f32x16 s = {};
#pragma unroll
        for (int d0 = 0; d0 < 4; ++d0) s = __builtin_amdgcn_mfma_f32_32x32x16_bf16(kf[d0], qr[d0], s, 0, 0, 0);
        float av[16];
        if (jt == qblk) C = sb_weights<true>(s, k0, q, hi, C, av); else C = sb_weights<false>(s, k0, q, hi, C, av);
        v4u pa0, pa1;
        pa0.x = pg8::cvt_pk_bf16(av[0], av[1]); pa0.y = pg8::cvt_pk_bf16(av[2], av[3]); pa0.z = pg8::cvt_pk_bf16(av[4], av[5]); pa0.w = pg8::cvt_pk_bf16(av[6], av[7]);
        pa1.x = pg8::cvt_pk_bf16(av[8], av[9]); pa1.y = pg8::cvt_pk_bf16(av[10], av[11]); pa1.z = pg8::cvt_pk_bf16(av[12], av[13]); pa1.w = pg8::cvt_pk_bf16(av[14], av[15]);
        LDS_WAIT();
#pragma unroll
        for (int ks = 0; ks < 2; ++ks)
#pragma unroll
            for (int d0 = 0; d0 < 2; ++d0) { unsigned short e[8];
#pragma unroll
                for (int j = 0; j < 8; ++j) e[j] = *(const LAS unsigned short*)(vst + (16 * ks + 8 * (j >> 2) + 4 * hi + (j & 3)) * 144 + (32 * d0 + r32) * 2);
                v4u vb; vb.x = e[0] | ((unsigned)e[1] << 16); vb.y = e[2] | ((unsigned)e[3] << 16); vb.z = e[4] | ((unsigned)e[5] << 16); vb.w = e[6] | ((unsigned)e[7] << 16);
                const s16x8 pa = __builtin_bit_cast(s16x8, ks == 0 ? pa0 : pa1), vf = __builtin_bit_cast(s16x8, vb);
                if (d0 == 0) o0 = __builtin_amdgcn_mfma_f32_32x32x16_bf16(pa, vf, o0, 0, 0, 0); else o1 = __builtin_amdgcn_mfma_f32_32x32x16_bf16(pa, vf, o1, 0, 0, 0); }
        LDS_WAIT();
        if (__all((SKIP_LOG2 >= 149.f) ? (C == 0.f) : (C < SB_STICK_MIN))) break;
    }
    bf16_t* Ow = O + (rowbase + qw0) * 1024 + 512 + h * 64;
#pragma unroll
    for (int r = 0; r < 16; ++r) { const int orow = crow16(r, hi);
        Ow[(size_t)orow * 1024 + r32] = (bf16_t)f2bf(o0[r]); Ow[(size_t)orow * 1024 + 32 + r32] = (bf16_t)f2bf(o1[r]); }
}

struct Args { const float* in[17]; float* out; unsigned char* ws; };

__global__ void __launch_bounds__(NWAVES * 64, 2) fwd_mega(Args args) {
    extern __shared__ __attribute__((aligned(16))) unsigned char lds[];
    cg::grid_group grid = cg::this_grid();
    LAS unsigned char* L = (LAS unsigned char*)lds;
    const int tid = threadIdx.x, lane = tid & 63, wave = __builtin_amdgcn_readfirstlane(tid >> 6);
    const int G = gridDim.x, gw = blockIdx.x * NWAVES + wave, NGW = G * NWAVES;
    unsigned char* ws = args.ws;
    volatile LAS unsigned* xst = (volatile LAS unsigned*)(L + MISC_OFF + 512);
    if (tid == 0) { xst[0] = 0u; xst[1] = 0u; }
    __syncthreads();
    const XcdBarrier xbar = xcd_barrier_post((unsigned*)(ws + WS_BAR), xst);
#if defined(PROBE_AT)
    if (blockIdx.x == 0 && tid == 0) { *(volatile LAS unsigned long long*)(L + MISC_OFF + 256) = __builtin_amdgcn_s_memrealtime(); }
#define PROBE_MARK(k) do { if ((k) == PROBE_AT && blockIdx.x == 0 && tid == 0) { *(volatile LAS unsigned long long*)(L + MISC_OFF + 264) = __builtin_amdgcn_s_memrealtime(); } } while (0)
#else
#define PROBE_MARK(k) do {} while (0)
#endif
    const float* x = args.in[0]; const float* cvec = args.in[1]; const float* w_ada = args.in[2]; const float* b_ada = args.in[3]; const float* w_in = args.in[4];
    const float* b_forget = args.in[5]; const float* w_fox = args.in[6]; const float* w_sb = args.in[7]; const float* w_o = args.in[8];
    const float* ln1_g = args.in[9]; const float* ln1_b = args.in[10]; const float* w_up = args.in[11]; const float* conv_w = args.in[12]; const float* conv_b = args.in[13];
    const float* w_dn = args.in[14]; const float* ln2_g = args.in[15]; const float* ln2_b = args.in[16];
    float* MOD = (float*)(ws + WS_MOD); float* WFT = (float*)(ws + WS_WFT); float* LF = (float*)(ws + WS_LF); float* CK = (float*)(ws + WS_CK);
    bf16_t* WIN = (bf16_t*)(ws + WS_WIN); bf16_t* WFS = (bf16_t*)(ws + WS_WFS); bf16_t* WO = (bf16_t*)(ws + WS_WO); bf16_t* WUP = (bf16_t*)(ws + WS_WUP); bf16_t* WDN = (bf16_t*)(ws + WS_WDN);
    bf16_t* U = (bf16_t*)(ws + WS_U); bf16_t* QKV = (bf16_t*)(ws + WS_QKV); bf16_t* MERGED = (bf16_t*)(ws + WS_MERGED); bf16_t* ACT = (bf16_t*)(ws + WS_ACT);
    bf16_t* GATES = (bf16_t*)(ws + WS_G); float* H1 = (float*)(ws + WS_H1);
    const size_t SLOT = (size_t)MTOK * 512;
    bf16_t* QA = QKV; bf16_t* QB = QKV + SLOT; bf16_t* KA = QKV + 2 * SLOT; bf16_t* VA = QKV + 3 * SLOT; bf16_t* KB = QKV + 4 * SLOT; bf16_t* VB = QKV + 5 * SLOT;

#if !defined(SKIP_P0)
    {
        LAS float* scr = (LAS float*)(L + wave * 16384);
        constexpr int I_IN = 16 * 160, I_FS = 8 * 32, I_O = 16 * 32, I_UP = 16 * 176, I_DN = 44 * 32, I_MOD = 768;
        constexpr int NIT = I_MOD + I_IN + 2 * I_FS + I_O + I_UP + I_DN;
        for (int it = gw; it < NIT; it += NGW) {
            int r = it;
            if (r < I_MOD) {
                const int j0 = 8 * r; float a[8][8];
#pragma unroll
                for (int bb = 0; bb < 8; ++bb)
#pragma unroll
                    for (int j = 0; j < 8; ++j) a[bb][j] = 0.f;
#pragma unroll 4
                for (int i = 0; i < 16; ++i) { const int k = lane + 64 * i; const f32x4 w0 = *(const f32x4*)(w_ada + (size_t)k * 6144 + j0), w1 = *(const f32x4*)(w_ada + (size_t)k * 6144 + j0 + 4);
#pragma unroll
                    for (int bb = 0; bb < 8; ++bb) { const float cb = cvec[bb * 1024 + k];
                        a[bb][0] += cb * w0[0]; a[bb][1] += cb * w0[1]; a[bb][2] += cb * w0[2]; a[bb][3] += cb * w0[3]; a[bb][4] += cb * w1[0]; a[bb][5] += cb * w1[1]; a[bb][6] += cb * w1[2]; a[bb][7] += cb * w1[3]; } }
                float mine = 0.f;
#pragma unroll
                for (int bb = 0; bb < 8; ++bb)
#pragma unroll
                    for (int j = 0; j < 8; ++j) { const float s = wave_sum(a[bb][j]); if (lane == bb * 8 + j) mine = s; }
                MOD[(lane >> 3) * 6144 + j0 + (lane & 7)] = mine + b_ada[j0 + (lane & 7)];
                continue;
            }
            r -= I_MOD;
            if (r < I_IN) { const int kb = r / 160, nb = r % 160, n0 = 32 * nb; const int t = n0 - 3072;
                const int src = (n0 < 1536) ? n0 : (n0 < 3072) ? n0 + 8 : 3080 + ((t >> 7) & 1) * 1024 + 128 * (t >> 8) + (t & 127);
                tr_item(w_in, NIN, src, 64 * kb, WIN, 1024, n0, scr, lane); continue; } r -= I_IN;
            if (r < I_FS) { const int kb = r / 32, nb = r % 32; tr_item(w_fox, 1024, 32 * nb, 64 * kb, WFS, 1024, 32 * nb, scr, lane, 0); continue; } r -= I_FS;
            if (r < I_FS) { const int kb = r / 32, nb = r % 32; tr_item(w_sb, 1024, 32 * nb, 64 * kb, WFS, 1024, 32 * nb, scr, lane, 512); continue; } r -= I_FS;
            if (r < I_O) { const int kb = r / 32, nb = r % 32; tr_item(w_o, 1024, 32 * nb, 64 * kb, WO, 1024, 32 * nb, scr, lane); continue; } r -= I_O;
            if (r < I_UP) { const int kb = r / 176, nb = r % 176, nn0 = 32 * nb; const int src = ((nn0 >> 7) & 1) * DFF + 128 * (nn0 >> 8) + (nn0 & 127);
                tr_item(w_up, 2 * DFF, src, 64 * kb, WUP, 1024, nn0, scr, lane); continue; } r -= I_UP;
            { const int kb = r / 32, nb = r % 32; tr_item(w_dn, 1024, 32 * nb, 64 * kb, WDN, DFF, 32 * nb, scr, lane); }
        }
        if (blockIdx.x == 0) { ((float*)(ws + WS_NRM))[tid & 255] = 0.f; ((unsigned*)(ws + WS_CTR))[tid] = 0u; }
        for (int e = blockIdx.x * (NWAVES * 64) + tid; e < 8192; e += G * NWAVES * 64) WFT[e] = w_in[(size_t)(e & 1023) * NIN + 1536 + (e >> 10)];
    }
#endif
    if (G == 0x7fffffff) grid.sync();
    xcd_barrier(xbar);
    PROBE_MARK(0);

#if !defined(SKIP_P1)
    LAS f32x4* wfl = (LAS f32x4*)L;
    for (int i = tid; i < 2048; i += NWAVES * 64) wfl[i] = ((const f32x4*)WFT)[i];
    __syncthreads();
    for (int blk = gw; blk < MTOK / 32; blk += NGW) {
        const int m0 = blk * 32, b = m0 >> 13; const float* mb = MOD + (size_t)b * 6144;
        const float bf = b_forget[lane & 7];
        f32x4 xn[4];
#pragma unroll
        for (int j = 0; j < 4; ++j) xn[j] = ((const f32x4*)(x + (size_t)m0 * 1024) + lane)[64 * j];
        for (int r = 0; r < 32; ++r) {
            const int m = m0 + r; unsigned long long* o8 = (unsigned long long*)(U + (size_t)m * 1024) + lane;
            f32x4 u[4], xc[4];
#pragma unroll
            for (int j = 0; j < 4; ++j) xc[j] = xn[j];
            if (r < 31) {
#pragma unroll
                for (int j = 0; j < 4; ++j) xn[j] = ((const f32x4*)(x + (size_t)(m + 1) * 1024) + lane)[64 * j]; }
#pragma unroll
            for (int j = 0; j < 4; ++j) { const f32x4 shj = *(const f32x4*)(mb + 4 * lane + 256 * j), scj = *(const f32x4*)(mb + 1024 + 4 * lane + 256 * j) + 1.0f; u[j] = xc[j] * scj + shj; o8[64 * j] = (unsigned long long)pk2(u[j][0], u[j][1]) | ((unsigned long long)pk2(u[j][2], u[j][3]) << 32); }
            float mine = 0.f;
#pragma unroll
            for (int hh = 0; hh < 8; ++hh) { float s = 0.f;
#pragma unroll
                for (int j = 0; j < 4; ++j) { const f32x4 p = u[j] * wfl[hh * 256 + lane + 64 * j]; s += (p[0] + p[1]) + (p[2] + p[3]); }
                s = wave_sum(s); if ((lane & 7) == hh) mine = s; }
            if (lane < 8) { const float f = mine + bf; const float ls = (f >= 0.f) ? -log1pf(expf(-f)) : (f - log1pf(expf(f)));
                LF[((size_t)(b * 8 + lane)) * SEQ + (m & (SEQ - 1))] = ls * LOG2E_F; }
        }
    }
#endif
    xcd_barrier(xbar);
    PROBE_MARK(1);

#if !defined(SKIP_P2)
    if (blockIdx.x < 64) {
        LAS double* sm = (LAS double*)(L + MISC_OFF);
        const float* src = LF + (size_t)blockIdx.x * SEQ + 16 * tid; float* dst = CK + (size_t)blockIdx.x * SEQ + 16 * tid;
        f32x4 v[4]; double loc[16]; double run = 0.0;
#pragma unroll
        for (int j = 0; j < 4; ++j) v[j] = *(const f32x4*)(src + 4 * j);
#pragma unroll
        for (int i = 0; i < 16; ++i) { run += (double)v[i >> 2][i & 3]; loc[i] = run; }
        double inc = run;
#pragma unroll
        for (int o = 1; o < 64; o <<= 1) { const double t = __shfl_up(inc, o); if (lane >= o) inc += t; }
        if (lane == 63) sm[wave] = inc;
        __syncthreads();
        double woff = 0.0;
        for (int w = 0; w < wave; ++w) woff += sm[w];
        const double excl = woff + inc - run;
#pragma unroll
        for (int j = 0; j < 4; ++j) *(f32x4*)(dst + 4 * j) = (f32x4){(float)(excl + loc[4 * j]), (float)(excl + loc[4 * j + 1]), (float)(excl + loc[4 * j + 2]), (float)(excl + loc[4 * j + 3])};
        __syncthreads();
    }
    {
        pg8::Gemm g{U, WIN, MTOK, 5120, 1024, (size_t)256 * 1024 * 2}; pg8::StaticOrder S; S.init(MTOK, 5120, G, (int)blockIdx.x); S.wgm = WGM_WIDE;
        pg8::EpiInProj E{QKV, GATES, (unsigned*)(ws + WS_NRM)};
        pg8::gemm_phase<pg8::EpiInProj, pg8::StaticOrder, true, true>(L, g, S, E);
    }
#endif
    xcd_barrier(xbar);
    PROBE_MARK(2);

#if !defined(SKIP_P3)
    {
        LAS unsigned char* vst = L + wave * 4608;
        for (int i = 0; i < (64 * 256) / NGW + 1; ++i) { const int uid = i * NGW + gw; if (uid >= 64 * 256) break; const int bh = uid >> 8, qblk = uid & 255;
            sb_unit(bh >> 3, bh & 7, qblk, QB, KB, VB, U, vst, lane); }
        __syncthreads();
        PROBE_MARK(20);
        const attn_body::AttnTensors AT{(const attn_body::bf16*)QA, (const attn_body::bf16*)KA, (const attn_body::bf16*)VA, (attn_body::bf16*)U, CK, (const float*)(ws + WS_NRM)};
        const attn_body::DynOrder S{(unsigned*)(ws + WS_CTR), (volatile LAS unsigned*)(L + MISC_OFF + 128), (int)(blockIdx.x & 7)};
        attn_body::attn_phase<attn_body::DynOrder>((char*)lds, AT, S);
    }
#endif
    xcd_barrier(xbar);
    PROBE_MARK(3);

#if !defined(SKIP_P4)
    {
        pg8::Gemm g{U, WFS, MTOK, 1024, 1024, (size_t)256 * 1024 * 2}; pg8::StaticOrder S; S.init(MTOK, 1024, G, (int)blockIdx.x); S.wgm = WGM_NARROW;
        pg8::EpiMerge E{GATES, MERGED};
        pg8::gemm_phase<pg8::EpiMerge, pg8::StaticOrder, true, true>(L, g, S, E);
    }
#endif
    xcd_barrier(xbar);
    PROBE_MARK(4);

#if !defined(SKIP_P5)
    {
        pg8::Gemm g{MERGED, WO, MTOK, 1024, 1024, (size_t)256 * 1024 * 2}; pg8::StaticOrder S; S.init(MTOK, 1024, G, (int)blockIdx.x); S.wgm = WGM_NARROW;
        pg8::EpiBranch E{MOD + 2048, U};
        pg8::gemm_phase<pg8::EpiBranch, pg8::StaticOrder, true, true>(L, g, S, E);
    }
#endif
    xcd_barrier(xbar);
    PROBE_MARK(5);

#if !defined(SKIP_P6)
    for (int blk = gw; blk < MTOK / 32; blk += NGW) {
        const int m0 = blk * 32, b = m0 >> 13; const float* mb = MOD + (size_t)b * 6144;
        f32x4 sc[4], sh[4], lg[4], lb[4];
#pragma unroll
        for (int j = 0; j < 4; ++j) { sh[j] = *(const f32x4*)(mb + 3072 + 4 * lane + 256 * j); sc[j] = *(const f32x4*)(mb + 4096 + 4 * lane + 256 * j) + 1.0f;
            lg[j] = *(const f32x4*)(ln1_g + 4 * lane + 256 * j); lb[j] = *(const f32x4*)(ln1_b + 4 * lane + 256 * j); }
        for (int g4 = 0; g4 < 8; ++g4) {
            const int mg = m0 + 4 * g4;
            f32x4 v[4][4]; unsigned long long bb[4][4];
#pragma unroll
            for (int i = 0; i < 4; ++i)
#pragma unroll
                for (int j = 0; j < 4; ++j) { v[i][j] = ((const f32x4*)(x + (size_t)(mg + i) * 1024) + lane)[64 * j]; bb[i][j] = ((const unsigned long long*)(U + (size_t)(mg + i) * 1024) + lane)[64 * j]; }
            float s[4], s2[4];
#pragma unroll
            for (int i = 0; i < 4; ++i) { s[i] = 0.f;
#pragma unroll
                for (int j = 0; j < 4; ++j) { const unsigned blo = (unsigned)bb[i][j], bhi = (unsigned)(bb[i][j] >> 32);
                    v[i][j] = v[i][j] * DN_ALPHA + (f32x4){pg8::bflo(blo), pg8::bfhi(blo), pg8::bflo(bhi), pg8::bfhi(bhi)}; s[i] += (v[i][j][0] + v[i][j][1]) + (v[i][j][2] + v[i][j][3]); } }
            wave_sum4(s);
#pragma unroll
            for (int i = 0; i < 4; ++i) { const float mean = s[i] * (1.f / 1024.f); s2[i] = 0.f;
#pragma unroll
                for (int j = 0; j < 4; ++j) { v[i][j] = v[i][j] - mean; s2[i] += (v[i][j][0] * v[i][j][0] + v[i][j][1] * v[i][j][1]) + (v[i][j][2] * v[i][j][2] + v[i][j][3] * v[i][j][3]); } }
            wave_sum4(s2);
#pragma unroll
            for (int i = 0; i < 4; ++i) { const float rstd = 1.f / sqrtf(s2[i] * (1.f / 1024.f) + LN_EPS);
                unsigned long long* hr = (unsigned long long*)((bf16_t*)H1 + (size_t)(mg + i) * 1024) + lane; unsigned long long* o8 = (unsigned long long*)(U + (size_t)(mg + i) * 1024) + lane;
#pragma unroll
                for (int j = 0; j < 4; ++j) { const f32x4 x1 = v[i][j] * rstd * lg[j] + lb[j]; hr[64 * j] = (unsigned long long)pk2(x1[0], x1[1]) | ((unsigned long long)pk2(x1[2], x1[3]) << 32);
                    const f32x4 u2 = x1 * sc[j] + sh[j]; o8[64 * j] = (unsigned long long)pk2(u2[0], u2[1]) | ((unsigned long long)pk2(u2[2], u2[3]) << 32); } }
        }
    }
#endif
    xcd_barrier(xbar);
    PROBE_MARK(6);

#if !defined(SKIP_P7)
    {
        pg8::Gemm g{U, WUP, MTOK, 2 * DFF, 1024, (size_t)256 * 1024 * 2}; pg8::StaticOrder S; S.init(MTOK, 2 * DFF, G, (int)blockIdx.x); S.wgm = WGM_WIDE;
        pg8::EpiUpConv E{conv_w, conv_b, ACT, (LAS f32x4*)(L + XCH_OFF), (LAS float*)(L + MISC_OFF + 1024), (float*)(ws + WS_HALO)};
        pg8::gemm_phase<pg8::EpiUpConv, pg8::StaticOrder, true, true>(L, g, S, E);
    }
    xcd_barrier(xbar);
    {
        const float* HALO = (const float*)(ws + WS_HALO);
        for (int idx = blockIdx.x * (NWAVES * 64) + tid; idx < 43 * DFF; idx += G * NWAVES * 64) {
            const int pg = idx / DFF, ch = idx - pg * DFF, nng = 256 * (ch >> 7) + (ch & 127);
            float w0[2], w1[2], w2[2], bb[2];
#pragma unroll
            for (int v = 0; v < 2; ++v) { const int cc = ch + DFF * v; w0[v] = conv_w[cc]; w1[v] = conv_w[5632 + cc]; w2[v] = conv_w[2 * 5632 + cc]; bb[v] = conv_b[cc]; }
            float h0[6][2], h1[6][2], hm2[6][2], hm1[6][2];
#pragma unroll
            for (int k = 0; k < 6; ++k) { const int p = 6 * pg + k; const bool in = p < 256, s0 = (p & 31) == 0;
                const float* Hc = HALO + (size_t)(in ? p : 0) * 4 * 5632; const float* Hp = Hc - (s0 ? 0 : 4 * 5632);
#pragma unroll
                for (int v = 0; v < 2; ++v) { const int nn = nng + 128 * v; h0[k][v] = Hc[nn]; h1[k][v] = Hc[5632 + nn]; hm2[k][v] = Hp[2 * 5632 + nn]; hm1[k][v] = Hp[3 * 5632 + nn]; } }
#pragma unroll
            for (int k = 0; k < 6; ++k) { const int p = 6 * pg + k; if (p >= 256) break; const bool s0 = (p & 31) == 0; float cr0[2], cr1[2];
#pragma unroll
                for (int v = 0; v < 2; ++v) { const float a2 = s0 ? 0.f : hm2[k][v], a1 = s0 ? 0.f : hm1[k][v];
                    cr0[v] = bb[v] + w0[v] * a2 + w1[v] * a1 + w2[v] * h0[k][v]; cr1[v] = bb[v] + w0[v] * a1 + w1[v] * h0[k][v] + w2[v] * h1[k][v]; }
                ACT[(size_t)(256 * p) * DFF + ch] = (bf16_t)f2bf(cr0[0] * pg8::sigm(cr0[0]) * cr0[1]);
                ACT[(size_t)(256 * p + 1) * DFF + ch] = (bf16_t)f2bf(cr1[0] * pg8::sigm(cr1[0]) * cr1[1]); }
        }
    }
#endif
    xcd_barrier(xbar);
    PROBE_MARK(7);

#if !defined(SKIP_P8)
    {
        pg8::Gemm g{ACT, WDN, MTOK, 1024, DFF, (size_t)256 * DFF * 2}; pg8::StaticOrder S; S.init(MTOK, 1024, G, (int)blockIdx.x); S.wgm = WGM_NARROW;
        pg8::EpiBranch E{MOD + 5120, U};
        pg8::gemm_phase<pg8::EpiBranch, pg8::StaticOrder, true, true>(L, g, S, E);
    }
#endif
    xcd_barrier(xbar);
    PROBE_MARK(8);

#if !defined(SKIP_P9)
    {
        f32x4 lg[4], lb[4]; const bf16_t* X1B = (const bf16_t*)H1;
#pragma unroll
        for (int j = 0; j < 4; ++j) { lg[j] = *(const f32x4*)(ln2_g + 4 * lane + 256 * j); lb[j] = *(const f32x4*)(ln2_b + 4 * lane + 256 * j); }
        for (int blk = gw; blk < MTOK / 32; blk += NGW)
        for (int g4 = 0; g4 < 8; ++g4) {
            const int mg = blk * 32 + 4 * g4;
            unsigned long long xb[4][4], bb[4][4];
#pragma unroll
            for (int i = 0; i < 4; ++i)
#pragma unroll
                for (int j = 0; j < 4; ++j) { xb[i][j] = ((const unsigned long long*)(X1B + (size_t)(mg + i) * 1024) + lane)[64 * j]; bb[i][j] = ((const unsigned long long*)(U + (size_t)(mg + i) * 1024) + lane)[64 * j]; }
            f32x4 v[4][4]; float s[4], s2[4];
#pragma unroll
            for (int i = 0; i < 4; ++i) { s[i] = 0.f;
#pragma unroll
                for (int j = 0; j < 4; ++j) { const unsigned xlo = (unsigned)xb[i][j], xhi = (unsigned)(xb[i][j] >> 32), blo = (unsigned)bb[i][j], bhi = (unsigned)(bb[i][j] >> 32);
                    v[i][j] = (f32x4){pg8::bflo(xlo), pg8::bfhi(xlo), pg8::bflo(xhi), pg8::bfhi(xhi)} * DN_ALPHA + (f32x4){pg8::bflo(blo), pg8::bfhi(blo), pg8::bflo(bhi), pg8::bfhi(bhi)};
                    s[i] += (v[i][j][0] + v[i][j][1]) + (v[i][j][2] + v[i][j][3]); } }
            wave_sum4(s);
#pragma unroll
            for (int i = 0; i < 4; ++i) { const float mean = s[i] * (1.f / 1024.f); s2[i] = 0.f;
#pragma unroll
                for (int j = 0; j < 4; ++j) { v[i][j] = v[i][j] - mean; s2[i] += (v[i][j][0] * v[i][j][0] + v[i][j][1] * v[i][j][1]) + (v[i][j][2] * v[i][j][2] + v[i][j][3] * v[i][j][3]); } }
            wave_sum4(s2);
#pragma unroll
            for (int i = 0; i < 4; ++i) { const float rstd = 1.f / sqrtf(s2[i] * (1.f / 1024.f) + LN_EPS); f32x4* hr = (f32x4*)(args.out + (size_t)(mg + i) * 1024) + lane;
#pragma unroll
                for (int j = 0; j < 4; ++j) hr[64 * j] = v[i][j] * rstd * lg[j] + lb[j]; }
        }
    }
#endif
#if defined(PROBE_AT)
    if (blockIdx.x == 0 && tid == 0) { const unsigned long long a = *(volatile LAS unsigned long long*)(L + MISC_OFF + 256), b = *(volatile LAS unsigned long long*)(L + MISC_OFF + 264);
        const unsigned long long t1 = __builtin_amdgcn_s_memrealtime(); while (__builtin_amdgcn_s_memrealtime() - t1 < 2 * (b - a)) __builtin_amdgcn_s_sleep(8); }
#endif
}

extern "C" void kernel_launch(void* const* d_in, const int* in_sizes, int n_in, void* d_out, int out_size, void* d_ws, size_t ws_size, hipStream_t stream) {
    static int grid = 0;
    if (grid == 0) {
        if (n_in != 17 || out_size != MTOK * 1024 || ws_size < WS_END) { fprintf(stderr, "kernel_launch: unexpected shapes (n_in %d out %d ws %zu)\n", n_in, out_size, ws_size); grid = -1; return; }
        int dev = 0, cus = 0, per_cu = 0;
        hipGetDevice(&dev); hipDeviceGetAttribute(&cus, hipDeviceAttributeMultiprocessorCount, dev);
        if (hipFuncSetAttribute((const void*)fwd_mega, hipFuncAttributeMaxDynamicSharedMemorySize, LDS_BYTES) != hipSuccess) { fprintf(stderr, "kernel_launch: hipFuncSetAttribute failed\n"); grid = -1; return; }
        hipOccupancyMaxActiveBlocksPerMultiprocessor(&per_cu, (const void*)fwd_mega, NWAVES * 64, LDS_BYTES);
        (void)hipGetLastError();
        if (per_cu < 1) per_cu = 1;
        grid = cus * 1;
    }
    if (grid < 0) return;
    if (hipMemsetAsync((char*)d_ws + WS_BAR, 0, XCD_BAR_WORDS * 4, stream) != hipSuccess) { fprintf(stderr, "kernel_launch: memset of the barrier words failed\n"); return; }
    Args a{};
    for (int i = 0; i < 17; ++i) a.in[i] = (const float*)d_in[i];
    a.out = (float*)d_out; a.ws = (unsigned char*)d_ws;
    void* kargs[] = {&a};
    hipError_t e = hipLaunchCooperativeKernel((const void*)fwd_mega, dim3(grid), dim3(NWAVES * 64), kargs, LDS_BYTES, stream);
    if (e != hipSuccess) fprintf(stderr, "cooperative launch failed: %s (grid %d)\n", hipGetErrorString(e), grid);
}
```

```cpp
#include <hip/hip_runtime.h>
#include <hip/hip_cooperative_groups.h>
#include <cstdio>
#include <cstdint>
constexpr int MTOK = 65536;
constexpr float DN_ALPHA = 1.189207115002721f;
#ifndef SKIP_LOG2
#define SKIP_LOG2 68.0f
#endif
namespace pg8 {
#define PG8_LAS __attribute__((address_space(3)))
typedef unsigned short bf16_t;
typedef short bf16x8 __attribute__((ext_vector_type(8)));
typedef float f32x4 __attribute__((ext_vector_type(4)));
typedef unsigned u32x4 __attribute__((ext_vector_type(4)));
constexpr int BM = 256, BK = 64, HALF = 128, HTB = HALF * BK * 2  , STAGE_BYTES = 8 * HTB, NXCD = 8, WGM = 8;

__host__ __device__ __forceinline__ int lds_byte(int r, int c) { const int st = (r >> 4) * 2 + (c >> 5), rr = r & 15, cc = c & 31, ob = rr * 64 + cc * 2; return st * 1024 + (ob ^ (((ob >> 9) & 1) << 5)); }
__host__ __device__ __forceinline__ void stage_rc(int b, int& R, int& C) { const int st = b / 1024, sb = b % 1024, swz = sb ^ (((sb >> 9) & 1) << 5); R = (st >> 1) * 16 + swz / 64; C = (st & 1) * 32 + (swz % 64) / 2; }
__host__ __device__ __forceinline__ int perm32(int rho) { const int n = rho >> 4, i = rho & 15; return 8 * (i >> 2) + 4 * n + (i & 3); }

struct Unit { int pm, pn; };
struct Gemm { const bf16_t* A; const bf16_t* Bt; int M, N, K; size_t a_tstep; };

struct StaticOrder {
    int nM, nN, nwg, G, c, wgm = WGM;
    __host__ __device__ void init(int M, int N, int G_, int c_) { nM = M / BM; nN = N / BM; nwg = nM * nN; G = G_; c = c_; }
    __host__ __device__ void init_tiles(int nM_, int nN_, int G_, int c_) { nM = nM_; nN = nN_; nwg = nM * nN; G = G_; c = c_; }
    __host__ __device__ bool next(int i, Unit& u) const {
        const long L = (long)i * G + c; if (L >= nwg) return false;
        int wgid = (int)L; { const int q = nwg / NXCD, r = nwg % NXCD, xcd = wgid % NXCD, off = wgid / NXCD; wgid = (xcd < r ? xcd * (q + 1) : r * (q + 1) + (xcd - r) * q) + off; }
        const int nig = wgm * nN, gid = wgid / nig, fm = gid * wgm, gsz = (nM - fm) < wgm ? (nM - fm) : wgm;
        u.pm = fm + ((wgid % nig) % gsz); u.pn = (wgid % nig) / gsz; return true;
    }
    __device__ __forceinline__ void a_ready(const Unit&) const {}
    __device__ __forceinline__ void done(const Unit&) const {}
};

__device__ __forceinline__ unsigned cvt_pk_bf16(float lo, float hi) { unsigned r; asm volatile("v_cvt_pk_bf16_f32 %0, %1, %2" : "=v"(r) : "v"(lo), "v"(hi)); return r; }
typedef float f32x2 __attribute__((ext_vector_type(2)));
constexpr float C2f = 0.125f * 1.4426950408889634f;
constexpr float LOG2E = 1.4426950408889634f;
__device__ __forceinline__ float sigm(float v) { return __builtin_amdgcn_rcpf(1.0f + __builtin_amdgcn_exp2f(-LOG2E * v)); }
__device__ __forceinline__ float bflo(unsigned w) { return __builtin_bit_cast(float, w << 16); }
__device__ __forceinline__ float bfhi(unsigned w) { return __builtin_bit_cast(float, w & 0xffff0000u); }

struct EpiInProj {
    static constexpr bool PERM = true, AFTER_DRAIN = false, HAS_MID = false;
    bf16_t* qkv; bf16_t* gates; unsigned* nrm;
    __device__ __forceinline__ void operator()(const f32x4 (&acc)[2][2][4][2], const Unit& u, int wr, int wc, int fr, int fq) const {
        const int pn = u.pn; bf16_t* base; int ldc, colt; float sc = 1.f; bool sg = false;
        if (pn < 12) { const int t = pn >> 1, slot = (0x541320 >> (4 * t)) & 7; base = qkv + (size_t)slot * ((size_t)MTOK * 512); ldc = 512; colt = (pn & 1) * 256; if (t == 0 || t == 3) sc = C2f; }
        else { base = gates; ldc = 1024; colt = (pn - 12) * 128; sg = true; }
        const int row0 = u.pm * BM + wr * 64 + fr, col0 = colt + wc * 32 + 8 * fq;
        float nmx[2] = {0.f, 0.f};
#pragma unroll
        for (int ai = 0; ai < 2; ++ai)
#pragma unroll
            for (int m = 0; m < 4; ++m) { bf16_t* rowp = base + (size_t)(row0 + ai * HALF + m * 16) * ldc + col0;
                if (sg) {
                    f32x4 rr[2], gg[2];
#pragma unroll
                    for (int n = 0; n < 2; ++n)
#pragma unroll
                        for (int j = 0; j < 4; ++j) { const float ea = __builtin_amdgcn_exp2f(-LOG2E * acc[ai][0][m][n][j]), eb = __builtin_fminf(__builtin_amdgcn_exp2f(-LOG2E * acc[ai][1][m][n][j]), 1e30f);
                            gg[n][j] = __builtin_amdgcn_rcpf(1.0f + eb); rr[n][j] = (1.0f + eb) * __builtin_amdgcn_rcpf(1.0f + ea); }
                    u32x4 w; w.x = cvt_pk_bf16(rr[0][0], rr[0][1]); w.y = cvt_pk_bf16(rr[0][2], rr[0][3]); w.z = cvt_pk_bf16(rr[1][0], rr[1][1]); w.w = cvt_pk_bf16(rr[1][2], rr[1][3]);
                    *(u32x4*)rowp = w;
                    w.x = cvt_pk_bf16(gg[0][0], gg[0][1]); w.y = cvt_pk_bf16(gg[0][2], gg[0][3]); w.z = cvt_pk_bf16(gg[1][0], gg[1][1]); w.w = cvt_pk_bf16(gg[1][2], gg[1][3]);
                    *(u32x4*)(rowp + (size_t)MTOK * 1024) = w;
                    continue; }
#pragma unroll
                for (int bj = 0; bj < 2; ++bj) { f32x4 v0 = acc[ai][bj][m][0], v1 = acc[ai][bj][m][1];
                    if (pn < 4) { const float a0 = bflo(cvt_pk_bf16(v0[0] * sc, 0.f)), a1 = bflo(cvt_pk_bf16(v0[1] * sc, 0.f)), a2 = bflo(cvt_pk_bf16(v0[2] * sc, 0.f)), a3 = bflo(cvt_pk_bf16(v0[3] * sc, 0.f)),
                                      a4 = bflo(cvt_pk_bf16(v1[0] * sc, 0.f)), a5 = bflo(cvt_pk_bf16(v1[1] * sc, 0.f)), a6 = bflo(cvt_pk_bf16(v1[2] * sc, 0.f)), a7 = bflo(cvt_pk_bf16(v1[3] * sc, 0.f));
                        float s = (a0 * a0 + a1 * a1) + (a2 * a2 + a3 * a3) + (a4 * a4 + a5 * a5) + (a6 * a6 + a7 * a7);
                        s += __shfl_xor(s, 16); s += __shfl_xor(s, 32); nmx[bj] = __builtin_fmaxf(nmx[bj], s); }
                    v0 = v0 * sc; v1 = v1 * sc;
                    u32x4 w; w.x = cvt_pk_bf16(v0[0], v0[1]); w.y = cvt_pk_bf16(v0[2], v0[3]); w.z = cvt_pk_bf16(v1[0], v1[1]); w.w = cvt_pk_bf16(v1[2], v1[3]);
                    *(u32x4*)(rowp + bj * HALF) = w; } }
        if (pn < 4) {
#pragma unroll
            for (int bj = 0; bj < 2; ++bj) { float s = nmx[bj] * 1.0001f;
#pragma unroll
                for (int o = 1; o < 16; o <<= 1) s = __builtin_fmaxf(s, __shfl_xor(s, o));
                if (fr == 0 && fq == 0) atomicMax(nrm + (((u.pm >> 5) * 8 + (pn & 1) * 4 + bj * 2 + (wc >> 1)) * 2 + (pn >> 1)) * 2 + (wc & 1), __builtin_bit_cast(unsigned, s)); }
        }
    }
};

struct EpiMerge {
    static constexpr bool PERM = true, AFTER_DRAIN = false, HAS_MID = true;
    const bf16_t* gates; bf16_t* merged;
    __device__ __forceinline__ void mid(f32x4 (&acc)[2][2][4][2], const Unit& u, int wr, int wc, int, int) const {
        int t_ = threadIdx.x; asm volatile("" : "+v"(t_)); const int fr = t_ & 15, fq = (t_ >> 4) & 3;
        const int row0 = u.pm * BM + wr * 64 + fr, col0 = u.pn * BM + wc * 32 + 8 * fq; const bf16_t* R = gates;
#pragma unroll
        for (int ai = 0; ai < 2; ++ai)
#pragma unroll
            for (int m = 0; m < 4; ++m)
#pragma unroll
                for (int bj = 0; bj < 2; ++bj) { const size_t off = (size_t)(row0 + ai * HALF + m * 16) * 1024 + col0 + bj * HALF;
                    const u32x4 a = *(const u32x4*)(R + off);
                    acc[ai][bj][m][0] = acc[ai][bj][m][0] * (f32x4){bflo(a.x), bfhi(a.x), bflo(a.y), bfhi(a.y)};
                    acc[ai][bj][m][1] = acc[ai][bj][m][1] * (f32x4){bflo(a.z), bfhi(a.z), bflo(a.w), bfhi(a.w)}; }
    }
    __device__ __forceinline__ void operator()(const f32x4 (&acc)[2][2][4][2], const Unit& u, int wr, int wc, int fr, int fq) const {
        const bf16_t* GB = gates + (size_t)MTOK * 1024;
        const int row0 = u.pm * BM + wr * 64 + fr, col0 = u.pn * BM + wc * 32 + 8 * fq;
#pragma unroll
        for (int ai = 0; ai < 2; ++ai)
#pragma unroll
            for (int m = 0; m < 4; ++m)
#pragma unroll
                for (int bj = 0; bj < 2; ++bj) { const size_t off = (size_t)(row0 + ai * HALF + m * 16) * 1024 + col0 + bj * HALF;
                    const u32x4 b = *(const u32x4*)(GB + off);
#define PG8_CL(x, f) f(x)
                    const f32x4 v0 = acc[ai][bj][m][0] * (f32x4){PG8_CL(b.x, bflo), PG8_CL(b.x, bfhi), PG8_CL(b.y, bflo), PG8_CL(b.y, bfhi)};
                    const f32x4 v1 = acc[ai][bj][m][1] * (f32x4){PG8_CL(b.z, bflo), PG8_CL(b.z, bfhi), PG8_CL(b.w, bflo), PG8_CL(b.w, bfhi)};
#undef PG8_CL
                    u32x4 w; w.x = cvt_pk_bf16(v0[0], v0[1]); w.y = cvt_pk_bf16(v0[2], v0[3]); w.z = cvt_pk_bf16(v1[0], v1[1]); w.w = cvt_pk_bf16(v1[2], v1[3]);
                    *(u32x4*)(merged + off) = w; }
    }
};

struct EpiBranch {
    static constexpr bool PERM = true, AFTER_DRAIN = false, HAS_MID = false;
    const float* gt; bf16_t* out;
    __device__ __forceinline__ void operator()(const f32x4 (&acc)[2][2][4][2], const Unit& u, int wr, int wc, int fr, int fq) const {
        const int row0 = u.pm * BM + wr * 64 + fr, col0 = u.pn * BM + wc * 32 + 8 * fq; const float* g = gt + (size_t)(u.pm >> 5) * 6144 + col0;
#pragma unroll
        for (int bj = 0; bj < 2; ++bj) { const f32x4 g0 = *(const f32x4*)(g + bj * HALF) + 1.0f, g1 = *(const f32x4*)(g + bj * HALF + 4) + 1.0f;
#pragma unroll
            for (int ai = 0; ai < 2; ++ai)
#pragma unroll
                for (int m = 0; m < 4; ++m) { const f32x4 v0 = g0 * acc[ai][bj][m][0], v1 = g1 * acc[ai][bj][m][1];
                    u32x4 w; w.x = cvt_pk_bf16(v0[0], v0[1]); w.y = cvt_pk_bf16(v0[2], v0[3]); w.z = cvt_pk_bf16(v1[0], v1[1]); w.w = cvt_pk_bf16(v1[2], v1[3]);
                    *(u32x4*)(out + (size_t)(row0 + ai * HALF + m * 16) * 1024 + col0 + bj * HALF) = w; } }
    }
};

struct EpiUpConv {
    static constexpr bool PERM = true, AFTER_DRAIN = false, HAS_MID = false;
    const float* cw; const float* cb; bf16_t* act; PG8_LAS f32x4* xch; PG8_LAS float* wl; float* halo;
    template <int CTRL> static __device__ __forceinline__ float ror_d(float x) { return __builtin_bit_cast(float, __builtin_amdgcn_update_dpp(0, __builtin_bit_cast(int, x), CTRL, 0xf, 0xf, true)); }
    template <bool SEQ0> __device__ __forceinline__ f32x4 conv1(const f32x4 cur, const f32x4 prv, const f32x4 w0, const f32x4 w1, const f32x4 w2, const f32x4 bb, int fr, int s1, int s2, int tseq) const {
        const f32x4 a1 = (fr >= 15) ? prv : cur, a2 = (fr >= 14) ? prv : cur;
        f32x4 p1, p2;
        p1 = (f32x4){ror_d<0x121>(a1[0]), ror_d<0x121>(a1[1]), ror_d<0x121>(a1[2]), ror_d<0x121>(a1[3])};
        p2 = (f32x4){ror_d<0x122>(a2[0]), ror_d<0x122>(a2[1]), ror_d<0x122>(a2[2]), ror_d<0x122>(a2[3])};
        if (SEQ0) { if (tseq < 1) p1 = (f32x4){0.f, 0.f, 0.f, 0.f}; if (tseq < 2) p2 = (f32x4){0.f, 0.f, 0.f, 0.f}; }
        return bb + w0 * p2 + w1 * p1 + w2 * cur;
    }
    __device__ __forceinline__ void operator()(const f32x4 (&acc)[2][2][4][2], const Unit& u, int wr, int wc, int, int) const { run<false>(acc, u, wr, wc); }
    template <bool SEQ0> __device__ __forceinline__ void run(const f32x4 (&acc)[2][2][4][2], const Unit& u, int wr, int wc) const {
        int t_ = threadIdx.x; asm volatile("" : "+v"(t_));
        const int fr = t_ & 15, fq = (t_ >> 4) & 3, lane = t_ & 63;
        const int R0 = 256 * u.pm, ch0 = 128 * u.pn + 32 * wc + 8 * fq;
        if ((wr == 0 && fr < 2) || (wr == 1 && fr >= 14)) {
#pragma unroll
            for (int bj = 0; bj < 2; ++bj)
#pragma unroll
                for (int n = 0; n < 2; ++n) { const f32x4 hv = (wr == 0) ? acc[0][bj][0][n] : acc[1][bj][3][n];
                    *(f32x4*)(halo + ((size_t)u.pm * 4 + (wr == 0 ? fr : fr - 12)) * 5632 + 256 * u.pn + 128 * bj + 32 * wc + 8 * fq + 4 * n) = hv; }
        }
        const int xi = fq * 2 + (fr - 14);
        { const int idx = (t_ & 511) * 2, p = idx >> 8, bjw = (idx >> 7) & 1, cc = idx & 127; const float* src = (p < 3 ? cw + p * 5632 : cb) + bjw * 2816 + 128 * u.pn + cc;
          typedef float f32x2w __attribute__((ext_vector_type(2))); *(PG8_LAS f32x2w*)(wl + idx) = *(const f32x2w*)src; }
        if (fr >= 14) {
#pragma unroll
            for (int ai = 0; ai < 2; ++ai)
#pragma unroll
                for (int bj = 0; bj < 2; ++bj)
#pragma unroll
                    for (int n = 0; n < 2; ++n) xch[(((((ai * 2 + wr) * 4 + wc) * 2 + bj) * 2 + n) * 8) + xi] = acc[ai][bj][3][n];
        }
        asm volatile("s_waitcnt lgkmcnt(0)\n\ts_barrier" ::: "memory");
        const int s1 = (lane & 48) | ((fr - 1) & 15), s2 = (lane & 48) | ((fr - 2) & 15);
#pragma unroll
        for (int ai = 0; ai < 2; ++ai) {
            typedef unsigned u32x2 __attribute__((ext_vector_type(2))); u32x2 wq[2][4];
#pragma unroll
            for (int n = 0; n < 2; ++n) {
                asm volatile("" ::: "memory");
                const bool hasup = (fr >= 14) && ((ai * 2 + wr) >= 1);
                const int upi = (((((ai * 2 + wr - 1) * 4 + wc) * 2 + 0) * 2 + n) * 8) + xi;
                f32x4 cg[4];
                {   int cl = 32 * wc + 8 * fq + 4 * n; asm volatile("" : "+v"(cl));
                    const f32x4 w0 = *(const PG8_LAS f32x4*)(wl + cl), w1 = *(const PG8_LAS f32x4*)(wl + 256 + cl), w2 = *(const PG8_LAS f32x4*)(wl + 512 + cl), bb = *(const PG8_LAS f32x4*)(wl + 768 + cl);
                    f32x4 up = (f32x4){0.f, 0.f, 0.f, 0.f}; if (hasup) up = xch[upi];
#pragma unroll
                    for (int m = 0; m < 4; ++m) cg[m] = conv1<SEQ0>(acc[ai][0][m][n], (m == 0) ? up : acc[ai][0][m > 0 ? m - 1 : 0][n], w0, w1, w2, bb, fr, s1, s2, (R0 + 128 * ai + 64 * wr + 16 * m + fr) & 8191);
                }
                {   int cl = 128 + 32 * wc + 8 * fq + 4 * n; asm volatile("" : "+v"(cl));
                    const f32x4 w0 = *(const PG8_LAS f32x4*)(wl + cl), w1 = *(const PG8_LAS f32x4*)(wl + 256 + cl), w2 = *(const PG8_LAS f32x4*)(wl + 512 + cl), bb = *(const PG8_LAS f32x4*)(wl + 768 + cl);
                    f32x4 up = (f32x4){0.f, 0.f, 0.f, 0.f}; if (hasup) up = xch[upi + 16];
#pragma unroll
                    for (int m = 0; m < 4; ++m) {
                        const int rr = 128 * ai + 64 * wr + 16 * m + fr, grow = R0 + rr;
                        const f32x4 vl = conv1<SEQ0>(acc[ai][1][m][n], (m == 0) ? up : acc[ai][1][m > 0 ? m - 1 : 0][n], w0, w1, w2, bb, fr, s1, s2, grow & 8191);
                        const f32x4 gt = cg[m];
                        const f32x4 ex = gt * (-LOG2E); f32x4 dn = (f32x4){__builtin_amdgcn_exp2f(ex[0]), __builtin_amdgcn_exp2f(ex[1]), __builtin_amdgcn_exp2f(ex[2]), __builtin_amdgcn_exp2f(ex[3])} + 1.0f;
                        const f32x4 rc = (f32x4){__builtin_amdgcn_rcpf(dn[0]), __builtin_amdgcn_rcpf(dn[1]), __builtin_amdgcn_rcpf(dn[2]), __builtin_amdgcn_rcpf(dn[3])};
                        const f32x4 ov = (gt * vl) * rc;
                        wq[n][m].x = cvt_pk_bf16(ov[0], ov[1]); wq[n][m].y = cvt_pk_bf16(ov[2], ov[3]);
                    }
                }
            }
#pragma unroll
            for (int m = 0; m < 4; ++m) { const int rr = 128 * ai + 64 * wr + 16 * m + fr, grow = R0 + rr;
                if (rr >= 2) { u32x4 w; w.x = wq[0][m].x; w.y = wq[0][m].y; w.z = wq[1][m].x; w.w = wq[1][m].y; *(u32x4*)(act + (size_t)grow * 2816 + ch0) = w; } }
        }
    }
};
template <class Epi, class Sched, bool ALIGN_EPI = false, bool SP2 = false>
__device__ __forceinline__ void gemm_phase(PG8_LAS unsigned char* lds, const Gemm g, const Sched& S, const Epi& E) {
    int tid_ = threadIdx.x; asm volatile("" : "+v"(tid_));
    const int tid = tid_, wid = __builtin_amdgcn_readfirstlane(tid >> 6), lane = tid & 63, wr = wid >> 2, wc = wid & 3, fr = lane & 15, fq = lane >> 4;
    const int K = g.K, nt = K / BK;
    unsigned voffA[2], voffB[2];
#pragma unroll
    for (int i = 0; i < 2; ++i) { int R, C; stage_rc(tid * 16 + i * 8192, R, C); const int Rb = Epi::PERM ? ((R & ~31) + perm32(R & 31)) : R;
        voffA[i] = (unsigned)(R * K + C) * 2u; voffB[i] = (unsigned)(Rb * K + C) * 2u; }
    const size_t kstep = (size_t)(BK * 2);
    const size_t hstep = (size_t)HALF * K * 2;
    const size_t tstep = 2 * hstep;
    const unsigned ldsw = (unsigned)wid * 1024u;
    const int aoff = lds_byte(wr * 64 + fr, fq * 8), boff = lds_byte(wc * 32 + fr, fq * 8);
#define PG8_SA(b, h) (((b) * 2 + (h)) * HTB)
#define PG8_SB(b, h) ((4 + (b) * 2 + (h)) * HTB)
#define PG8_STAGE(bufoff, gbase, voff) do { _Pragma("unroll") for (int _i = 0; _i < 2; ++_i) \
        __builtin_amdgcn_global_load_lds((const unsigned*)((const char*)(gbase) + (voff)[_i]), (PG8_LAS unsigned*)(lds + (bufoff) + ldsw + _i * 8192), 16, 0, 0); } while (0)
#define PG8_LDA(dst, b, h) do { _Pragma("unroll") for (int m = 0; m < 4; ++m) _Pragma("unroll") for (int k = 0; k < 2; ++k) dst[m][k] = *(const PG8_LAS bf16x8*)(lds + PG8_SA(b, h) + aoff + m * 2048 + k * 1024); } while (0)
#define PG8_LDB(dst, b, h) do { _Pragma("unroll") for (int n = 0; n < 2; ++n) _Pragma("unroll") for (int k = 0; k < 2; ++k) dst[n][k] = *(const PG8_LAS bf16x8*)(lds + PG8_SB(b, h) + boff + n * 2048 + k * 1024); } while (0)
#define PG8_MMA(ai, bj, At, Bt) do { __builtin_amdgcn_s_setprio(1); _Pragma("unroll") for (int m = 0; m < 4; ++m) _Pragma("unroll") for (int n = 0; n < 2; ++n) _Pragma("unroll") for (int k = 0; k < 2; ++k) \
        acc[ai][bj][m][n] = __builtin_amdgcn_mfma_f32_16x16x32_bf16(Bt[n][k], At[m][k], acc[ai][bj][m][n], 0, 0, 0); __builtin_amdgcn_s_setprio(0); } while (0)
#define PG8_WAIT_V(n) asm volatile("s_waitcnt vmcnt(" #n ")" ::: "memory")
#define PG8_WAIT_L(n) asm volatile("s_waitcnt lgkmcnt(" #n ")" ::: "memory")
#define PG8_BAR __builtin_amdgcn_s_barrier()
#define PG8_SCHED __builtin_amdgcn_sched_barrier(0)
    Unit cur, nxt; int ui = 0;
    if (!S.next(0, cur)) return;
    f32x4 acc[2][2][4][2];
#pragma unroll
    for (int a = 0; a < 2; ++a)
#pragma unroll
        for (int b = 0; b < 2; ++b)
#pragma unroll
            for (int m = 0; m < 4; ++m)
#pragma unroll
                for (int n = 0; n < 2; ++n) acc[a][b][m][n] = (f32x4){0.f, 0.f, 0.f, 0.f};
    bf16x8 At[4][2], B0[2][2], B1[2][2];
    const char* cA = (const char*)g.A + (size_t)cur.pm * g.a_tstep; const char* cB = (const char*)g.Bt + (size_t)cur.pn * tstep;
    S.a_ready(cur);
    if constexpr (SP2) {
        PG8_STAGE(PG8_SB(0, 0), cB, voffB); PG8_STAGE(PG8_SB(0, 1), cB + hstep, voffB); PG8_STAGE(PG8_SA(0, 0), cA, voffA); PG8_STAGE(PG8_SA(0, 1), cA + hstep, voffA);
        if (wr == 1) PG8_BAR;
        PG8_WAIT_V(2); PG8_BAR;
        PG8_STAGE(PG8_SB(1, 0), cB + kstep, voffB); PG8_STAGE(PG8_SA(1, 0), cA + kstep, voffA); PG8_STAGE(PG8_SB(1, 1), cB + hstep + kstep, voffB);
        PG8_WAIT_V(6); PG8_BAR;
    } else {
        PG8_STAGE(PG8_SB(0, 0), cB, voffB); PG8_STAGE(PG8_SA(0, 0), cA, voffA); PG8_STAGE(PG8_SB(0, 1), cB + hstep, voffB); PG8_STAGE(PG8_SA(0, 1), cA + hstep, voffA);
        if (wr == 1) PG8_BAR;
        PG8_WAIT_V(4); PG8_BAR;
        PG8_STAGE(PG8_SB(1, 0), cB + kstep, voffB); PG8_STAGE(PG8_SA(1, 0), cA + kstep, voffA); PG8_STAGE(PG8_SB(1, 1), cB + hstep + kstep, voffB);
        PG8_WAIT_V(6); PG8_BAR;
    }
    for (;;) {
        const bool has_next = S.next(ui + 1, nxt);
        const char* nA = has_next ? (const char*)g.A + (size_t)nxt.pm * g.a_tstep : cA; const char* nB = has_next ? (const char*)g.Bt + (size_t)nxt.pn * tstep : cB;
        for (int t = 0; t < nt; t += 2) {
            const bool last = (t == nt - 2);
            const char* a1 = cA + (size_t)(t + 1) * kstep;
            const char* a2 = last ? nA : cA + (size_t)(t + 2) * kstep; const char* b2 = last ? nB : cB + (size_t)(t + 2) * kstep;
            const char* a3 = a2 + kstep; const char* b3 = b2 + kstep;
            if (last && has_next) S.a_ready(nxt);
            if constexpr (SP2) {
            PG8_LDB(B0, 0, 0); PG8_LDB(B1, 0, 1); PG8_SCHED; PG8_LDA(At, 0, 0); PG8_STAGE(PG8_SA(1, 1), a1 + hstep, voffA);
            PG8_WAIT_V(8); PG8_WAIT_L(0); PG8_BAR; PG8_MMA(0, 0, At, B0); PG8_MMA(0, 1, At, B1); PG8_BAR; PG8_SCHED;
            PG8_LDA(At, 0, 1); PG8_STAGE(PG8_SB(0, 0), b2, voffB); PG8_STAGE(PG8_SB(0, 1), b2 + hstep, voffB); PG8_STAGE(PG8_SA(0, 0), a2, voffA);
            PG8_WAIT_V(8); PG8_WAIT_L(0); PG8_BAR; PG8_MMA(1, 0, At, B0); PG8_MMA(1, 1, At, B1); PG8_BAR; PG8_SCHED;
            PG8_LDB(B0, 1, 0); PG8_LDB(B1, 1, 1); PG8_SCHED; PG8_LDA(At, 1, 0); PG8_STAGE(PG8_SA(0, 1), a2 + hstep, voffA);
            PG8_WAIT_V(8); PG8_WAIT_L(0); PG8_BAR; PG8_MMA(0, 0, At, B0); PG8_MMA(0, 1, At, B1); PG8_BAR; PG8_SCHED;
            PG8_LDA(At, 1, 1); PG8_STAGE(PG8_SB(1, 0), b3, voffB); PG8_STAGE(PG8_SB(1, 1), b3 + hstep, voffB); PG8_STAGE(PG8_SA(1, 0), a3, voffA);
            PG8_WAIT_V(8); PG8_WAIT_L(0); PG8_BAR; PG8_MMA(1, 0, At, B0); PG8_MMA(1, 1, At, B1); PG8_BAR; PG8_SCHED;
            } else {
            PG8_LDB(B0, 0, 0); PG8_SCHED; PG8_LDA(At, 0, 0); PG8_STAGE(PG8_SA(1, 1), a1 + hstep, voffA);
            PG8_WAIT_L(8); PG8_BAR; PG8_WAIT_L(0); PG8_MMA(0, 0, At, B0); PG8_BAR; PG8_SCHED;
            PG8_LDB(B1, 0, 1); PG8_STAGE(PG8_SB(0, 0), b2, voffB);
            PG8_BAR; PG8_WAIT_L(0); PG8_MMA(0, 1, At, B1); PG8_BAR;
            PG8_LDA(At, 0, 1); PG8_STAGE(PG8_SA(0, 0), a2, voffA);
            PG8_BAR; PG8_WAIT_L(0); PG8_MMA(1, 0, At, B0); PG8_BAR; PG8_SCHED;
            PG8_STAGE(PG8_SB(0, 1), b2 + hstep, voffB);
            PG8_WAIT_V(6); PG8_BAR; PG8_MMA(1, 1, At, B1); PG8_BAR;
            PG8_LDB(B0, 1, 0); PG8_SCHED; PG8_LDA(At, 1, 0); PG8_STAGE(PG8_SA(0, 1), a2 + hstep, voffA);
            PG8_WAIT_L(8); PG8_BAR; PG8_WAIT_L(0); PG8_MMA(0, 0, At, B0); PG8_BAR; PG8_SCHED;
            PG8_LDB(B1, 1, 1); PG8_STAGE(PG8_SB(1, 0), b3, voffB);
            PG8_BAR; PG8_WAIT_L(0); PG8_MMA(0, 1, At, B1); PG8_BAR;
            PG8_LDA(At, 1, 1); PG8_STAGE(PG8_SA(1, 0), a3, voffA);
            PG8_BAR; PG8_WAIT_L(0); PG8_MMA(1, 0, At, B0); PG8_BAR; PG8_SCHED;
            PG8_STAGE(PG8_SB(1, 1), b3 + hstep, voffB);
            PG8_WAIT_V(6); PG8_BAR; PG8_MMA(1, 1, At, B1); PG8_BAR;
            }
            if constexpr (Epi::HAS_MID) { if (t == nt / 2 - 2) E.mid(acc, cur, wr, wc, fr, fq); }
        }
        if constexpr (ALIGN_EPI) { if (wr == 0) PG8_BAR; }
        if constexpr (!Epi::AFTER_DRAIN) { E(acc, cur, wr, wc, fr, fq); S.done(cur); }
        if (!has_next) break;
#pragma unroll
        for (int a = 0; a < 2; ++a)
#pragma unroll
            for (int b = 0; b < 2; ++b)
#pragma unroll
                for (int m = 0; m < 4; ++m)
#pragma unroll
                    for (int n = 0; n < 2; ++n) acc[a][b][m][n] = (f32x4){0.f, 0.f, 0.f, 0.f};
        cur = nxt; cA = nA; cB = nB; ++ui;
        if constexpr (ALIGN_EPI) { if (wr == 1) PG8_BAR; }
    }
    PG8_WAIT_V(0);
    if constexpr (!ALIGN_EPI) { if (wr == 0) PG8_BAR; }
    PG8_BAR;
    if constexpr (Epi::AFTER_DRAIN) { E.fused(acc, cur, wr, wc, fr, fq, lds, wid, lane); S.done(cur); }
#undef PG8_SA
#undef PG8_SB
#undef PG8_STAGE
#undef PG8_LDA
#undef PG8_LDB
#undef PG8_MMA
#undef PG8_WAIT_V
#undef PG8_WAIT_L
#undef PG8_BAR
#undef PG8_SCHED
}
}
#include <hip/hip_bf16.h>
#include <cmath>
namespace attn_body {
using bf16=__hip_bfloat16;
using bf16x8=__attribute__((ext_vector_type(8)))short;
using s16x4=__attribute__((ext_vector_type(4)))short;
using f32x16=__attribute__((ext_vector_type(16)))float;
using u32x4=__attribute__((ext_vector_type(4)))unsigned;
constexpr int BATCH=8,NHEAD=8,SEQ=8192,D=64,DM=NHEAD*D;
constexpr int NW=8,QBLK=32,QB=QBLK*NW,KVBLK=64,NQB=SEQ/QB;
constexpr int ATTN_PITCH=DM, ATTN_UNIT_ROWS=QB, ODM=1024;
constexpr float ATTN_SKIP_LOG2=SKIP_LOG2;
__device__ __forceinline__ int crow(int r,int hi){return (r&3)+8*(r>>2)+4*hi;}
#define SBAR() __builtin_amdgcn_sched_barrier(0)
__device__ __forceinline__ void cmask(f32x16&p0,f32x16&p1,int jb,int qrel,int hi){
  const float NEG=-INFINITY; int kb=64*jb+4*hi;
  #pragma unroll
  for(int r=0;r<16;++r){int kv=kb+(r&3)+8*(r>>2); if(kv>qrel)p0[r]=NEG; if(kv+32>qrel)p1[r]=NEG;}
}

constexpr int NSLOT=3, SLOTB=8192;
constexpr int LDS_K=0, LDS_V=NSLOT*SLOTB, LDS_WS=2*NSLOT*SLOTB, LDS_OST=LDS_WS+NW*64*4, LDS_CK=LDS_OST+NW*4096, LDS_T0=LDS_CK+SEQ*4, LDS_BYTES=LDS_T0+64;
constexpr float C2=0.125f*1.4426950408889634f;
__device__ __forceinline__ void glds16(const void*gsrc,unsigned lds_dst){unsigned keep;
  asm volatile("s_mov_b32 %0, m0\n\ts_mov_b32 m0, %2\n\ts_nop 0\n\tglobal_load_lds_dwordx4 %1, off\n\ts_mov_b32 m0, %0":"=&s"(keep):"v"(gsrc),"s"(lds_dst):"memory");}
__device__ __forceinline__ float max3f(float a,float b,float c){float r;asm("v_max3_f32 %0, %1, %2, %3":"=v"(r):"v"(a),"v"(b),"v"(c));return r;}
__device__ __forceinline__ float max2f(float a,float b){float r;asm("v_max_f32_e32 %0, %1, %2":"=v"(r):"v"(a),"v"(b));return r;}
__device__ __forceinline__ float fadd_s(float a,float b){float r;asm("v_add_f32_e32 %0, %1, %2":"=v"(r):"v"(a),"v"(b));return r;}
__device__ __forceinline__ float fsub_s(float a,float b){float r;asm("v_sub_f32_e32 %0, %1, %2":"=v"(r):"v"(a),"v"(b));return r;}
typedef float f32x2_t __attribute__((ext_vector_type(2))); typedef __bf16 bf16x2_t __attribute__((ext_vector_type(2)));
__device__ __forceinline__ unsigned cvtpk_s(float lo,float hi){f32x2_t v={lo,hi};bf16x2_t b=__builtin_convertvector(v,bf16x2_t);return __builtin_bit_cast(unsigned,b);}
#define WAIT_BAR(N) asm volatile("s_waitcnt vmcnt(" #N ") lgkmcnt(0)\n\ts_barrier":::"memory")

__device__ __forceinline__ void qkt(f32x16&p0,f32x16&p1,const char*Kslot,const bf16x8*qr,int r32,int hi){
  const char*kb=Kslot+hi*1024+r32*16;
  #pragma unroll
  for(int d0=0;d0<4;++d0){
    const bf16x8 b0=*reinterpret_cast<const bf16x8*>(kb+d0*2048);
    const bf16x8 b1=*reinterpret_cast<const bf16x8*>(kb+d0*2048+512);
    {p0=__builtin_amdgcn_mfma_f32_32x32x16_bf16(b0,qr[d0],p0,0,0,0);p1=__builtin_amdgcn_mfma_f32_32x32x16_bf16(b1,qr[d0],p1,0,0,0);}}
}
typedef __attribute__((address_space(3))) const char* lds_cptr;
typedef short v4i16_t __attribute__((ext_vector_type(4)));
__device__ __forceinline__ void kload8(bf16x8*kf,lds_cptr kp){
  kf[0]=*(const __attribute__((address_space(3))) bf16x8*)(kp);      kf[1]=*(const __attribute__((address_space(3))) bf16x8*)(kp+512);
  kf[2]=*(const __attribute__((address_space(3))) bf16x8*)(kp+2048); kf[3]=*(const __attribute__((address_space(3))) bf16x8*)(kp+2560);
  kf[4]=*(const __attribute__((address_space(3))) bf16x8*)(kp+4096); kf[5]=*(const __attribute__((address_space(3))) bf16x8*)(kp+4608);
  kf[6]=*(const __attribute__((address_space(3))) bf16x8*)(kp+6144); kf[7]=*(const __attribute__((address_space(3))) bf16x8*)(kp+6656);
}
__device__ __forceinline__ void kload2(bf16x8*kf,lds_cptr kp,int j){ kf[2*j]=*(const __attribute__((address_space(3))) bf16x8*)(kp+j*2048); kf[2*j+1]=*(const __attribute__((address_space(3))) bf16x8*)(kp+j*2048+512); }
__device__ __forceinline__ s16x4 vtr(lds_cptr p){ return __builtin_bit_cast(s16x4,__builtin_amdgcn_ds_read_tr16_b64_v4i16((__attribute__((address_space(3))) v4i16_t*)p)); }
__device__ __forceinline__ float rowmax(const f32x16&p0,const f32x16&p1){
  float a=max3f(p0[0],p0[1],p1[0]),b=max3f(p0[2],p0[3],p1[1]);a=max3f(a,p1[2],p1[3]);
  #pragma unroll
  for(int r=4;r<16;r+=4){a=max3f(a,p0[r],p0[r+1]);b=max3f(b,p0[r+2],p0[r+3]);a=max3f(a,p1[r],p1[r+1]);b=max3f(b,p1[r+2],p1[r+3]);}
  const float m=max2f(a,b);
  auto rr=__builtin_amdgcn_permlane32_swap(__float_as_uint(m),__float_as_uint(m),false,false);
  return max2f(__uint_as_float(rr[0]),__uint_as_float(rr[1]));
}
__device__ __forceinline__ void pv(f32x16*o,int vb,bf16x8 pa0,bf16x8 pa1,bf16x8 pa2,bf16x8 pa3){
  #pragma unroll
  for(int d0=0;d0<2;++d0){s16x4 lo[4],hi[4];
    #pragma unroll
    for(int ks=0;ks<4;++ks){
      asm volatile("ds_read_b64_tr_b16 %0,%1 offset:%c2":"=&v"(lo[ks]):"v"(vb),"i"(d0*4096+ks*1024):"memory");
      asm volatile("ds_read_b64_tr_b16 %0,%1 offset:%c2":"=&v"(hi[ks]):"v"(vb),"i"(d0*4096+ks*1024+512):"memory");}
    asm volatile("s_waitcnt lgkmcnt(0)":::"memory");SBAR();
    #define PK(k) (bf16x8){lo[k][0],lo[k][1],lo[k][2],lo[k][3],hi[k][0],hi[k][1],hi[k][2],hi[k][3]}
    o[d0]=__builtin_amdgcn_mfma_f32_32x32x16_bf16(pa0,PK(0),o[d0],0,0,0);
    o[d0]=__builtin_amdgcn_mfma_f32_32x32x16_bf16(pa1,PK(1),o[d0],0,0,0);
    o[d0]=__builtin_amdgcn_mfma_f32_32x32x16_bf16(pa2,PK(2),o[d0],0,0,0);
    o[d0]=__builtin_amdgcn_mfma_f32_32x32x16_bf16(pa3,PK(3),o[d0],0,0,0);
    #undef PK
  }
}

typedef __attribute__((address_space(3))) const float* lds_fptr;
typedef float f32x4_t __attribute__((ext_vector_type(4)));
__device__ __forceinline__ void biasinit(f32x16&c0,f32x16&c1,lds_fptr ckt,float aq){
  #pragma unroll
  for(int g=0;g<4;++g){ const f32x4_t v=*(const __attribute__((address_space(3))) f32x4_t*)(ckt+8*g); const f32x4_t w=*(const __attribute__((address_space(3))) f32x4_t*)(ckt+32+8*g);
    c0[4*g]=aq-v[0];c0[4*g+1]=aq-v[1];c0[4*g+2]=aq-v[2];c0[4*g+3]=aq-v[3]; c1[4*g]=aq-w[0];c1[4*g+1]=aq-w[1];c1[4*g+2]=aq-w[2];c1[4*g+3]=aq-w[3]; }
}
#ifndef ATTN_STORE16
#define ATTN_STORE16(p,v) (*(u32x4*)(p)=(v))
#endif
template<int THRL> __device__ __forceinline__ void attn_unit(int b,int h,int qb,const bf16*Q,const bf16*__restrict__ K,const bf16*__restrict__ V,bf16*O,char*shm,const float*__restrict__ CKg,const float Tskip){
  int tid_=threadIdx.x; asm volatile("":"+v"(tid_)); const int tid=tid_,lane=tid&63,r32=lane&31,hi=lane>>5; const int wid=__builtin_amdgcn_readfirstlane(tid>>6);
  const long rowbase=(long)b*SEQ; const int q0=qb*QB; const lds_cptr shm3=(lds_cptr)shm;
  const float*ckh=CKg+(long)(b*NHEAD+h)*SEQ; int t0;
  { __attribute__((address_space(3))) int*cw=(__attribute__((address_space(3))) int*)((__attribute__((address_space(3))) char*)shm3+LDS_T0);
    const int ntf=(q0+QB)/KVBLK; bool ok=false; if(tid>=1&&tid<=ntf-4) ok=(ckh[64*tid-1]-ckh[q0])>=Tskip;
    const unsigned long long bm=__ballot(ok); if(lane==0)cw[wid]=__popcll(bm);
    asm volatile("s_waitcnt vmcnt(0) lgkmcnt(0)\n\ts_barrier":::"memory");
    t0=__builtin_amdgcn_readfirstlane((cw[0]+cw[1])&~1); }
  const bf16*Qw=Q+(rowbase+q0+wid*QBLK)*DM+h*D;
  const bf16*Kh=K+(rowbase+64*t0)*DM+h*D,*Vh=V+(rowbase+64*t0)*DM+h*D;
  const unsigned lds0=(unsigned)(uintptr_t)shm;
  float*wsf=(float*)(shm+LDS_WS)+wid*64;
  const bf16*ksrc=Kh+(long)lane*DM+wid*8;
  const bf16*vsrc=Vh+(long)(16*(wid&3)+(lane>>2))*DM+(wid>>2)*32+(lane&3)*8;
  const unsigned kdst=lds0+LDS_K+wid*1024, vdst=lds0+LDS_V+wid*1024;
  #define DMA_K(t,slot) glds16(ksrc+(long)(t)*KVBLK*DM,(unsigned)__builtin_amdgcn_readfirstlane(kdst+(slot)))
  #define DMA_V(t,slot) glds16(vsrc+(long)(t)*KVBLK*DM,(unsigned)__builtin_amdgcn_readfirstlane(vdst+(slot)))
  const int vb0=(int)(lds0+LDS_V)+((lane>>4)&1)*32+(lane&3)*8+(4*hi+((lane&15)>>2))*64;
  const char*Kbase=shm+LDS_K; bf16x8 kf[8];
  const lds_cptr kp0=shm3+LDS_K+hi*1024+r32*16; const lds_cptr vp0=shm3+LDS_V+((lane>>4)&1)*32+(lane&3)*8+(4*hi+((lane&15)>>2))*64;
  const int NT=(q0+QB)/KVBLK-t0;
  { __attribute__((address_space(3))) f32x4_t*ckd=(__attribute__((address_space(3))) f32x4_t*)((__attribute__((address_space(3))) char*)shm3+LDS_CK);
    for(int i=tid;i<(q0+QB-64*t0)/4;i+=NW*64) ckd[i]=*(const f32x4_t*)(ckh+64*t0+4*i);
    asm volatile("s_waitcnt vmcnt(0) lgkmcnt(0)\n\ts_barrier":::"memory"); }
  const lds_fptr ckl=(lds_fptr)(shm3+LDS_CK);
  const float cq=ckl[q0-64*t0+wid*QBLK+r32]; float aq=cq;
  DMA_K(0,0);DMA_V(0,0);DMA_K(1,SLOTB);
  bf16x8 qr[4];
  #pragma unroll
  for(int d0=0;d0<4;++d0)qr[d0]=*reinterpret_cast<const bf16x8*>(&Qw[(long)r32*DM+d0*16+hi*8]);
  float mhat=0.f,l_reg=0.f;f32x16 o[2];o[0]=f32x16{};o[1]=f32x16{};
  const int qrel=wid*QBLK+r32;
  #define CMASK(P0,P1,t) do{int jb_=(t)-(NT-4); if(jb_>=0)cmask(P0,P1,jb_,qrel,hi);}while(0)
  bool resc=false;
  #define START(P0,P1) do{ const float rm=rowmax(P0,P1); resc=false; \
    { const float dl=rm; mhat=fadd_s(mhat,dl); \
      _Pragma("unroll") for(int r=0;r<16;++r){P0[r]=fsub_s(P0[r],dl);P1[r]=fsub_s(P1[r],dl);} \
      aq=cq-mhat; } \
    _Pragma("unroll") for(int r=0;r<16;++r)P0[r]=__builtin_amdgcn_exp2f(P0[r]); }while(0)
  #define RESC() do{ if(resc){ asm volatile("s_waitcnt lgkmcnt(0)":::"memory"); \
      _Pragma("unroll") for(int d_=0;d_<2;++d_) _Pragma("unroll") for(int r=0;r<16;++r)o[d_][r]*=wsf[crow(r,hi)]; } }while(0)
  f32x16 pA0,pA1,pB0,pB1;
  int sl_prev=0,sl_cur=0,sl_next=SLOTB;
  #define ROT() do{sl_prev=sl_cur;sl_cur=sl_next;sl_next=(sl_next==(NSLOT-1)*SLOTB)?0:sl_next+SLOTB;}while(0)
  DMA_K(2,2*SLOTB);
  WAIT_BAR(3);
  biasinit(pA0,pA1,ckl+4*hi,aq); qkt(pA0,pA1,Kbase,qr,r32,hi);asm volatile("s_nop 15\n\ts_nop 7":"+v"(pA0),"+v"(pA1));CMASK(pA0,pA1,0);
  START(pA0,pA1);
  _Pragma("unroll") for(int r=0;r<16;++r)pA1[r]=__builtin_amdgcn_exp2f(pA1[r]);
  WAIT_BAR(0);
  DMA_K(3,0);DMA_V(1,SLOTB);
  ROT();
  kload8(kf,kp0+sl_cur);
  WAIT_BAR(2);
  s16x4 vlo[8],vhi[8]; u32x4 pw0,pw1,pw2,pw3;
  #define PKW(P,B) cvtpk_s(P[B],P[B+1])
  #define PAF(k) __builtin_bit_cast(bf16x8,pw##k)
  #define VFR(i) (bf16x8){vlo[i][0],vlo[i][1],vlo[i][2],vlo[i][3],vhi[i][0],vhi[i][1],vhi[i][2],vhi[i][3]}
  #define PIN(x) asm volatile("":"+v"(x))
  #define MX3(a,b,c) __builtin_fmaxf(__builtin_fmaxf((a),(b)),(c))
  #define GAPA(MF,A0,A1,A2,A3,W0,W1,PW) do{ MF; sacc+=A0; sacc+=A1; sacc+=A2; sacc+=A3; PIN(sacc); W0; W1; PIN(PW); SBAR(); }while(0)
  #define EX(v) __builtin_amdgcn_exp2f(v)
  #define GAPB(MF,X,B) do{ MF; X[B]=EX(X[B]); X[B+1]=EX(X[B+1]); X[B+2]=EX(X[B+2]); X[B+3]=EX(X[B+3]); PIN(X); SBAR(); }while(0)
  #define VRD(i) do{ vlo[i]=vtr(vp_+(((i)>>2)*4096+((i)&3)*1024)); vhi[i]=vtr(vp_+(((i)>>2)*4096+((i)&3)*1024+512)); }while(0)
  #define KRD(G,j) do{ if(G){ kload2(kf,kp0+sl_next,j); SBAR(); } }while(0)
  #define STEP(C0,C1,P0,P1,t,GK,GV,GL) do{ SBAR(); biasinit(C0,C1,ckl+64*(t)+4*hi,aq); SBAR(); \
    const lds_cptr vp_=vp0+sl_prev; \
    VRD(0); SBAR(); float sacc=(P0[0]+P0[1]); \
    GAPA(C0=__builtin_amdgcn_mfma_f32_32x32x16_bf16(kf[0],qr[0],C0,0,0,0), P0[2],P0[3],P0[4],P0[5],     pw0[0]=PKW(P0,0), pw0[1]=PKW(P0,2), pw0); \
    VRD(4); SBAR(); GAPA(C1=__builtin_amdgcn_mfma_f32_32x32x16_bf16(kf[1],qr[0],C1,0,0,0), P0[6],P0[7],P0[8],P0[9],     pw0[2]=PKW(P0,4), pw0[3]=PKW(P0,6), pw0); \
    VRD(1); SBAR(); GAPA(C0=__builtin_amdgcn_mfma_f32_32x32x16_bf16(kf[2],qr[1],C0,0,0,0),   P0[10],P0[11],P0[12],P0[13], pw1[0]=PKW(P0,8), pw1[1]=PKW(P0,10), pw1); \
    VRD(5); SBAR(); GAPA(C1=__builtin_amdgcn_mfma_f32_32x32x16_bf16(kf[3],qr[1],C1,0,0,0),   P0[14],P0[15],P1[0],P1[1],   pw1[2]=PKW(P0,12),pw1[3]=PKW(P0,14), pw1); \
    VRD(2); SBAR(); GAPA(C0=__builtin_amdgcn_mfma_f32_32x32x16_bf16(kf[4],qr[2],C0,0,0,0),   P1[2],P1[3],P1[4],P1[5],     pw2[0]=PKW(P1,0), pw2[1]=PKW(P1,2), pw2); \
    VRD(6); SBAR(); GAPA(C1=__builtin_amdgcn_mfma_f32_32x32x16_bf16(kf[5],qr[2],C1,0,0,0),   P1[6],P1[7],P1[8],P1[9],     pw2[2]=PKW(P1,4), pw2[3]=PKW(P1,6), pw2); \
    VRD(3); SBAR(); GAPA(C0=__builtin_amdgcn_mfma_f32_32x32x16_bf16(kf[6],qr[3],C0,0,0,0),   P1[10],P1[11],P1[12],P1[13], pw3[0]=PKW(P1,8), pw3[1]=PKW(P1,10), pw3); \
    VRD(7); SBAR(); GAPA(C1=__builtin_amdgcn_mfma_f32_32x32x16_bf16(kf[7],qr[3],C1,0,0,0),   P1[14],P1[15],0.f,0.f,       pw3[2]=PKW(P1,12),pw3[3]=PKW(P1,14), pw3); \
    l_reg+=sacc; \
    if(GK){DMA_K((t)+3,sl_cur);} if(GV){DMA_V((t)+1,sl_next);} \
    CMASK(C0,C1,t); \
    { float a=MX3(C0[0],C0[1],C1[0]),b=MX3(C0[2],C0[3],C1[1]); a=MX3(a,C1[2],C1[3]); \
      _Pragma("unroll") for(int r=4;r<16;r+=4){a=MX3(a,C0[r],C0[r+1]);b=MX3(b,C0[r+2],C0[r+3]);a=MX3(a,C1[r],C1[r+1]);b=MX3(b,C1[r+2],C1[r+3]);} \
      float rm=__builtin_fmaxf(a,b); { auto rr=__builtin_amdgcn_permlane32_swap(__float_as_uint(rm),__float_as_uint(rm),false,false); rm=__builtin_fmaxf(__uint_as_float(rr[0]),__uint_as_float(rr[1])); } \
      resc=false; \
      if(__builtin_expect(__any(rm>(float)THRL),0)){ const float dl=__builtin_fmaxf(rm,0.f); mhat+=dl; \
        _Pragma("unroll") for(int r=0;r<16;++r){C0[r]-=dl;C1[r]-=dl;} \
        aq=cq-mhat; \
        const float f=__builtin_amdgcn_exp2f(-dl); l_reg*=f; if(hi==0)wsf[r32]=f; resc=true; } } \
    SBAR(); \
    GAPB(o[0]=__builtin_amdgcn_mfma_f32_32x32x16_bf16(PAF(0),VFR(0),o[0],0,0,0), C0,0); \
    GAPB(o[1]=__builtin_amdgcn_mfma_f32_32x32x16_bf16(PAF(0),VFR(4),o[1],0,0,0), C0,4); \
    KRD(GL,0); GAPB(o[0]=__builtin_amdgcn_mfma_f32_32x32x16_bf16(PAF(1),VFR(1),o[0],0,0,0), C0,8); \
    KRD(GL,1); GAPB(o[1]=__builtin_amdgcn_mfma_f32_32x32x16_bf16(PAF(1),VFR(5),o[1],0,0,0), C0,12); \
    KRD(GL,2); GAPB(o[0]=__builtin_amdgcn_mfma_f32_32x32x16_bf16(PAF(2),VFR(2),o[0],0,0,0), C1,0); \
    KRD(GL,3); GAPB(o[1]=__builtin_amdgcn_mfma_f32_32x32x16_bf16(PAF(2),VFR(6),o[1],0,0,0), C1,4); \
    GAPB(o[0]=__builtin_amdgcn_mfma_f32_32x32x16_bf16(PAF(3),VFR(3),o[0],0,0,0), C1,8); \
    GAPB(o[1]=__builtin_amdgcn_mfma_f32_32x32x16_bf16(PAF(3),VFR(7),o[1],0,0,0), C1,12); \
    }while(0)
  int t=1;
  #undef CMASK
  #define CMASK(P0,P1,t) do{}while(0)
  for(;t+5<NT;t+=2){
    STEP(pB0,pB1,pA0,pA1,t,true,true,true);     WAIT_BAR(2); RESC(); ROT();
    STEP(pA0,pA1,pB0,pB1,t+1,true,true,true);   WAIT_BAR(2); RESC(); ROT();
  }
  #undef CMASK
  #define CMASK(P0,P1,t) do{int jb_=(t)-(NT-4); if(jb_>=0)cmask(P0,P1,jb_,qrel,hi);}while(0)
  #define ENDW(tt) do{ if((tt)+3<NT){WAIT_BAR(2);} else if((tt)+2<NT){WAIT_BAR(1);} else {WAIT_BAR(0);} }while(0)
  for(;t+1<NT;t+=2){
    STEP(pB0,pB1,pA0,pA1,t,(t+3<NT),(t+1<NT),(t+1<NT));       ENDW(t);   RESC(); ROT();
    STEP(pA0,pA1,pB0,pB1,t+1,(t+4<NT),(t+2<NT),(t+2<NT));     ENDW(t+1); RESC(); ROT();
  }
  STEP(pB0,pB1,pA0,pA1,NT-1,false,false,false); RESC();
  { float sacc=pB0[0]+pB0[1]; _Pragma("unroll") for(int r=2;r<16;++r)sacc+=pB0[r]; _Pragma("unroll") for(int r=0;r<16;++r)sacc+=pB1[r]; l_reg+=sacc;
    pw0=(u32x4){PKW(pB0,0),PKW(pB0,2),PKW(pB0,4),PKW(pB0,6)};pw1=(u32x4){PKW(pB0,8),PKW(pB0,10),PKW(pB0,12),PKW(pB0,14)};pw2=(u32x4){PKW(pB1,0),PKW(pB1,2),PKW(pB1,4),PKW(pB1,6)};pw3=(u32x4){PKW(pB1,8),PKW(pB1,10),PKW(pB1,12),PKW(pB1,14)};
    SBAR(); pv(o,vb0+sl_cur,PAF(0),PAF(1),PAF(2),PAF(3)); }
  #undef PKW
  #undef PAF
  #undef VFR
  #undef PIN
  #undef MX3
  #undef GAPA
  #undef GAPB
  #undef EX
  #undef VRD
  #undef KRD
  #undef STEP
  #undef ENDW
  {auto rr=__builtin_amdgcn_permlane32_swap(__float_as_uint(l_reg),__float_as_uint(l_reg),false,false);l_reg=__uint_as_float(rr[0])+__uint_as_float(rr[1]);}
  if(hi==0)wsf[32+r32]=l_reg;asm volatile("s_waitcnt lgkmcnt(0)":::"memory");
  float rli[16];
  #pragma unroll
  for(int r=0;r<16;++r)rli[r]=__builtin_amdgcn_rcpf(wsf[32+crow(r,hi)]);
  bf16*Ow=O+(rowbase+q0+wid*QBLK)*ODM+h*D;
  { bf16*stg=(bf16*)(shm+LDS_OST)+wid*2048;
    #pragma unroll
    for(int r=0;r<16;++r){const int orow=crow(r,hi);
      #pragma unroll
      for(int d0=0;d0<2;++d0)stg[orow*64+d0*32+r32]=__float2bfloat16(o[d0][r]*rli[r]);}
    asm volatile("s_waitcnt lgkmcnt(0)":::"memory");
    #pragma unroll
    for(int i=0;i<4;++i){const int row=i*8+(lane>>3),ch=lane&7; const u32x4 v=*(const u32x4*)(stg+row*64+ch*8); ATTN_STORE16(Ow+(long)row*ODM+ch*8,v);} }
  asm volatile("s_waitcnt lgkmcnt(0)\n\ts_barrier":::"memory");
  #undef DMA_K
  #undef DMA_V
  #undef CMASK
  #undef START
  #undef RESC
  #undef ROT
}
constexpr int ATTN_LDS_BYTES=LDS_BYTES;
struct AttnTensors { const bf16* Q; const bf16* K; const bf16* V; bf16* O; const float* CK; const float* NRM; };
struct AttnUnit { int bh; int qb; };
struct StaticOrder {
  int vcu;
  __device__ __forceinline__ explicit StaticOrder(int grid,int block):vcu((block%8)*(grid/8)+block/8){}
  __device__ __forceinline__ bool next(int i,AttnUnit&u)const{ if(i>=8)return false; const int s=vcu&7,j=i&3; u.bh=(vcu>>3)+32*(i>>2); u.qb=(j==0)?s:(j==1)?15-s:(j==2)?16+s:31-s; return true; }
  __device__ __forceinline__ void a_ready(const AttnUnit&)const{}
  __device__ __forceinline__ void done(const AttnUnit&)const{}
};
struct DynOrder {
  unsigned*ctr; volatile __attribute__((address_space(3))) unsigned*slot; int x;
  __device__ __forceinline__ bool next(int,AttnUnit&u)const{
    if(threadIdx.x==0)*slot=atomicAdd(ctr+64*x,1u);
    __syncthreads(); const unsigned n=*slot; __syncthreads();
    if(n>=256u)return false; const int hs=7-(int)(n>>5), j=(x-hs)&7; u.bh=j*8+hs; u.qb=31-(int)(n&31u); return true; }
  __device__ __forceinline__ void a_ready(const AttnUnit&)const{}
  __device__ __forceinline__ void done(const AttnUnit&)const{}
};
template<class Sched,int THRL=32> __device__ __forceinline__ void attn_phase(char*lds,const AttnTensors&T,const Sched&S){
  AttnUnit u;
  for(int i=0;S.next(i,u);++i){ S.a_ready(u); { const float*nr=T.NRM+u.bh*4; const float tsk=ATTN_SKIP_LOG2+2.f+2.002f*sqrtf((nr[0]+nr[1])*(nr[2]+nr[3])); attn_unit<THRL>(u.bh/NHEAD,u.bh%NHEAD,u.qb,T.Q,T.K,T.V,T.O,lds,T.CK,tsk); } S.done(u); }
}
#undef SBAR
#undef WAIT_BAR
}
namespace cg = cooperative_groups;
#define LAS __attribute__((address_space(3)))
typedef unsigned v4u __attribute__((ext_vector_type(4)));
typedef unsigned v2u __attribute__((ext_vector_type(2)));
typedef float f32x4 __attribute__((ext_vector_type(4)));
using pg8::bf16_t;
#ifndef WGM_WIDE
#define WGM_WIDE 4
#endif
#ifndef WGM_NARROW
#define WGM_NARROW 2
#endif
constexpr int NWAVES = 8, SEQ = 8192, DM = 1024, NB = 8, DFF = 2816, NIN = 5128;
constexpr float LN_EPS = 1e-5f, LOG2E_F = 1.4426950408889634f;
constexpr size_t MiB = 1u << 20;
constexpr size_t WS_MOD = 0, WS_WFT = 512 * 1024, WS_NRM = 768 * 1024, WS_CTR = 772 * 1024, WS_BAR = 800 * 1024, WS_LF = 1 * MiB, WS_CK = 3 * MiB;
constexpr size_t WS_WIN = 6 * MiB, WS_WFS = 16 * MiB, WS_WO = 18 * MiB, WS_WUP = 20 * MiB, WS_WDN = 31 * MiB;
constexpr size_t WS_U = 40 * MiB;
constexpr size_t WS_QKV = 168 * MiB;
constexpr size_t WS_MERGED = WS_QKV + 128 * MiB;
constexpr size_t WS_ACT = WS_QKV;
constexpr size_t WS_G = 552 * MiB;
constexpr size_t WS_H1 = WS_G;
constexpr size_t WS_HALO = 808 * MiB;
constexpr size_t WS_END = 832 * MiB;
constexpr int RING_BYTES = 131072, XCH_OFF = RING_BYTES, MISC_OFF = XCH_OFF + 8192, LDS_BYTES = 147456;

#define LDS_WAIT() asm volatile("s_waitcnt lgkmcnt(0)" ::: "memory")
#define XB_TMO      128
#define XB_XCNT(j)  (256  + 64 * (j))
#define XB_XSUB(j)  (1280 + 64 * (j))
#define XB_XGEN(j)  (2304 + 64 * (j))
#define XB_TOP      3328
#define XB_TOPGEN   3392
#define XCD_BAR_WORDS 3456
#define XB_SPIN_CAP (1u << 18)

__device__ __forceinline__ unsigned xb_ld(unsigned* p)              { return __hip_atomic_load(p, __ATOMIC_RELAXED, __HIP_MEMORY_SCOPE_AGENT); }
__device__ __forceinline__ unsigned xb_add(unsigned* p, unsigned v) { return __hip_atomic_fetch_add(p, v, __ATOMIC_RELAXED, __HIP_MEMORY_SCOPE_AGENT); }
__device__ __forceinline__ unsigned xb_xcc_id() { return (unsigned)__builtin_amdgcn_s_getreg((3 << 11) | 20) & 0xFu; }
#define XB_SPIN(cond, bar) do { unsigned _sp = 0; while (cond) { __builtin_amdgcn_s_sleep(1); \
    if ((++_sp & 255u) == 0u) { if (xb_ld(&(bar)[XB_TMO])) break; if (_sp > XB_SPIN_CAP) { atomicAdd(&(bar)[XB_TMO], 1u); break; } } } } while (0)

struct XcdBarrier {
    unsigned* bar; unsigned x;
    volatile LAS unsigned* st;
};

__device__ __forceinline__ XcdBarrier xcd_barrier_post(unsigned* bar, volatile LAS unsigned* st) {
    XcdBarrier b; b.bar = bar; b.x = xb_xcc_id(); b.st = st;
    if (threadIdx.x == 0) (void)xb_add(&bar[XB_XCNT(b.x)], 1u);
    return b;
}
__device__ __forceinline__ void xcd_barrier_complete(unsigned* bar, unsigned x, unsigned& nloc, unsigned& nx) {
    const unsigned G = gridDim.x * gridDim.y * gridDim.z;
    unsigned sum, cnt, mine, sp = 0u;
    for (;;) {
        sum = 0u; cnt = 0u; mine = 0u;
#pragma unroll
        for (unsigned j = 0; j < 16; ++j) { const unsigned c = xb_ld(&bar[XB_XCNT(j)]); sum += c; cnt += (c > 0u) ? 1u : 0u; mine = (j == x) ? c : mine; }
        if (sum == G) break;
        __builtin_amdgcn_s_sleep(1);
        if ((++sp & 255u) == 0u) { if (xb_ld(&bar[XB_TMO])) break; if (sp > XB_SPIN_CAP) { atomicAdd(&bar[XB_TMO], 1u); break; } }
    }
    nloc = mine > 0u ? mine : 1u; nx = cnt > 0u ? cnt : 1u;
}

__device__ __forceinline__ void xcd_barrier(const XcdBarrier& b) {
    asm volatile("s_waitcnt vmcnt(0)" ::: "memory");
    __syncthreads();
    if (threadIdx.x == 0) {
        unsigned* bar = b.bar;
        __builtin_amdgcn_s_waitcnt(0);
        unsigned nloc = b.st[0], nx = b.st[1];
        if (nloc == 0u) { xcd_barrier_complete(bar, b.x, nloc, nx); b.st[0] = nloc; b.st[1] = nx; }
        const unsigned old = xb_add(&bar[XB_XSUB(b.x)], 1u);
        const unsigned gen = old / nloc;
        if (old + 1u == (gen + 1u) * nloc) {
            __builtin_amdgcn_fence(__ATOMIC_RELEASE, "agent");
            asm volatile("s_waitcnt vmcnt(0)" ::: "memory");
            const unsigned og = xb_add(&bar[XB_TOP], 1u);
            const unsigned tg = og / nx;
            if (og + 1u == (tg + 1u) * nx) xb_add(&bar[XB_TOPGEN], 1u);
            else XB_SPIN(xb_ld(&bar[XB_TOPGEN]) == tg, bar);
            __builtin_amdgcn_fence(__ATOMIC_ACQUIRE, "agent");
            xb_add(&bar[XB_XGEN(b.x)], 1u);
            asm volatile("s_waitcnt vmcnt(0)" ::: "memory");
        } else {
            XB_SPIN(xb_ld(&bar[XB_XGEN(b.x)]) == gen, bar);
            __builtin_amdgcn_fence(__ATOMIC_ACQUIRE, "agent");
            asm volatile("s_waitcnt vmcnt(0)" ::: "memory");
        }
    }
    __syncthreads();
}
__device__ __forceinline__ unsigned f2bf(float f) { unsigned u = __builtin_bit_cast(unsigned, f); return (u + 0x7fffu + ((u >> 16) & 1u)) >> 16; }
__device__ __forceinline__ unsigned pk2(float lo, float hi) { return f2bf(lo) | (f2bf(hi) << 16); }
__device__ __forceinline__ float wave_sum(float v) {
#pragma unroll
    for (int o = 1; o < 64; o <<= 1) v += __shfl_xor(v, o);
    return v;
}
__device__ __forceinline__ void wave_sum4(float (&s)[4]) {
#pragma unroll
    for (int o = 1; o < 64; o <<= 1) {
#pragma unroll
        for (int i = 0; i < 4; ++i) s[i] += __shfl_xor(s[i], o); }
}
__device__ __forceinline__ void tr_item(const float* W, int ldw, int srcc0, int k0, bf16_t* WT, int ldk, int dstr0, LAS float* scr, int lane, int dk0 = 0) {
#pragma unroll 8
    for (int i = 0; i < 32; ++i) { const int kk = 2 * i + (lane >> 5); scr[kk * 33 + (lane & 31)] = W[(size_t)(k0 + kk) * ldw + srcc0 + (lane & 31)]; }
    LDS_WAIT();
    const int c = lane & 7;
#pragma unroll
    for (int j = 0; j < 4; ++j) { const int n = (lane >> 3) + 8 * j; const LAS float* s = scr + (8 * c) * 33 + n;
        v4u o; o.x = pk2(s[0 * 33], s[1 * 33]); o.y = pk2(s[2 * 33], s[3 * 33]); o.z = pk2(s[4 * 33], s[5 * 33]); o.w = pk2(s[6 * 33], s[7 * 33]);
        *(v4u*)(WT + (size_t)(dstr0 + n) * ldk + dk0 + k0 + 8 * c) = o; }
    LDS_WAIT();
}

constexpr float SB_STICK_MIN = 3.3881318e-21f;
typedef short s16x8 __attribute__((ext_vector_type(8)));
typedef float f32x16 __attribute__((ext_vector_type(16)));
__device__ __forceinline__ int crow16(int r, int hi) { return (r & 3) + 8 * (r >> 2) + 4 * hi; }
template <bool DIAG> __device__ __forceinline__ float sb_weights(const f32x16& s, int k0, int q, int hi, float C, float (&av)[16]) {
    float uv[16], bt[16], sfx[16], own[4], oth[4], sufg[4];
#pragma unroll
    for (int r = 0; r < 16; ++r) { const float zz = __builtin_fminf(s[r], 100.f), ex = __builtin_amdgcn_exp2f(zz), ui = __builtin_amdgcn_rcpf(1.0f + ex);
        if (DIAG) { const bool valid = (k0 + crow16(r, hi)) < q; uv[r] = valid ? ui : 1.0f; bt[r] = valid ? ex * ui : 0.f; } else { uv[r] = ui; bt[r] = ex * ui; } }
#pragma unroll
    for (int i = 0; i < 4; ++i) { const float a3 = uv[4 * i + 3], a2 = a3 * uv[4 * i + 2], a1 = a2 * uv[4 * i + 1]; own[i] = a1 * uv[4 * i];
        sfx[4 * i + 3] = bt[4 * i + 3]; sfx[4 * i + 2] = bt[4 * i + 2] * a3; sfx[4 * i + 1] = bt[4 * i + 1] * a2; sfx[4 * i] = bt[4 * i] * a1; }
#pragma unroll
    for (int i = 0; i < 4; ++i) oth[i] = __shfl_xor(own[i], 32);
    float accs = C;
#pragma unroll
    for (int i = 3; i >= 0; --i) { sufg[i] = (hi == 0) ? accs * oth[i] : accs; accs *= own[i] * oth[i]; }
#pragma unroll
    for (int r = 0; r < 16; ++r) av[r] = sfx[r] * sufg[r >> 2];
    return accs;
}
__device__ __forceinline__ void sb_unit(int b, int h, int qblk, const bf16_t* Q, const bf16_t* __restrict__ K, const bf16_t* __restrict__ V, bf16_t* O, LAS unsigned char* vst, int lane_) {
    int lane = lane_; asm volatile("" : "+v"(lane));
    const int r32 = lane & 31, hi = lane >> 5; const size_t rowbase = (size_t)b * SEQ; const int qw0 = qblk * 32, q = qw0 + r32;
    const bf16_t* Qw = Q + (rowbase + qw0) * 512 + h * 64;
    s16x8 qr[4];
#pragma unroll
    for (int d0 = 0; d0 < 4; ++d0) qr[d0] = *(const s16x8*)(Qw + (size_t)r32 * 512 + d0 * 16 + hi * 8);
    f32x16 o0 = {}, o1 = {}; float C = 1.f;
    s16x8 kn[4]; v4u vn[4];
    { const bf16_t* Kp = K + (rowbase + qblk * 32 + r32) * 512 + h * 64 + hi * 8;
#pragma unroll
      for (int d0 = 0; d0 < 4; ++d0) kn[d0] = *(const s16x8*)(Kp + d0 * 16);
#pragma unroll
      for (int i = 0; i < 4; ++i) { const int c = lane + 64 * i; vn[i] = *(const v4u*)(V + (rowbase + qblk * 32 + (c >> 3)) * 512 + h * 64 + (c & 7) * 8); } }
    for (int jt = qblk; jt >= 0; --jt) {
        const int k0 = jt * 32;
        s16x8 kf[4];
#pragma unroll
        for (int d0 = 0; d0 < 4; ++d0) kf[d0] = kn[d0];
#pragma unroll
        for (int i = 0; i < 4; ++i) { const int c = lane + 64 * i, key = c >> 3, part = c & 7; *(LAS v4u*)(vst + key * 144 + part * 16) = vn[i]; }
        if (jt > 0) { const bf16_t* Kp = K + (rowbase + k0 - 32 + r32) * 512 + h * 64 + hi * 8;
#pragma unroll
            for (int d0 = 0; d0 < 4; ++d0) kn[d0] = *(const s16x8*)(Kp + d0 * 16);
#pragma unroll
            for (int i = 0; i < 4; ++i) { const int c = lane + 64 * i; vn[i] = *(const v4u*)(V + (rowbase + k0 - 32 + (c >> 3)) * 512 + h * 64 + (c & 7) * 8); } }
        f32x16 s = {};
#pragma unroll
        for (int d0 = 0; d0 < 4; ++d0) s = __builtin_amdgcn_mfma_f32_32x32x16_bf16(kf[d0], qr[d0], s, 0, 0, 0);
        float av[16];
        if (jt == qblk) C = sb_weights<true>(s, k0, q, hi, C, av); else C = sb_weights<false>(s, k0, q, hi, C, av);
        v4u pa0, pa1;
        pa0.x = pg8::cvt_pk_bf16(av[0], av[1]); pa0.y = pg8::cvt_pk_bf16(av[2], av[3]); pa0.z = pg8::cvt_pk_bf16(av[4], av[5]); pa0.w = pg8::cvt_pk_bf16(av[6], av[7]);
        pa1.x = pg8::cvt_pk_bf16(av[8], av[9]); pa1.y = pg8::cvt_pk_bf16(av[10], av[11]); pa1.z = pg8::cvt_pk_bf16(av[12], av[13]); pa1.w = pg8::cvt_pk_bf16(av[14], av[15]);
        LDS_WAIT();
#pragma unroll
        for (int ks = 0; ks < 2; ++ks)
#pragma unroll
            for (int d0 = 0; d0 < 2; ++d0) { unsigned short e[8];
#pragma unroll
                for (int j = 0; j < 8; ++j) e[j] = *(const LAS unsigned short*)(vst + (16 * ks + 8 * (j >> 2) + 4 * hi + (j & 3)) * 144 + (32 * d0 + r32) * 2);
                v4u vb; vb.x = e[0] | ((unsigned)e[1] << 16); vb.y = e[2] | ((unsigned)e[3] << 16); vb.z = e[4] | ((unsigned)e[5] << 16); vb.w = e[6] | ((unsigned)e[7] << 16);
                const s16x8 pa = __builtin_bit_cast(s16x8, ks == 0 ? pa0 : pa1), vf = __builtin_bit_cast(s16x8, vb);
                if (d0 == 0) o0 = __builtin_amdgcn_mfma_f32_32x32x16_bf16(pa, vf, o0, 0, 0, 0); else o1 = __builtin_amdgcn_mfma_f32_32x32x16_bf16(pa, vf, o1, 0, 0, 0); }
        LDS_WAIT();
        if (__all((SKIP_LOG2 >= 149.f) ? (C == 0.f) : (C < SB_STICK_MIN))) break;
    }
    bf16_t* Ow = O + (rowbase + qw0) * 1024 + 512 + h * 64;
#pragma unroll
    for (int r = 0; r < 16; ++r) { const int orow = crow16(r, hi);
        Ow[(size_t)orow * 1024 + r32] = (bf16_t)f2bf(o0[r]); Ow[(size_t)orow * 1024 + 32 + r32] = (bf16_t)f2bf(o1[r]); }
}

struct Args { const float* in[17]; float* out; unsigned char* ws; };

__global__ void __launch_bounds__(NWAVES * 64, 2) fwd_mega(Args args) {
    extern __shared__ __attribute__((aligned(16))) unsigned char lds[];
    cg::grid_group grid = cg::this_grid();
    LAS unsigned char* L = (LAS unsigned char*)lds;
    const int tid = threadIdx.x, lane = tid & 63, wave = __builtin_amdgcn_readfirstlane(tid >> 6);
    const int G = gridDim.x, gw = blockIdx.x * NWAVES + wave, NGW = G * NWAVES;
    unsigned char* ws = args.ws;
    volatile LAS unsigned* xst = (volatile LAS unsigned*)(L + MISC_OFF + 512);
    if (tid == 0) { xst[0] = 0u; xst[1] = 0u; }
    __syncthreads();
    const XcdBarrier xbar = xcd_barrier_post((unsigned*)(ws + WS_BAR), xst);
#if defined(PROBE_AT)
    if (blockIdx.x == 0 && tid == 0) { *(volatile LAS unsigned long long*)(L + MISC_OFF + 256) = __builtin_amdgcn_s_memrealtime(); }
#define PROBE_MARK(k) do { if ((k) == PROBE_AT && blockIdx.x == 0 && tid == 0) { *(volatile LAS unsigned long long*)(L + MISC_OFF + 264) = __builtin_amdgcn_s_memrealtime(); } } while (0)
#else
#define PROBE_MARK(k) do {} while (0)
#endif
    const float* x = args.in[0]; const float* cvec = args.in[1]; const float* w_ada = args.in[2]; const float* b_ada = args.in[3]; const float* w_in = args.in[4];
    const float* b_forget = args.in[5]; const float* w_fox = args.in[6]; const float* w_sb = args.in[7]; const float* w_o = args.in[8];
    const float* ln1_g = args.in[9]; const float* ln1_b = args.in[10]; const float* w_up = args.in[11]; const float* conv_w = args.in[12]; const float* conv_b = args.in[13];
    const float* w_dn = args.in[14]; const float* ln2_g = args.in[15]; const float* ln2_b = args.in[16];
    float* MOD = (float*)(ws + WS_MOD); float* WFT = (float*)(ws + WS_WFT); float* LF = (float*)(ws + WS_LF); float* CK = (float*)(ws + WS_CK);
    bf16_t* WIN = (bf16_t*)(ws + WS_WIN); bf16_t* WFS = (bf16_t*)(ws + WS_WFS); bf16_t* WO = (bf16_t*)(ws + WS_WO); bf16_t* WUP = (bf16_t*)(ws + WS_WUP); bf16_t* WDN = (bf16_t*)(ws + WS_WDN);
    bf16_t* U = (bf16_t*)(ws + WS_U); bf16_t* QKV = (bf16_t*)(ws + WS_QKV); bf16_t* MERGED = (bf16_t*)(ws + WS_MERGED); bf16_t* ACT = (bf16_t*)(ws + WS_ACT);
    bf16_t* GATES = (bf16_t*)(ws + WS_G); float* H1 = (float*)(ws + WS_H1);
    const size_t SLOT = (size_t)MTOK * 512;
    bf16_t* QA = QKV; bf16_t* QB = QKV + SLOT; bf16_t* KA = QKV + 2 * SLOT; bf16_t* VA = QKV + 3 * SLOT; bf16_t* KB = QKV + 4 * SLOT; bf16_t* VB = QKV + 5 * SLOT;

#if !defined(SKIP_P0)
    {
        LAS float* scr = (LAS float*)(L + wave * 16384);
        constexpr int I_IN = 16 * 160, I_FS = 8 * 32, I_O = 16 * 32, I_UP = 16 * 176, I_DN = 44 * 32, I_MOD = 768;
        constexpr int NIT = I_MOD + I_IN + 2 * I_FS + I_O + I_UP + I_DN;
        for (int it = gw; it < NIT; it += NGW) {
            int r = it;
            if (r < I_MOD) {
                const int j0 = 8 * r; float a[8][8];
#pragma unroll
                for (int bb = 0; bb < 8; ++bb)
#pragma unroll
                    for (int j = 0; j < 8; ++j) a[bb][j] = 0.f;
#pragma unroll 4
                for (int i = 0; i < 16; ++i) { const int k = lane + 64 * i; const f32x4 w0 = *(const f32x4*)(w_ada + (size_t)k * 6144 + j0), w1 = *(const f32x4*)(w_ada + (size_t)k * 6144 + j0 + 4);
#pragma unroll
                    for (int bb = 0; bb < 8; ++bb) { const float cb = cvec[bb * 1024 + k];
                        a[bb][0] += cb * w0[0]; a[bb][1] += cb * w0[1]; a[bb][2] += cb * w0[2]; a[bb][3] += cb * w0[3]; a[bb][4] += cb * w1[0]; a[bb][5] += cb * w1[1]; a[bb][6] += cb * w1[2]; a[bb][7] += cb * w1[3]; } }
                float mine = 0.f;
#pragma unroll
                for (int bb = 0; bb < 8; ++bb)
#pragma unroll
                    for (int j = 0; j < 8; ++j) { const float s = wave_sum(a[bb][j]); if (lane == bb * 8 + j) mine = s; }
                MOD[(lane >> 3) * 6144 + j0 + (lane & 7)] = mine + b_ada[j0 + (lane & 7)];
                continue;
            }
            r -= I_MOD;
            if (r < I_IN) { const int kb = r / 160, nb = r % 160, n0 = 32 * nb; const int t = n0 - 3072;
                const int src = (n0 < 1536) ? n0 : (n0 < 3072) ? n0 + 8 : 3080 + ((t >> 7) & 1) * 1024 + 128 * (t >> 8) + (t & 127);
                tr_item(w_in, NIN, src, 64 * kb, WIN, 1024, n0, scr, lane); continue; } r -= I_IN;
            if (r < I_FS) { const int kb = r / 32, nb = r % 32; tr_item(w_fox, 1024, 32 * nb, 64 * kb, WFS, 1024, 32 * nb, scr, lane, 0); continue; } r -= I_FS;
            if (r < I_FS) { const int kb = r / 32, nb = r % 32; tr_item(w_sb, 1024, 32 * nb, 64 * kb, WFS, 1024, 32 * nb, scr, lane, 512); continue; } r -= I_FS;
            if (r < I_O) { const int kb = r / 32, nb = r % 32; tr_item(w_o, 1024, 32 * nb, 64 * kb, WO, 1024, 32 * nb, scr, lane); continue; } r -= I_O;
            if (r < I_UP) { const int kb = r / 176, nb = r % 176, nn0 = 32 * nb; const int src = ((nn0 >> 7) & 1) * DFF + 128 * (nn0 >> 8) + (nn0 & 127);
                tr_item(w_up, 2 * DFF, src, 64 * kb, WUP, 1024, nn0, scr, lane); continue; } r -= I_UP;
            { const int kb = r / 32, nb = r % 32; tr_item(w_dn, 1024, 32 * nb, 64 * kb, WDN, DFF, 32 * nb, scr, lane); }
        }
        if (blockIdx.x == 0) { ((float*)(ws + WS_NRM))[tid & 255] = 0.f; ((unsigned*)(ws + WS_CTR))[tid] = 0u; }
        for (int e = blockIdx.x * (NWAVES * 64) + tid; e < 8192; e += G * NWAVES * 64) WFT[e] = w_in[(size_t)(e & 1023) * NIN + 1536 + (e >> 10)];
    }
#endif
    if (G == 0x7fffffff) grid.sync();
    xcd_barrier(xbar);
    PROBE_MARK(0);

#if !defined(SKIP_P1)
    LAS f32x4* wfl = (LAS f32x4*)L;
    for (int i = tid; i < 2048; i += NWAVES * 64) wfl[i] = ((const f32x4*)WFT)[i];
    __syncthreads();
    for (int blk = gw; blk < MTOK / 32; blk += NGW) {
        const int m0 = blk * 32, b = m0 >> 13; const float* mb = MOD + (size_t)b * 6144;
        const float bf = b_forget[lane & 7];
        f32x4 xn[4];
#pragma unroll
        for (int j = 0; j < 4; ++j) xn[j] = __builtin_nontemporal_load(((const f32x4*)(x + (size_t)m0 * 1024) + lane) + 64 * j);
        for (int r = 0; r < 32; ++r) {
            const int m = m0 + r; unsigned long long* o8 = (unsigned long long*)(U + (size_t)m * 1024) + lane;
            f32x4 u[4], xc[4];
#pragma unroll
            for (int j = 0; j < 4; ++j) xc[j] = xn[j];
            if (r < 31) {
#pragma unroll
                for (int j = 0; j < 4; ++j) xn[j] = __builtin_nontemporal_load(((const f32x4*)(x + (size_t)(m + 1) * 1024) + lane) + 64 * j); }
#pragma unroll
            for (int j = 0; j < 4; ++j) { const f32x4 shj = *(const f32x4*)(mb + 4 * lane + 256 * j), scj = *(const f32x4*)(mb + 1024 + 4 * lane + 256 * j) + 1.0f; u[j] = xc[j] * scj + shj; o8[64 * j] = (unsigned long long)pk2(u[j][0], u[j][1]) | ((unsigned long long)pk2(u[j][2], u[j][3]) << 32); }
            float mine = 0.f;
#pragma unroll
            for (int hh = 0; hh < 8; ++hh) { float s = 0.f;
#pragma unroll
                for (int j = 0; j < 4; ++j) { const f32x4 p = u[j] * wfl[hh * 256 + lane + 64 * j]; s += (p[0] + p[1]) + (p[2] + p[3]); }
                s = wave_sum(s); if ((lane & 7) == hh) mine = s; }
            if (lane < 8) { const float f = mine + bf; const float ls = (f >= 0.f) ? -log1pf(expf(-f)) : (f - log1pf(expf(f)));
                LF[((size_t)(b * 8 + lane)) * SEQ + (m & (SEQ - 1))] = ls * LOG2E_F; }
        }
    }
#endif
    xcd_barrier(xbar);
    PROBE_MARK(1);

#if !defined(SKIP_P2)
    if (blockIdx.x < 64) {
        LAS double* sm = (LAS double*)(L + MISC_OFF);
        const float* src = LF + (size_t)blockIdx.x * SEQ + 16 * tid; float* dst = CK + (size_t)blockIdx.x * SEQ + 16 * tid;
        f32x4 v[4]; double loc[16]; double run = 0.0;
#pragma unroll
        for (int j = 0; j < 4; ++j) v[j] = *(const f32x4*)(src + 4 * j);
#pragma unroll
        for (int i = 0; i < 16; ++i) { run += (double)v[i >> 2][i & 3]; loc[i] = run; }
        double inc = run;
#pragma unroll
        for (int o = 1; o < 64; o <<= 1) { const double t = __shfl_up(inc, o); if (lane >= o) inc += t; }
        if (lane == 63) sm[wave] = inc;
        __syncthreads();
        double woff = 0.0;
        for (int w = 0; w < wave; ++w) woff += sm[w];
        const double excl = woff + inc - run;
#pragma unroll
        for (int j = 0; j < 4; ++j) *(f32x4*)(dst + 4 * j) = (f32x4){(float)(excl + loc[4 * j]), (float)(excl + loc[4 * j + 1]), (float)(excl + loc[4 * j + 2]), (float)(excl + loc[4 * j + 3])};
        __syncthreads();
    }
    {
        pg8::Gemm g{U, WIN, MTOK, 5120, 1024, (size_t)256 * 1024 * 2}; pg8::StaticOrder S; S.init(MTOK, 5120, G, (int)blockIdx.x); S.wgm = WGM_WIDE;
        pg8::EpiInProj E{QKV, GATES, (unsigned*)(ws + WS_NRM)};
        pg8::gemm_phase<pg8::EpiInProj, pg8::StaticOrder, true, true>(L, g, S, E);
    }
#endif
    xcd_barrier(xbar);
    PROBE_MARK(2);

#if !defined(SKIP_P3)
    {
        LAS unsigned char* vst = L + wave * 4608;
        for (int i = 0; i < (64 * 256) / NGW + 1; ++i) { const int uid = i * NGW + gw; if (uid >= 64 * 256) break; const int bh = uid >> 8, qblk = uid & 255;
            sb_unit(bh >> 3, bh & 7, qblk, QB, KB, VB, U, vst, lane); }
        __syncthreads();
        PROBE_MARK(20);
        const attn_body::AttnTensors AT{(const attn_body::bf16*)QA, (const attn_body::bf16*)KA, (const attn_body::bf16*)VA, (attn_body::bf16*)U, CK, (const float*)(ws + WS_NRM)};
        const attn_body::DynOrder S{(unsigned*)(ws + WS_CTR), (volatile LAS unsigned*)(L + MISC_OFF + 128), (int)(blockIdx.x & 7)};
        attn_body::attn_phase<attn_body::DynOrder>((char*)lds, AT, S);
    }
#endif
    xcd_barrier(xbar);
    PROBE_MARK(3);

#if !defined(SKIP_P4)
    {
        pg8::Gemm g{U, WFS, MTOK, 1024, 1024, (size_t)256 * 1024 * 2}; pg8::StaticOrder S; S.init(MTOK, 1024, G, (int)blockIdx.x); S.wgm = WGM_NARROW;
        pg8::EpiMerge E{GATES, MERGED};
        pg8::gemm_phase<pg8::EpiMerge, pg8::StaticOrder, true, true>(L, g, S, E);
    }
#endif
    xcd_barrier(xbar);
    PROBE_MARK(4);

#if !defined(SKIP_P5)
    {
        pg8::Gemm g{MERGED, WO, MTOK, 1024, 1024, (size_t)256 * 1024 * 2}; pg8::StaticOrder S; S.init(MTOK, 1024, G, (int)blockIdx.x); S.wgm = WGM_NARROW;
        pg8::EpiBranch E{MOD + 2048, U};
        pg8::gemm_phase<pg8::EpiBranch, pg8::StaticOrder, true, true>(L, g, S, E);
    }
#endif
    xcd_barrier(xbar);
    PROBE_MARK(5);

#if !defined(SKIP_P6)
    for (int blk = gw; blk < MTOK / 32; blk += NGW) {
        const int m0 = blk * 32, b = m0 >> 13; const float* mb = MOD + (size_t)b * 6144;
        f32x4 sc[4], sh[4], lg[4], lb[4];
#pragma unroll
        for (int j = 0; j < 4; ++j) { sh[j] = *(const f32x4*)(mb + 3072 + 4 * lane + 256 * j); sc[j] = *(const f32x4*)(mb + 4096 + 4 * lane + 256 * j) + 1.0f;
            lg[j] = *(const f32x4*)(ln1_g + 4 * lane + 256 * j); lb[j] = *(const f32x4*)(ln1_b + 4 * lane + 256 * j); }
        for (int g4 = 0; g4 < 8; ++g4) {
            const int mg = m0 + 4 * g4;
            f32x4 v[4][4]; unsigned long long bb[4][4];
#pragma unroll
            for (int i = 0; i < 4; ++i)
#pragma unroll
                for (int j = 0; j < 4; ++j) { v[i][j] = __builtin_nontemporal_load(((const f32x4*)(x + (size_t)(mg + i) * 1024) + lane) + 64 * j); bb[i][j] = ((const unsigned long long*)(U + (size_t)(mg + i) * 1024) + lane)[64 * j]; }
            float s[4], s2[4];
#pragma unroll
            for (int i = 0; i < 4; ++i) { s[i] = 0.f;
#pragma unroll
                for (int j = 0; j < 4; ++j) { const unsigned blo = (unsigned)bb[i][j], bhi = (unsigned)(bb[i][j] >> 32);
                    v[i][j] = v[i][j] * DN_ALPHA + (f32x4){pg8::bflo(blo), pg8::bfhi(blo), pg8::bflo(bhi), pg8::bfhi(bhi)}; s[i] += (v[i][j][0] + v[i][j][1]) + (v[i][j][2] + v[i][j][3]); } }
            wave_sum4(s);
#pragma unroll
            for (int i = 0; i < 4; ++i) { const float mean = s[i] * (1.f / 1024.f); s2[i] = 0.f;
#pragma unroll
                for (int j = 0; j < 4; ++j) { v[i][j] = v[i][j] - mean; s2[i] += (v[i][j][0] * v[i][j][0] + v[i][j][1] * v[i][j][1]) + (v[i][j][2] * v[i][j][2] + v[i][j][3] * v[i][j][3]); } }
            wave_sum4(s2);
#pragma unroll
            for (int i = 0; i < 4; ++i) { const float rstd = 1.f / sqrtf(s2[i] * (1.f / 1024.f) + LN_EPS);
                unsigned long long* hr = (unsigned long long*)((bf16_t*)H1 + (size_t)(mg + i) * 1024) + lane; unsigned long long* o8 = (unsigned long long*)(U + (size_t)(mg + i) * 1024) + lane;
#pragma unroll
                for (int j = 0; j < 4; ++j) { const f32x4 x1 = v[i][j] * rstd * lg[j] + lb[j]; hr[64 * j] = (unsigned long long)pk2(x1[0], x1[1]) | ((unsigned long long)pk2(x1[2], x1[3]) << 32);
                    const f32x4 u2 = x1 * sc[j] + sh[j]; o8[64 * j] = (unsigned long long)pk2(u2[0], u2[1]) | ((unsigned long long)pk2(u2[2], u2[3]) << 32); } }
        }
    }
#endif
    xcd_barrier(xbar);
    PROBE_MARK(6);

#if !defined(SKIP_P7)
    {
        pg8::Gemm g{U, WUP, MTOK, 2 * DFF, 1024, (size_t)256 * 1024 * 2}; pg8::StaticOrder S; S.init(MTOK, 2 * DFF, G, (int)blockIdx.x); S.wgm = WGM_WIDE;
        pg8::EpiUpConv E{conv_w, conv_b, ACT, (LAS f32x4*)(L + XCH_OFF), (LAS float*)(L + MISC_OFF + 1024), (float*)(ws + WS_HALO)};
        pg8::gemm_phase<pg8::EpiUpConv, pg8::StaticOrder, true, true>(L, g, S, E);
    }
    xcd_barrier(xbar);
    {
        const float* HALO = (const float*)(ws + WS_HALO);
        for (int idx = blockIdx.x * (NWAVES * 64) + tid; idx < 43 * DFF; idx += G * NWAVES * 64) {
            const int pg = idx / DFF, ch = idx - pg * DFF, nng = 256 * (ch >> 7) + (ch & 127);
            float w0[2], w1[2], w2[2], bb[2];
#pragma unroll
            for (int v = 0; v < 2; ++v) { const int cc = ch + DFF * v; w0[v] = conv_w[cc]; w1[v] = conv_w[5632 + cc]; w2[v] = conv_w[2 * 5632 + cc]; bb[v] = conv_b[cc]; }
            float h0[6][2], h1[6][2], hm2[6][2], hm1[6][2];
#pragma unroll
            for (int k = 0; k < 6; ++k) { const int p = 6 * pg + k; const bool in = p < 256, s0 = (p & 31) == 0;
                const float* Hc = HALO + (size_t)(in ? p : 0) * 4 * 5632; const float* Hp = Hc - (s0 ? 0 : 4 * 5632);
#pragma unroll
                for (int v = 0; v < 2; ++v) { const int nn = nng + 128 * v; h0[k][v] = Hc[nn]; h1[k][v] = Hc[5632 + nn]; hm2[k][v] = Hp[2 * 5632 + nn]; hm1[k][v] = Hp[3 * 5632 + nn]; } }
#pragma unroll
            for (int k = 0; k < 6; ++k) { const int p = 6 * pg + k; if (p >= 256) break; const bool s0 = (p & 31) == 0; float cr0[2], cr1[2];
#pragma unroll
                for (int v = 0; v < 2; ++v) { const float a2 = s0 ? 0.f : hm2[k][v], a1 = s0 ? 0.f : hm1[k][v];
                    cr0[v] = bb[v] + w0[v] * a2 + w1[v] * a1 + w2[v] * h0[k][v]; cr1[v] = bb[v] + w0[v] * a1 + w1[v] * h0[k][v] + w2[v] * h1[k][v]; }
                ACT[(size_t)(256 * p) * DFF + ch] = (bf16_t)f2bf(cr0[0] * pg8::sigm(cr0[0]) * cr0[1]);
                ACT[(size_t)(256 * p + 1) * DFF + ch] = (bf16_t)f2bf(cr1[0] * pg8::sigm(cr1[0]) * cr1[1]); }
        }
    }
#endif
    xcd_barrier(xbar);
    PROBE_MARK(7);

#if !defined(SKIP_P8)
    {
        pg8::Gemm g{ACT, WDN, MTOK, 1024, DFF, (size_t)256 * DFF * 2}; pg8::StaticOrder S; S.init(MTOK, 1024, G, (int)blockIdx.x); S.wgm = WGM_NARROW;
        pg8::EpiBranch E{MOD + 5120, U};
        pg8::gemm_phase<pg8::EpiBranch, pg8::StaticOrder, true, true>(L, g, S, E);
    }
#endif
    xcd_barrier(xbar);
    PROBE_MARK(8);

#if !defined(SKIP_P9)
    {
        f32x4 lg[4], lb[4]; const bf16_t* X1B = (const bf16_t*)H1;
#pragma unroll
        for (int j = 0; j < 4; ++j) { lg[j] = *(const f32x4*)(ln2_g + 4 * lane + 256 * j); lb[j] = *(const f32x4*)(ln2_b + 4 * lane + 256 * j); }
        for (int blk = gw; blk < MTOK / 32; blk += NGW)
        for (int g4 = 0; g4 < 8; ++g4) {
            const int mg = blk * 32 + 4 * g4;
            unsigned long long xb[4][4], bb[4][4];
#pragma unroll
            for (int i = 0; i < 4; ++i)
#pragma unroll
                for (int j = 0; j < 4; ++j) { xb[i][j] = ((const unsigned long long*)(X1B + (size_t)(mg + i) * 1024) + lane)[64 * j]; bb[i][j] = ((const unsigned long long*)(U + (size_t)(mg + i) * 1024) + lane)[64 * j]; }
            f32x4 v[4][4]; float s[4], s2[4];
#pragma unroll
            for (int i = 0; i < 4; ++i) { s[i] = 0.f;
#pragma unroll
                for (int j = 0; j < 4; ++j) { const unsigned xlo = (unsigned)xb[i][j], xhi = (unsigned)(xb[i][j] >> 32), blo = (unsigned)bb[i][j], bhi = (unsigned)(bb[i][j] >> 32);
                    v[i][j] = (f32x4){pg8::bflo(xlo), pg8::bfhi(xlo), pg8::bflo(xhi), pg8::bfhi(xhi)} * DN_ALPHA + (f32x4){pg8::bflo(blo), pg8::bfhi(blo), pg8::bflo(bhi), pg8::bfhi(bhi)};
                    s[i] += (v[i][j][0] + v[i][j][1]) + (v[i][j][2] + v[i][j][3]); } }
            wave_sum4(s);
#pragma unroll
            for (int i = 0; i < 4; ++i) { const float mean = s[i] * (1.f / 1024.f); s2[i] = 0.f;
#pragma unroll
                for (int j = 0; j < 4; ++j) { v[i][j] = v[i][j] - mean; s2[i] += (v[i][j][0] * v[i][j][0] + v[i][j][1] * v[i][j][1]) + (v[i][j][2] * v[i][j][2] + v[i][j][3] * v[i][j][3]); } }
            wave_sum4(s2);
#pragma unroll
            for (int i = 0; i < 4; ++i) { const float rstd = 1.f / sqrtf(s2[i] * (1.f / 1024.f) + LN_EPS); f32x4* hr = (f32x4*)(args.out + (size_t)(mg + i) * 1024) + lane;
#pragma unroll
                for (int j = 0; j < 4; ++j) hr[64 * j] = v[i][j] * rstd * lg[j] + lb[j]; }
        }
    }
#endif
#if defined(PROBE_AT)
    if (blockIdx.x == 0 && tid == 0) { const unsigned long long a = *(volatile LAS unsigned long long*)(L + MISC_OFF + 256), b = *(volatile LAS unsigned long long*)(L + MISC_OFF + 264);
        const unsigned long long t1 = __builtin_amdgcn_s_memrealtime(); while (__builtin_amdgcn_s_memrealtime() - t1 < 2 * (b - a)) __builtin_amdgcn_s_sleep(8); }
#endif
}

extern "C" void kernel_launch(void* const* d_in, const int* in_sizes, int n_in, void* d_out, int out_size, void* d_ws, size_t ws_size, hipStream_t stream) {
    static int grid = 0;
    if (grid == 0) {
        if (n_in != 17 || out_size != MTOK * 1024 || ws_size < WS_END) { fprintf(stderr, "kernel_launch: unexpected shapes (n_in %d out %d ws %zu)\n", n_in, out_size, ws_size); grid = -1; return; }
        int dev = 0, cus = 0, per_cu = 0;
        hipGetDevice(&dev); hipDeviceGetAttribute(&cus, hipDeviceAttributeMultiprocessorCount, dev);
        if (hipFuncSetAttribute((const void*)fwd_mega, hipFuncAttributeMaxDynamicSharedMemorySize, LDS_BYTES) != hipSuccess) { fprintf(stderr, "kernel_launch: hipFuncSetAttribute failed\n"); grid = -1; return; }
        hipOccupancyMaxActiveBlocksPerMultiprocessor(&per_cu, (const void*)fwd_mega, NWAVES * 64, LDS_BYTES);
        (void)hipGetLastError();
        if (per_cu < 1) per_cu = 1;
        grid = cus * 1;
    }
    if (grid < 0) return;
    if (hipMemsetAsync((char*)d_ws + WS_BAR, 0, XCD_BAR_WORDS * 4, stream) != hipSuccess) { fprintf(stderr, "kernel_launch: memset of the barrier words failed\n"); return; }
    Args a{};
    for (int i = 0; i < 17; ++i) a.in[i] = (const float*)d_in[i];
    a.out = (float*)d_out; a.ws = (unsigned char*)d_ws;
    void* kargs[] = {&a};
    hipError_t e = hipLaunchCooperativeKernel((const void*)fwd_mega, dim3(grid), dim3(NWAVES * 64), kargs, LDS_BYTES, stream);
    if (e != hipSuccess) fprintf(stderr, "cooperative launch failed: %s (grid %d)\n", hipGetErrorString(e), grid);
}
```

```cpp
#include <hip/hip_runtime.h>
#include <hip/hip_cooperative_groups.h>
#include <cstdio>
#include <cstdint>
constexpr int MTOK = 65536;
constexpr float DN_ALPHA = 1.189207115002721f;
#ifndef SKIP_LOG2
#define SKIP_LOG2 68.0f
#endif
namespace pg8 {
#define PG8_LAS __attribute__((address_space(3)))
typedef unsigned short bf16_t;
typedef short bf16x8 __attribute__((ext_vector_type(8)));
typedef float f32x4 __attribute__((ext_vector_type(4)));
typedef unsigned u32x4 __attribute__((ext_vector_type(4)));
constexpr int BM = 256, BK = 64, HALF = 128, HTB = HALF * BK * 2  , STAGE_BYTES = 8 * HTB, NXCD = 8, WGM = 8;

__host__ __device__ __forceinline__ int lds_byte(int r, int c) { const int st = (r >> 4) * 2 + (c >> 5), rr = r & 15, cc = c & 31, ob = rr * 64 + cc * 2; return st * 1024 + (ob ^ (((ob >> 9) & 1) << 5)); }
__host__ __device__ __forceinline__ void stage_rc(int b, int& R, int& C) { const int st = b / 1024, sb = b % 1024, swz = sb ^ (((sb >> 9) & 1) << 5); R = (st >> 1) * 16 + swz / 64; C = (st & 1) * 32 + (swz % 64) / 2; }
__host__ __device__ __forceinline__ int perm32(int rho) { const int n = rho >> 4, i = rho & 15; return 8 * (i >> 2) + 4 * n + (i & 3); }

struct Unit { int pm, pn; };
struct Gemm { const bf16_t* A; const bf16_t* Bt; int M, N, K; size_t a_tstep; };

struct StaticOrder {
    int nM, nN, nwg, G, c, wgm = WGM;
    __host__ __device__ void init(int M, int N, int G_, int c_) { nM = M / BM; nN = N / BM; nwg = nM * nN; G = G_; c = c_; }
    __host__ __device__ void init_tiles(int nM_, int nN_, int G_, int c_) { nM = nM_; nN = nN_; nwg = nM * nN; G = G_; c = c_; }
    __host__ __device__ bool next(int i, Unit& u) const {
        const long L = (long)i * G + c; if (L >= nwg) return false;
        int wgid = (int)L; { const int q = nwg / NXCD, r = nwg % NXCD, xcd = wgid % NXCD, off = wgid / NXCD; wgid = (xcd < r ? xcd * (q + 1) : r * (q + 1) + (xcd - r) * q) + off; }
        const int nig = wgm * nN, gid = wgid / nig, fm = gid * wgm, gsz = (nM - fm) < wgm ? (nM - fm) : wgm;
        u.pm = fm + ((wgid % nig) % gsz); u.pn = (wgid % nig) / gsz; return true;
    }
    __device__ __forceinline__ void a_ready(const Unit&) const {}
    __device__ __forceinline__ void done(const Unit&) const {}
};

__device__ __forceinline__ unsigned cvt_pk_bf16(float lo, float hi) { unsigned r; asm volatile("v_cvt_pk_bf16_f32 %0, %1, %2" : "=v"(r) : "v"(lo), "v"(hi)); return r; }
typedef float f32x2 __attribute__((ext_vector_type(2)));
constexpr float C2f = 0.125f * 1.4426950408889634f;
constexpr float LOG2E = 1.4426950408889634f;
__device__ __forceinline__ float sigm(float v) { return __builtin_amdgcn_rcpf(1.0f + __builtin_amdgcn_exp2f(-LOG2E * v)); }
__device__ __forceinline__ float bflo(unsigned w) { return __builtin_bit_cast(float, w << 16); }
__device__ __forceinline__ float bfhi(unsigned w) { return __builtin_bit_cast(float, w & 0xffff0000u); }

struct EpiInProj {
    static constexpr bool PERM = true, AFTER_DRAIN = false, HAS_MID = false;
    bf16_t* qkv; bf16_t* gates; unsigned* nrm;
    __device__ __forceinline__ void operator()(const f32x4 (&acc)[2][2][4][2], const Unit& u, int wr, int wc, int fr, int fq) const {
        const int pn = u.pn; bf16_t* base; int ldc, colt; float sc = 1.f; bool sg = false;
        if (pn < 12) { const int t = pn >> 1, slot = (0x541320 >> (4 * t)) & 7; base = qkv + (size_t)slot * ((size_t)MTOK * 512); ldc = 512; colt = (pn & 1) * 256; if (t == 0 || t == 3) sc = C2f; }
        else { base = gates; ldc = 1024; colt = (pn - 12) * 128; sg = true; }
        const int row0 = u.pm * BM + wr * 64 + fr, col0 = colt + wc * 32 + 8 * fq;
        float nmx[2] = {0.f, 0.f};
#pragma unroll
        for (int ai = 0; ai < 2; ++ai)
#pragma unroll
            for (int m = 0; m < 4; ++m) { bf16_t* rowp = base + (size_t)(row0 + ai * HALF + m * 16) * ldc + col0;
                if (sg) {
                    f32x4 rr[2], gg[2];
#pragma unroll
                    for (int n = 0; n < 2; ++n)
#pragma unroll
                        for (int j = 0; j < 4; ++j) { const float ea = __builtin_amdgcn_exp2f(-LOG2E * acc[ai][0][m][n][j]), eb = __builtin_fminf(__builtin_amdgcn_exp2f(-LOG2E * acc[ai][1][m][n][j]), 1e30f);
                            gg[n][j] = __builtin_amdgcn_rcpf(1.0f + eb); rr[n][j] = (1.0f + eb) * __builtin_amdgcn_rcpf(1.0f + ea); }
                    u32x4 w; w.x = cvt_pk_bf16(rr[0][0], rr[0][1]); w.y = cvt_pk_bf16(rr[0][2], rr[0][3]); w.z = cvt_pk_bf16(rr[1][0], rr[1][1]); w.w = cvt_pk_bf16(rr[1][2], rr[1][3]);
                    *(u32x4*)rowp = w;
                    w.x = cvt_pk_bf16(gg[0][0], gg[0][1]); w.y = cvt_pk_bf16(gg[0][2], gg[0][3]); w.z = cvt_pk_bf16(gg[1][0], gg[1][1]); w.w = cvt_pk_bf16(gg[1][2], gg[1][3]);
                    *(u32x4*)(rowp + (size_t)MTOK * 1024) = w;
                    continue; }
#pragma unroll
                for (int bj = 0; bj < 2; ++bj) { f32x4 v0 = acc[ai][bj][m][0], v1 = acc[ai][bj][m][1];
                    if (pn < 4) { const float a0 = bflo(cvt_pk_bf16(v0[0] * sc, 0.f)), a1 = bflo(cvt_pk_bf16(v0[1] * sc, 0.f)), a2 = bflo(cvt_pk_bf16(v0[2] * sc, 0.f)), a3 = bflo(cvt_pk_bf16(v0[3] * sc, 0.f)),
                                      a4 = bflo(cvt_pk_bf16(v1[0] * sc, 0.f)), a5 = bflo(cvt_pk_bf16(v1[1] * sc, 0.f)), a6 = bflo(cvt_pk_bf16(v1[2] * sc, 0.f)), a7 = bflo(cvt_pk_bf16(v1[3] * sc, 0.f));
                        float s = (a0 * a0 + a1 * a1) + (a2 * a2 + a3 * a3) + (a4 * a4 + a5 * a5) + (a6 * a6 + a7 * a7);
                        s += __shfl_xor(s, 16); s += __shfl_xor(s, 32); nmx[bj] = __builtin_fmaxf(nmx[bj], s); }
                    v0 = v0 * sc; v1 = v1 * sc;
                    u32x4 w; w.x = cvt_pk_bf16(v0[0], v0[1]); w.y = cvt_pk_bf16(v0[2], v0[3]); w.z = cvt_pk_bf16(v1[0], v1[1]); w.w = cvt_pk_bf16(v1[2], v1[3]);
                    *(u32x4*)(rowp + bj * HALF) = w; } }
        if (pn < 4) {
#pragma unroll
            for (int bj = 0; bj < 2; ++bj) { float s = nmx[bj] * 1.0001f;
#pragma unroll
                for (int o = 1; o < 16; o <<= 1) s = __builtin_fmaxf(s, __shfl_xor(s, o));
                if (fr == 0 && fq == 0) atomicMax(nrm + (((u.pm >> 5) * 8 + (pn & 1) * 4 + bj * 2 + (wc >> 1)) * 2 + (pn >> 1)) * 2 + (wc & 1), __builtin_bit_cast(unsigned, s)); }
        }
    }
};

struct EpiMerge {
    static constexpr bool PERM = true, AFTER_DRAIN = false, HAS_MID = true;
    const bf16_t* gates; bf16_t* merged;
    __device__ __forceinline__ void mid(f32x4 (&acc)[2][2][4][2], const Unit& u, int wr, int wc, int, int) const {
        int t_ = threadIdx.x; asm volatile("" : "+v"(t_)); const int fr = t_ & 15, fq = (t_ >> 4) & 3;
        const int row0 = u.pm * BM + wr * 64 + fr, col0 = u.pn * BM + wc * 32 + 8 * fq; const bf16_t* R = gates;
#pragma unroll
        for (int ai = 0; ai < 2; ++ai)
#pragma unroll
            for (int m = 0; m < 4; ++m)
#pragma unroll
                for (int bj = 0; bj < 2; ++bj) { const size_t off = (size_t)(row0 + ai * HALF + m * 16) * 1024 + col0 + bj * HALF;
                    const u32x4 a = *(const u32x4*)(R + off);
                    acc[ai][bj][m][0] = acc[ai][bj][m][0] * (f32x4){bflo(a.x), bfhi(a.x), bflo(a.y), bfhi(a.y)};
                    acc[ai][bj][m][1] = acc[ai][bj][m][1] * (f32x4){bflo(a.z), bfhi(a.z), bflo(a.w), bfhi(a.w)}; }
    }
    __device__ __forceinline__ void operator()(const f32x4 (&acc)[2][2][4][2], const Unit& u, int wr, int wc, int fr, int fq) const {
        const bf16_t* GB = gates + (size_t)MTOK * 1024;
        const int row0 = u.pm * BM + wr * 64 + fr, col0 = u.pn * BM + wc * 32 + 8 * fq;
#pragma unroll
        for (int ai = 0; ai < 2; ++ai)
#pragma unroll
            for (int m = 0; m < 4; ++m)
#pragma unroll
                for (int bj = 0; bj < 2; ++bj) { const size_t off = (size_t)(row0 + ai * HALF + m * 16) * 1024 + col0 + bj * HALF;
                    const u32x4 b = *(const u32x4*)(GB + off);
#define PG8_CL(x, f) f(x)
                    const f32x4 v0 = acc[ai][bj][m][0] * (f32x4){PG8_CL(b.x, bflo), PG8_CL(b.x, bfhi), PG8_CL(b.y, bflo), PG8_CL(b.y, bfhi)};
                    const f32x4 v1 = acc[ai][bj][m][1] * (f32x4){PG8_CL(b.z, bflo), PG8_CL(b.z, bfhi), PG8_CL(b.w, bflo), PG8_CL(b.w, bfhi)};
#undef PG8_CL
                    u32x4 w; w.x = cvt_pk_bf16(v0[0], v0[1]); w.y = cvt_pk_bf16(v0[2], v0[3]); w.z = cvt_pk_bf16(v1[0], v1[1]); w.w = cvt_pk_bf16(v1[2], v1[3]);
                    *(u32x4*)(merged + off) = w; }
    }
};

struct EpiBranch {
    static constexpr bool PERM = true, AFTER_DRAIN = false, HAS_MID = false;
    const float* gt; bf16_t* out;
    __device__ __forceinline__ void operator()(const f32x4 (&acc)[2][2][4][2], const Unit& u, int wr, int wc, int fr, int fq) const {
        const int row0 = u.pm * BM + wr * 64 + fr, col0 = u.pn * BM + wc * 32 + 8 * fq; const float* g = gt + (size_t)(u.pm >> 5) * 6144 + col0;
#pragma unroll
        for (int bj = 0; bj < 2; ++bj) { const f32x4 g0 = *(const f32x4*)(g + bj * HALF) + 1.0f, g1 = *(const f32x4*)(g + bj * HALF + 4) + 1.0f;
#pragma unroll
            for (int ai = 0; ai < 2; ++ai)
#pragma unroll
                for (int m = 0; m < 4; ++m) { const f32x4 v0 = g0 * acc[ai][bj][m][0], v1 = g1 * acc[ai][bj][m][1];
                    u32x4 w; w.x = cvt_pk_bf16(v0[0], v0[1]); w.y = cvt_pk_bf16(v0[2], v0[3]); w.z = cvt_pk_bf16(v1[0], v1[1]); w.w = cvt_pk_bf16(v1[2], v1[3]);
                    *(u32x4*)(out + (size_t)(row0 + ai * HALF + m * 16) * 1024 + col0 + bj * HALF) = w; } }
    }
};

struct EpiUpConv {
    static constexpr bool PERM = true, AFTER_DRAIN = false, HAS_MID = false;
    const float* cw; const float* cb; bf16_t* act; PG8_LAS f32x4* xch; PG8_LAS float* wl; float* halo;
    template <int CTRL> static __device__ __forceinline__ float ror_d(float x) { return __builtin_bit_cast(float, __builtin_amdgcn_update_dpp(0, __builtin_bit_cast(int, x), CTRL, 0xf, 0xf, true)); }
    template <bool SEQ0> __device__ __forceinline__ f32x4 conv1(const f32x4 cur, const f32x4 prv, const f32x4 w0, const f32x4 w1, const f32x4 w2, const f32x4 bb, int fr, int s1, int s2, int tseq) const {
        const f32x4 a1 = (fr >= 15) ? prv : cur, a2 = (fr >= 14) ? prv : cur;
        f32x4 p1, p2;
        p1 = (f32x4){ror_d<0x121>(a1[0]), ror_d<0x121>(a1[1]), ror_d<0x121>(a1[2]), ror_d<0x121>(a1[3])};
        p2 = (f32x4){ror_d<0x122>(a2[0]), ror_d<0x122>(a2[1]), ror_d<0x122>(a2[2]), ror_d<0x122>(a2[3])};
        if (SEQ0) { if (tseq < 1) p1 = (f32x4){0.f, 0.f, 0.f, 0.f}; if (tseq < 2) p2 = (f32x4){0.f, 0.f, 0.f, 0.f}; }
        return bb + w0 * p2 + w1 * p1 + w2 * cur;
    }
    __device__ __forceinline__ void operator()(const f32x4 (&acc)[2][2][4][2], const Unit& u, int wr, int wc, int, int) const { run<false>(acc, u, wr, wc); }
    template <bool SEQ0> __device__ __forceinline__ void run(const f32x4 (&acc)[2][2][4][2], const Unit& u, int wr, int wc) const {
        int t_ = threadIdx.x; asm volatile("" : "+v"(t_));
        const int fr = t_ & 15, fq = (t_ >> 4) & 3, lane = t_ & 63;
        const int R0 = 256 * u.pm, ch0 = 128 * u.pn + 32 * wc + 8 * fq;
        if ((wr == 0 && fr < 2) || (wr == 1 && fr >= 14)) {
#pragma unroll
            for (int bj = 0; bj < 2; ++bj)
#pragma unroll
                for (int n = 0; n < 2; ++n) { const f32x4 hv = (wr == 0) ? acc[0][bj][0][n] : acc[1][bj][3][n];
                    *(f32x4*)(halo + ((size_t)u.pm * 4 + (wr == 0 ? fr : fr - 12)) * 5632 + 256 * u.pn + 128 * bj + 32 * wc + 8 * fq + 4 * n) = hv; }
        }
        const int xi = fq * 2 + (fr - 14);
        { const int idx = (t_ & 511) * 2, p = idx >> 8, bjw = (idx >> 7) & 1, cc = idx & 127; const float* src = (p < 3 ? cw + p * 5632 : cb) + bjw * 2816 + 128 * u.pn + cc;
          typedef float f32x2w __attribute__((ext_vector_type(2))); *(PG8_LAS f32x2w*)(wl + idx) = *(const f32x2w*)src; }
        if (fr >= 14) {
#pragma unroll
            for (int ai = 0; ai < 2; ++ai)
#pragma unroll
                for (int bj = 0; bj < 2; ++bj)
#pragma unroll
                    for (int n = 0; n < 2; ++n) xch[(((((ai * 2 + wr) * 4 + wc) * 2 + bj) * 2 + n) * 8) + xi] = acc[ai][bj][3][n];
        }
        asm volatile("s_waitcnt lgkmcnt(0)\n\ts_barrier" ::: "memory");
        const int s1 = (lane & 48) | ((fr - 1) & 15), s2 = (lane & 48) | ((fr - 2) & 15);
#pragma unroll
        for (int ai = 0; ai < 2; ++ai) {
            typedef unsigned u32x2 __attribute__((ext_vector_type(2))); u32x2 wq[2][4];
#pragma unroll
            for (int n = 0; n < 2; ++n) {
                asm volatile("" ::: "memory");
                const bool hasup = (fr >= 14) && ((ai * 2 + wr) >= 1);
                const int upi = (((((ai * 2 + wr - 1) * 4 + wc) * 2 + 0) * 2 + n) * 8) + xi;
                f32x4 cg[4];
                {   int cl = 32 * wc + 8 * fq + 4 * n; asm volatile("" : "+v"(cl));
                    const f32x4 w0 = *(const PG8_LAS f32x4*)(wl + cl), w1 = *(const PG8_LAS f32x4*)(wl + 256 + cl), w2 = *(const PG8_LAS f32x4*)(wl + 512 + cl), bb = *(const PG8_LAS f32x4*)(wl + 768 + cl);
                    f32x4 up = (f32x4){0.f, 0.f, 0.f, 0.f}; if (hasup) up = xch[upi];
#pragma unroll
                    for (int m = 0; m < 4; ++m) cg[m] = conv1<SEQ0>(acc[ai][0][m][n], (m == 0) ? up : acc[ai][0][m > 0 ? m - 1 : 0][n], w0, w1, w2, bb, fr, s1, s2, (R0 + 128 * ai + 64 * wr + 16 * m + fr) & 8191);
                }
                {   int cl = 128 + 32 * wc + 8 * fq + 4 * n; asm volatile("" : "+v"(cl));
                    const f32x4 w0 = *(const PG8_LAS f32x4*)(wl + cl), w1 = *(const PG8_LAS f32x4*)(wl + 256 + cl), w2 = *(const PG8_LAS f32x4*)(wl + 512 + cl), bb = *(const PG8_LAS f32x4*)(wl + 768 + cl);
                    f32x4 up = (f32x4){0.f, 0.f, 0.f, 0.f}; if (hasup) up = xch[upi + 16];
#pragma unroll
                    for (int m = 0; m < 4; ++m) {
                        const int rr = 128 * ai + 64 * wr + 16 * m + fr, grow = R0 + rr;
                        const f32x4 vl = conv1<SEQ0>(acc[ai][1][m][n], (m == 0) ? up : acc[ai][1][m > 0 ? m - 1 : 0][n], w0, w1, w2, bb, fr, s1, s2, grow & 8191);
                        const f32x4 gt = cg[m];
                        const f32x4 ex = gt * (-LOG2E); f32x4 dn = (f32x4){__builtin_amdgcn_exp2f(ex[0]), __builtin_amdgcn_exp2f(ex[1]), __builtin_amdgcn_exp2f(ex[2]), __builtin_amdgcn_exp2f(ex[3])} + 1.0f;
                        const f32x4 rc = (f32x4){__builtin_amdgcn_rcpf(dn[0]), __builtin_amdgcn_rcpf(dn[1]), __builtin_amdgcn_rcpf(dn[2]), __builtin_amdgcn_rcpf(dn[3])};
                        const f32x4 ov = (gt * vl) * rc;
                        wq[n][m].x = cvt_pk_bf16(ov[0], ov[1]); wq[n][m].y = cvt_pk_bf16(ov[2], ov[3]);
                    }
                }
            }
#pragma unroll
            for (int m = 0; m < 4; ++m) { const int rr = 128 * ai + 64 * wr + 16 * m + fr, grow = R0 + rr;
                if (rr >= 2) { u32x4 w; w.x = wq[0][m].x; w.y = wq[0][m].y; w.z = wq[1][m].x; w.w = wq[1][m].y; *(u32x4*)(act + (size_t)grow * 2816 + ch0) = w; } }
        }
    }
};
template <class Epi, class Sched, bool ALIGN_EPI = false, bool SP2 = false>
__device__ __forceinline__ void gemm_phase(PG8_LAS unsigned char* lds, const Gemm g, const Sched& S, const Epi& E) {
    int tid_ = threadIdx.x; asm volatile("" : "+v"(tid_));
    const int tid = tid_, wid = __builtin_amdgcn_readfirstlane(tid >> 6), lane = tid & 63, wr = wid >> 2, wc = wid & 3, fr = lane & 15, fq = lane >> 4;
    const int K = g.K, nt = K / BK;
    unsigned voffA[2], voffB[2];
#pragma unroll
    for (int i = 0; i < 2; ++i) { int R, C; stage_rc(tid * 16 + i * 8192, R, C); const int Rb = Epi::PERM ? ((R & ~31) + perm32(R & 31)) : R;
        voffA[i] = (unsigned)(R * K + C) * 2u; voffB[i] = (unsigned)(Rb * K + C) * 2u; }
    const size_t kstep = (size_t)(BK * 2);
    const size_t hstep = (size_t)HALF * K * 2;
    const size_t tstep = 2 * hstep;
    const unsigned ldsw = (unsigned)wid * 1024u;
    const int aoff = lds_byte(wr * 64 + fr, fq * 8), boff = lds_byte(wc * 32 + fr, fq * 8);
#define PG8_SA(b, h) (((b) * 2 + (h)) * HTB)
#define PG8_SB(b, h) ((4 + (b) * 2 + (h)) * HTB)
#define PG8_STAGE(bufoff, gbase, voff) do { _Pragma("unroll") for (int _i = 0; _i < 2; ++_i) \
        __builtin_amdgcn_global_load_lds((const unsigned*)((const char*)(gbase) + (voff)[_i]), (PG8_LAS unsigned*)(lds + (bufoff) + ldsw + _i * 8192), 16, 0, 0); } while (0)
#define PG8_LDA(dst, b, h) do { _Pragma("unroll") for (int m = 0; m < 4; ++m) _Pragma("unroll") for (int k = 0; k < 2; ++k) dst[m][k] = *(const PG8_LAS bf16x8*)(lds + PG8_SA(b, h) + aoff + m * 2048 + k * 1024); } while (0)
#define PG8_LDB(dst, b, h) do { _Pragma("unroll") for (int n = 0; n < 2; ++n) _Pragma("unroll") for (int k = 0; k < 2; ++k) dst[n][k] = *(const PG8_LAS bf16x8*)(lds + PG8_SB(b, h) + boff + n * 2048 + k * 1024); } while (0)
#define PG8_MMA(ai, bj, At, Bt) do { __builtin_amdgcn_s_setprio(1); _Pragma("unroll") for (int m = 0; m < 4; ++m) _Pragma("unroll") for (int n = 0; n < 2; ++n) _Pragma("unroll") for (int k = 0; k < 2; ++k) \
        acc[ai][bj][m][n] = __builtin_amdgcn_mfma_f32_16x16x32_bf16(Bt[n][k], At[m][k], acc[ai][bj][m][n], 0, 0, 0); __builtin_amdgcn_s_setprio(0); } while (0)
#define PG8_WAIT_V(n) asm volatile("s_waitcnt vmcnt(" #n ")" ::: "memory")
#define PG8_WAIT_L(n) asm volatile("s_waitcnt lgkmcnt(" #n ")" ::: "memory")
#define PG8_BAR __builtin_amdgcn_s_barrier()
#define PG8_SCHED __builtin_amdgcn_sched_barrier(0)
    Unit cur, nxt; int ui = 0;
    if (!S.next(0, cur)) return;
    f32x4 acc[2][2][4][2];
#pragma unroll
    for (int a = 0; a < 2; ++a)
#pragma unroll
        for (int b = 0; b < 2; ++b)
#pragma unroll
            for (int m = 0; m < 4; ++m)
#pragma unroll
                for (int n = 0; n < 2; ++n) acc[a][b][m][n] = (f32x4){0.f, 0.f, 0.f, 0.f};
    bf16x8 At[4][2], B0[2][2], B1[2][2];
    const char* cA = (const char*)g.A + (size_t)cur.pm * g.a_tstep; const char* cB = (const char*)g.Bt + (size_t)cur.pn * tstep;
    S.a_ready(cur);
    if constexpr (SP2) {
        PG8_STAGE(PG8_SB(0, 0), cB, voffB); PG8_STAGE(PG8_SB(0, 1), cB + hstep, voffB); PG8_STAGE(PG8_SA(0, 0), cA, voffA); PG8_STAGE(PG8_SA(0, 1), cA + hstep, voffA);
        if (wr == 1) PG8_BAR;
        PG8_WAIT_V(2); PG8_BAR;
        PG8_STAGE(PG8_SB(1, 0), cB + kstep, voffB); PG8_STAGE(PG8_SA(1, 0), cA + kstep, voffA); PG8_STAGE(PG8_SB(1, 1), cB + hstep + kstep, voffB);
        PG8_WAIT_V(6); PG8_BAR;
    } else {
        PG8_STAGE(PG8_SB(0, 0), cB, voffB); PG8_STAGE(PG8_SA(0, 0), cA, voffA); PG8_STAGE(PG8_SB(0, 1), cB + hstep, voffB); PG8_STAGE(PG8_SA(0, 1), cA + hstep, voffA);
        if (wr == 1) PG8_BAR;
        PG8_WAIT_V(4); PG8_BAR;
        PG8_STAGE(PG8_SB(1, 0), cB + kstep, voffB); PG8_STAGE(PG8_SA(1, 0), cA + kstep, voffA); PG8_STAGE(PG8_SB(1, 1), cB + hstep + kstep, voffB);
        PG8_WAIT_V(6); PG8_BAR;
    }
    for (;;) {
        const bool has_next = S.next(ui + 1, nxt);
        const char* nA = has_next ? (const char*)g.A + (size_t)nxt.pm * g.a_tstep : cA; const char* nB = has_next ? (const char*)g.Bt + (size_t)nxt.pn * tstep : cB;
        for (int t = 0; t < nt; t += 2) {
            const bool last = (t == nt - 2);
            const char* a1 = cA + (size_t)(t + 1) * kstep;
            const char* a2 = last ? nA : cA + (size_t)(t + 2) * kstep; const char* b2 = last ? nB : cB + (size_t)(t + 2) * kstep;
            const char* a3 = a2 + kstep; const char* b3 = b2 + kstep;
            if (last && has_next) S.a_ready(nxt);
            if constexpr (SP2) {
            PG8_LDB(B0, 0, 0); PG8_LDB(B1, 0, 1); PG8_SCHED; PG8_LDA(At, 0, 0); PG8_STAGE(PG8_SA(1, 1), a1 + hstep, voffA);
            PG8_WAIT_V(8); PG8_WAIT_L(0); PG8_BAR; PG8_MMA(0, 0, At, B0); PG8_MMA(0, 1, At, B1); PG8_BAR; PG8_SCHED;
            PG8_LDA(At, 0, 1); PG8_STAGE(PG8_SB(0, 0), b2, voffB); PG8_STAGE(PG8_SB(0, 1), b2 + hstep, voffB); PG8_STAGE(PG8_SA(0, 0), a2, voffA);
            PG8_WAIT_V(8); PG8_WAIT_L(0); PG8_BAR; PG8_MMA(1, 0, At, B0); PG8_MMA(1, 1, At, B1); PG8_BAR; PG8_SCHED;
            PG8_LDB(B0, 1, 0); PG8_LDB(B1, 1, 1); PG8_SCHED; PG8_LDA(At, 1, 0); PG8_STAGE(PG8_SA(0, 1), a2 + hstep, voffA);
            PG8_WAIT_V(8); PG8_WAIT_L(0); PG8_BAR; PG8_MMA(0, 0, At, B0); PG8_MMA(0, 1, At, B1); PG8_BAR; PG8_SCHED;
            PG8_LDA(At, 1, 1); PG8_STAGE(PG8_SB(1, 0), b3, voffB); PG8_STAGE(PG8_SB(1, 1), b3 + hstep, voffB); PG8_STAGE(PG8_SA(1, 0), a3, voffA);
            PG8_WAIT_V(8); PG8_WAIT_L(0); PG8_BAR; PG8_MMA(1, 0, At, B0); PG8_MMA(1, 1, At, B1); PG8_BAR; PG8_SCHED;
            } else {
            PG8_LDB(B0, 0, 0); PG8_SCHED; PG8_LDA(At, 0, 0); PG8_STAGE(PG8_SA(1, 1), a1 + hstep, voffA);
            PG8_WAIT_L(8); PG8_BAR; PG8_WAIT_L(0); PG8_MMA(0, 0, At, B0); PG8_BAR; PG8_SCHED;
            PG8_LDB(B1, 0, 1); PG8_STAGE(PG8_SB(0, 0), b2, voffB);
            PG8_BAR; PG8_WAIT_L(0); PG8_MMA(0, 1, At, B1); PG8_BAR;
            PG8_LDA(At, 0, 1); PG8_STAGE(PG8_SA(0, 0), a2, voffA);
            PG8_BAR; PG8_WAIT_L(0); PG8_MMA(1, 0, At, B0); PG8_BAR; PG8_SCHED;
            PG8_STAGE(PG8_SB(0, 1), b2 + hstep, voffB);
            PG8_WAIT_V(6); PG8_BAR; PG8_MMA(1, 1, At, B1); PG8_BAR;
            PG8_LDB(B0, 1, 0); PG8_SCHED; PG8_LDA(At, 1, 0); PG8_STAGE(PG8_SA(0, 1), a2 + hstep, voffA);
            PG8_WAIT_L(8); PG8_BAR; PG8_WAIT_L(0); PG8_MMA(0, 0, At, B0); PG8_BAR; PG8_SCHED;
            PG8_LDB(B1, 1, 1); PG8_STAGE(PG8_SB(1, 0), b3, voffB);
            PG8_BAR; PG8_WAIT_L(0); PG8_MMA(0, 1, At, B1); PG8_BAR;
            PG8_LDA(At, 1, 1); PG8_STAGE(PG8_SA(1, 0), a3, voffA);
            PG8_BAR; PG8_WAIT_L(0); PG8_MMA(1, 0, At, B0); PG8_BAR; PG8_SCHED;
            PG8_STAGE(PG8_SB(1, 1), b3 + hstep, voffB);
            PG8_WAIT_V(6); PG8_BAR; PG8_MMA(1, 1, At, B1); PG8_BAR;
            }
            if constexpr (Epi::HAS_MID) { if (t == nt / 2 - 2) E.mid(acc, cur, wr, wc, fr, fq); }
        }
        if constexpr (ALIGN_EPI) { if (wr == 0) PG8_BAR; }
        if constexpr (!Epi::AFTER_DRAIN) { E(acc, cur, wr, wc, fr, fq); S.done(cur); }
        if (!has_next) break;
#pragma unroll
        for (int a = 0; a < 2; ++a)
#pragma unroll
            for (int b = 0; b < 2; ++b)
#pragma unroll
                for (int m = 0; m < 4; ++m)
#pragma unroll
                    for (int n = 0; n < 2; ++n) acc[a][b][m][n] = (f32x4){0.f, 0.f, 0.f, 0.f};
        cur = nxt; cA = nA; cB = nB; ++ui;
        if constexpr (ALIGN_EPI) { if (wr == 1) PG8_BAR; }
    }
    PG8_WAIT_V(0);
    if constexpr (!ALIGN_EPI) { if (wr == 0) PG8_BAR; }
    PG8_BAR;
    if constexpr (Epi::AFTER_DRAIN) { E.fused(acc, cur, wr, wc, fr, fq, lds, wid, lane); S.done(cur); }
#undef PG8_SA
#undef PG8_SB
#undef PG8_STAGE
#undef PG8_LDA
#undef PG8_LDB
#undef PG8_MMA
#undef PG8_WAIT_V
#undef PG8_WAIT_L
#undef PG8_BAR
#undef PG8_SCHED
}
}
#include <hip/hip_bf16.h>
#include <cmath>
namespace attn_body {
using bf16=__hip_bfloat16;
using bf16x8=__attribute__((ext_vector_type(8)))short;
using s16x4=__attribute__((ext_vector_type(4)))short;
using f32x16=__attribute__((ext_vector_type(16)))float;
using u32x4=__attribute__((ext_vector_type(4)))unsigned;
constexpr int BATCH=8,NHEAD=8,SEQ=8192,D=64,DM=NHEAD*D;
constexpr int NW=8,QBLK=32,QB=QBLK*NW,KVBLK=64,NQB=SEQ/QB;
constexpr int ATTN_PITCH=DM, ATTN_UNIT_ROWS=QB, ODM=1024;
constexpr float ATTN_SKIP_LOG2=SKIP_LOG2;
__device__ __forceinline__ int crow(int r,int hi){return (r&3)+8*(r>>2)+4*hi;}
#define SBAR() __builtin_amdgcn_sched_barrier(0)
__device__ __forceinline__ void cmask(f32x16&p0,f32x16&p1,int jb,int qrel,int hi){
  const float NEG=-INFINITY; int kb=64*jb+4*hi;
  #pragma unroll
  for(int r=0;r<16;++r){int kv=kb+(r&3)+8*(r>>2); if(kv>qrel)p0[r]=NEG; if(kv+32>qrel)p1[r]=NEG;}
}

constexpr int NSLOT=3, SLOTB=8192;
constexpr int LDS_K=0, LDS_V=NSLOT*SLOTB, LDS_WS=2*NSLOT*SLOTB, LDS_OST=LDS_WS+NW*64*4, LDS_CK=LDS_OST+NW*4096, LDS_T0=LDS_CK+SEQ*4, LDS_BYTES=LDS_T0+64;
constexpr float C2=0.125f*1.4426950408889634f;
__device__ __forceinline__ void glds16(const void*gsrc,unsigned lds_dst){unsigned keep;
  asm volatile("s_mov_b32 %0, m0\n\ts_mov_b32 m0, %2\n\ts_nop 0\n\tglobal_load_lds_dwordx4 %1, off\n\ts_mov_b32 m0, %0":"=&s"(keep):"v"(gsrc),"s"(lds_dst):"memory");}
__device__ __forceinline__ float max3f(float a,float b,float c){float r;asm("v_max3_f32 %0, %1, %2, %3":"=v"(r):"v"(a),"v"(b),"v"(c));return r;}
__device__ __forceinline__ float max2f(float a,float b){float r;asm("v_max_f32_e32 %0, %1, %2":"=v"(r):"v"(a),"v"(b));return r;}
__device__ __forceinline__ float fadd_s(float a,float b){float r;asm("v_add_f32_e32 %0, %1, %2":"=v"(r):"v"(a),"v"(b));return r;}
__device__ __forceinline__ float fsub_s(float a,float b){float r;asm("v_sub_f32_e32 %0, %1, %2":"=v"(r):"v"(a),"v"(b));return r;}
typedef float f32x2_t __attribute__((ext_vector_type(2))); typedef __bf16 bf16x2_t __attribute__((ext_vector_type(2)));
__device__ __forceinline__ unsigned cvtpk_s(float lo,float hi){f32x2_t v={lo,hi};bf16x2_t b=__builtin_convertvector(v,bf16x2_t);return __builtin_bit_cast(unsigned,b);}
#define WAIT_BAR(N) asm volatile("s_waitcnt vmcnt(" #N ") lgkmcnt(0)\n\ts_barrier":::"memory")

__device__ __forceinline__ void qkt(f32x16&p0,f32x16&p1,const char*Kslot,const bf16x8*qr,int r32,int hi){
  const char*kb=Kslot+hi*1024+r32*16;
  #pragma unroll
  for(int d0=0;d0<4;++d0){
    const bf16x8 b0=*reinterpret_cast<const bf16x8*>(kb+d0*2048);
    const bf16x8 b1=*reinterpret_cast<const bf16x8*>(kb+d0*2048+512);
    {p0=__builtin_amdgcn_mfma_f32_32x32x16_bf16(b0,qr[d0],p0,0,0,0);p1=__builtin_amdgcn_mfma_f32_32x32x16_bf16(b1,qr[d0],p1,0,0,0);}}
}
typedef __attribute__((address_space(3))) const char* lds_cptr;
typedef short v4i16_t __attribute__((ext_vector_type(4)));
__device__ __forceinline__ void kload8(bf16x8*kf,lds_cptr kp){
  kf[0]=*(const __attribute__((address_space(3))) bf16x8*)(kp);      kf[1]=*(const __attribute__((address_space(3))) bf16x8*)(kp+512);
  kf[2]=*(const __attribute__((address_space(3))) bf16x8*)(kp+2048); kf[3]=*(const __attribute__((address_space(3))) bf16x8*)(kp+2560);
  kf[4]=*(const __attribute__((address_space(3))) bf16x8*)(kp+4096); kf[5]=*(const __attribute__((address_space(3))) bf16x8*)(kp+4608);
  kf[6]=*(const __attribute__((address_space(3))) bf16x8*)(kp+6144); kf[7]=*(const __attribute__((address_space(3))) bf16x8*)(kp+6656);
}
__device__ __forceinline__ void kload2(bf16x8*kf,lds_cptr kp,int j){ kf[2*j]=*(const __attribute__((address_space(3))) bf16x8*)(kp+j*2048); kf[2*j+1]=*(const __attribute__((address_space(3))) bf16x8*)(kp+j*2048+512); }
__device__ __forceinline__ s16x4 vtr(lds_cptr p){ return __builtin_bit_cast(s16x4,__builtin_amdgcn_ds_read_tr16_b64_v4i16((__attribute__((address_space(3))) v4i16_t*)p)); }
__device__ __forceinline__ float rowmax(const f32x16&p0,const f32x16&p1){
  float a=max3f(p0[0],p0[1],p1[0]),b=max3f(p0[2],p0[3],p1[1]);a=max3f(a,p1[2],p1[3]);
  #pragma unroll
  for(int r=4;r<16;r+=4){a=max3f(a,p0[r],p0[r+1]);b=max3f(b,p0[r+2],p0[r+3]);a=max3f(a,p1[r],p1[r+1]);b=max3f(b,p1[r+2],p1[r+3]);}
  const float m=max2f(a,b);
  auto rr=__builtin_amdgcn_permlane32_swap(__float_as_uint(m),__float_as_uint(m),false,false);
  return max2f(__uint_as_float(rr[0]),__uint_as_float(rr[1]));
}
__device__ __forceinline__ void pv(f32x16*o,int vb,bf16x8 pa0,bf16x8 pa1,bf16x8 pa2,bf16x8 pa3){
  #pragma unroll
  for(int d0=0;d0<2;++d0){s16x4 lo[4],hi[4];
    #pragma unroll
    for(int ks=0;ks<4;++ks){
      asm volatile("ds_read_b64_tr_b16 %0,%1 offset:%c2":"=&v"(lo[ks]):"v"(vb),"i"(d0*4096+ks*1024):"memory");
      asm volatile("ds_read_b64_tr_b16 %0,%1 offset:%c2":"=&v"(hi[ks]):"v"(vb),"i"(d0*4096+ks*1024+512):"memory");}
    asm volatile("s_waitcnt lgkmcnt(0)":::"memory");SBAR();
    #define PK(k) (bf16x8){lo[k][0],lo[k][1],lo[k][2],lo[k][3],hi[k][0],hi[k][1],hi[k][2],hi[k][3]}
    o[d0]=__builtin_amdgcn_mfma_f32_32x32x16_bf16(pa0,PK(0),o[d0],0,0,0);
    o[d0]=__builtin_amdgcn_mfma_f32_32x32x16_bf16(pa1,PK(1),o[d0],0,0,0);
    o[d0]=__builtin_amdgcn_mfma_f32_32x32x16_bf16(pa2,PK(2),o[d0],0,0,0);
    o[d0]=__builtin_amdgcn_mfma_f32_32x32x16_bf16(pa3,PK(3),o[d0],0,0,0);
    #undef PK
  }
}

typedef __attribute__((address_space(3))) const float* lds_fptr;
typedef float f32x4_t __attribute__((ext_vector_type(4)));
__device__ __forceinline__ void biasinit(f32x16&c0,f32x16&c1,lds_fptr ckt,float aq){
  #pragma unroll
  for(int g=0;g<4;++g){ const f32x4_t v=*(const __attribute__((address_space(3))) f32x4_t*)(ckt+8*g); const f32x4_t w=*(const __attribute__((address_space(3))) f32x4_t*)(ckt+32+8*g);
    c0[4*g]=aq-v[0];c0[4*g+1]=aq-v[1];c0[4*g+2]=aq-v[2];c0[4*g+3]=aq-v[3]; c1[4*g]=aq-w[0];c1[4*g+1]=aq-w[1];c1[4*g+2]=aq-w[2];c1[4*g+3]=aq-w[3]; }
}
#ifndef ATTN_STORE16
#define ATTN_STORE16(p,v) (*(u32x4*)(p)=(v))
#endif
template<int THRL> __device__ __forceinline__ void attn_unit(int b,int h,int qb,const bf16*Q,const bf16*__restrict__ K,const bf16*__restrict__ V,bf16*O,char*shm,const float*__restrict__ CKg,const float Tskip){
  int tid_=threadIdx.x; asm volatile("":"+v"(tid_)); const int tid=tid_,lane=tid&63,r32=lane&31,hi=lane>>5; const int wid=__builtin_amdgcn_readfirstlane(tid>>6);
  const long rowbase=(long)b*SEQ; const int q0=qb*QB; const lds_cptr shm3=(lds_cptr)shm;
  const float*ckh=CKg+(long)(b*NHEAD+h)*SEQ; int t0;
  { __attribute__((address_space(3))) int*cw=(__attribute__((address_space(3))) int*)((__attribute__((address_space(3))) char*)shm3+LDS_T0);
    const int ntf=(q0+QB)/KVBLK; bool ok=false; if(tid>=1&&tid<=ntf-4) ok=(ckh[64*tid-1]-ckh[q0])>=Tskip;
    const unsigned long long bm=__ballot(ok); if(lane==0)cw[wid]=__popcll(bm);
    asm volatile("s_waitcnt vmcnt(0) lgkmcnt(0)\n\ts_barrier":::"memory");
    t0=__builtin_amdgcn_readfirstlane((cw[0]+cw[1])&~1); }
  const bf16*Qw=Q+(rowbase+q0+wid*QBLK)*DM+h*D;
  const bf16*Kh=K+(rowbase+64*t0)*DM+h*D,*Vh=V+(rowbase+64*t0)*DM+h*D;
  const unsigned lds0=(unsigned)(uintptr_t)shm;
  float*wsf=(float*)(shm+LDS_WS)+wid*64;
  const bf16*ksrc=Kh+(long)lane*DM+wid*8;
  const bf16*vsrc=Vh+(long)(16*(wid&3)+(lane>>2))*DM+(wid>>2)*32+(lane&3)*8;
  const unsigned kdst=lds0+LDS_K+wid*1024, vdst=lds0+LDS_V+wid*1024;
  #define DMA_K(t,slot) glds16(ksrc+(long)(t)*KVBLK*DM,(unsigned)__builtin_amdgcn_readfirstlane(kdst+(slot)))
  #define DMA_V(t,slot) glds16(vsrc+(long)(t)*KVBLK*DM,(unsigned)__builtin_amdgcn_readfirstlane(vdst+(slot)))
  const int vb0=(int)(lds0+LDS_V)+((lane>>4)&1)*32+(lane&3)*8+(4*hi+((lane&15)>>2))*64;
  const char*Kbase=shm+LDS_K; bf16x8 kf[8];
  const lds_cptr kp0=shm3+LDS_K+hi*1024+r32*16; const lds_cptr vp0=shm3+LDS_V+((lane>>4)&1)*32+(lane&3)*8+(4*hi+((lane&15)>>2))*64;
  const int NT=(q0+QB)/KVBLK-t0;
  { __attribute__((address_space(3))) f32x4_t*ckd=(__attribute__((address_space(3))) f32x4_t*)((__attribute__((address_space(3))) char*)shm3+LDS_CK);
    for(int i=tid;i<(q0+QB-64*t0)/4;i+=NW*64) ckd[i]=*(const f32x4_t*)(ckh+64*t0+4*i);
    asm volatile("s_waitcnt vmcnt(0) lgkmcnt(0)\n\ts_barrier":::"memory"); }
  const lds_fptr ckl=(lds_fptr)(shm3+LDS_CK);
  const float cq=ckl[q0-64*t0+wid*QBLK+r32]; float aq=cq;
  DMA_K(0,0);DMA_V(0,0);DMA_K(1,SLOTB);
  bf16x8 qr[4];
  #pragma unroll
  for(int d0=0;d0<4;++d0)qr[d0]=*reinterpret_cast<const bf16x8*>(&Qw[(long)r32*DM+d0*16+hi*8]);
  float mhat=0.f,l_reg=0.f;f32x16 o[2];o[0]=f32x16{};o[1]=f32x16{};
  const int qrel=wid*QBLK+r32;
  #define CMASK(P0,P1,t) do{int jb_=(t)-(NT-4); if(jb_>=0)cmask(P0,P1,jb_,qrel,hi);}while(0)
  bool resc=false;
  #define START(P0,P1) do{ const float rm=rowmax(P0,P1); resc=false; \
    { const float dl=rm; mhat=fadd_s(mhat,dl); \
      _Pragma("unroll") for(int r=0;r<16;++r){P0[r]=fsub_s(P0[r],dl);P1[r]=fsub_s(P1[r],dl);} \
      aq=cq-mhat; } \
    _Pragma("unroll") for(int r=0;r<16;++r)P0[r]=__builtin_amdgcn_exp2f(P0[r]); }while(0)
  #define RESC() do{ if(resc){ asm volatile("s_waitcnt lgkmcnt(0)":::"memory"); \
      _Pragma("unroll") for(int d_=0;d_<2;++d_) _Pragma("unroll") for(int r=0;r<16;++r)o[d_][r]*=wsf[crow(r,hi)]; } }while(0)
  f32x16 pA0,pA1,pB0,pB1;
  int sl_prev=0,sl_cur=0,sl_next=SLOTB;
  #define ROT() do{sl_prev=sl_cur;sl_cur=sl_next;sl_next=(sl_next==(NSLOT-1)*SLOTB)?0:sl_next+SLOTB;}while(0)
  DMA_K(2,2*SLOTB);
  WAIT_BAR(3);
  biasinit(pA0,pA1,ckl+4*hi,aq); qkt(pA0,pA1,Kbase,qr,r32,hi);asm volatile("s_nop 15\n\ts_nop 7":"+v"(pA0),"+v"(pA1));CMASK(pA0,pA1,0);
  START(pA0,pA1);
  _Pragma("unroll") for(int r=0;r<16;++r)pA1[r]=__builtin_amdgcn_exp2f(pA1[r]);
  WAIT_BAR(0);
  DMA_K(3,0);DMA_V(1,SLOTB);
  ROT();
  kload8(kf,kp0+sl_cur);
  WAIT_BAR(2);
  s16x4 vlo[8],vhi[8]; u32x4 pw0,pw1,pw2,pw3;
  #define PKW(P,B) cvtpk_s(P[B],P[B+1])
  #define PAF(k) __builtin_bit_cast(bf16x8,pw##k)
  #define VFR(i) (bf16x8){vlo[i][0],vlo[i][1],vlo[i][2],vlo[i][3],vhi[i][0],vhi[i][1],vhi[i][2],vhi[i][3]}
  #define PIN(x) asm volatile("":"+v"(x))
  #define MX3(a,b,c) __builtin_fmaxf(__builtin_fmaxf((a),(b)),(c))
  #define GAPA(MF,A0,A1,A2,A3,W0,W1,PW) do{ MF; sacc+=A0; sacc+=A1; sacc+=A2; sacc+=A3; PIN(sacc); W0; W1; PIN(PW); SBAR(); }while(0)
  #define EX(v) __builtin_amdgcn_exp2f(v)
  #define GAPB(MF,X,B) do{ MF; X[B]=EX(X[B]); X[B+1]=EX(X[B+1]); X[B+2]=EX(X[B+2]); X[B+3]=EX(X[B+3]); PIN(X); SBAR(); }while(0)
  #define VRD(i) do{ vlo[i]=vtr(vp_+(((i)>>2)*4096+((i)&3)*1024)); vhi[i]=vtr(vp_+(((i)>>2)*4096+((i)&3)*1024+512)); }while(0)
  #define KRD(G,j) do{ if(G){ kload2(kf,kp0+sl_next,j); SBAR(); } }while(0)
  #define STEP(C0,C1,P0,P1,t,GK,GV,GL) do{ SBAR(); biasinit(C0,C1,ckl+64*(t)+4*hi,aq); SBAR(); \
    const lds_cptr vp_=vp0+sl_prev; \
    VRD(0); SBAR(); float sacc=(P0[0]+P0[1]); \
    GAPA(C0=__builtin_amdgcn_mfma_f32_32x32x16_bf16(kf[0],qr[0],C0,0,0,0), P0[2],P0[3],P0[4],P0[5],     pw0[0]=PKW(P0,0), pw0[1]=PKW(P0,2), pw0); \
    VRD(4); SBAR(); GAPA(C1=__builtin_amdgcn_mfma_f32_32x32x16_bf16(kf[1],qr[0],C1,0,0,0), P0[6],P0[7],P0[8],P0[9],     pw0[2]=PKW(P0,4), pw0[3]=PKW(P0,6), pw0); \
    VRD(1); SBAR(); GAPA(C0=__builtin_amdgcn_mfma_f32_32x32x16_bf16(kf[2],qr[1],C0,0,0,0),   P0[10],P0[11],P0[12],P0[13], pw1[0]=PKW(P0,8), pw1[1]=PKW(P0,10), pw1); \
    VRD(5); SBAR(); GAPA(C1=__builtin_amdgcn_mfma_f32_32x32x16_bf16(kf[3],qr[1],C1,0,0,0),   P0[14],P0[15],P1[0],P1[1],   pw1[2]=PKW(P0,12),pw1[3]=PKW(P0,14), pw1); \
    VRD(2); SBAR(); GAPA(C0=__builtin_amdgcn_mfma_f32_32x32x16_bf16(kf[4],qr[2],C0,0,0,0),   P1[2],P1[3],P1[4],P1[5],     pw2[0]=PKW(P1,0), pw2[1]=PKW(P1,2), pw2); \
    VRD(6); SBAR(); GAPA(C1=__builtin_amdgcn_mfma_f32_32x32x16_bf16(kf[5],qr[2],C1,0,0,0),   P1[6],P1[7],P1[8],P1[9],     pw2[2]=PKW(P1,4), pw2[3]=PKW(P1,6), pw2); \
    VRD(3); SBAR(); GAPA(C0=__builtin_amdgcn_mfma_f32_32x32x16_bf16(kf[6],qr[3],C0,0,0,0),   P1[10],P1[11],P1[12],P1[13], pw3[0]=PKW(P1,8), pw3[1]=PKW(P1,10), pw3); \
    VRD(7); SBAR(); GAPA(C1=__builtin_amdgcn_mfma_f32_32x32x16_bf16(kf[7],qr[3],C1,0,0,0),   P1[14],P1[15],0.f,0.f,       pw3[2]=PKW(P1,12),pw3[3]=PKW(P1,14), pw3); \
    l_reg+=sacc; \
    if(GK){DMA_K((t)+3,sl_cur);} if(GV){DMA_V((t)+1,sl_next);} \
    CMASK(C0,C1,t); \
    { float a=MX3(C0[0],C0[1],C1[0]),b=MX3(C0[2],C0[3],C1[1]); a=MX3(a,C1[2],C1[3]); \
      _Pragma("unroll") for(int r=4;r<16;r+=4){a=MX3(a,C0[r],C0[r+1]);b=MX3(b,C0[r+2],C0[r+3]);a=MX3(a,C1[r],C1[r+1]);b=MX3(b,C1[r+2],C1[r+3]);} \
      float rm=__builtin_fmaxf(a,b); { auto rr=__builtin_amdgcn_permlane32_swap(__float_as_uint(rm),__float_as_uint(rm),false,false); rm=__builtin_fmaxf(__uint_as_float(rr[0]),__uint_as_float(rr[1])); } \
      resc=false; \
      if(__builtin_expect(__any(rm>(float)THRL),0)){ const float dl=__builtin_fmaxf(rm,0.f); mhat+=dl; \
        _Pragma("unroll") for(int r=0;r<16;++r){C0[r]-=dl;C1[r]-=dl;} \
        aq=cq-mhat; \
        const float f=__builtin_amdgcn_exp2f(-dl); l_reg*=f; if(hi==0)wsf[r32]=f; resc=true; } } \
    SBAR(); \
    GAPB(o[0]=__builtin_amdgcn_mfma_f32_32x32x16_bf16(PAF(0),VFR(0),o[0],0,0,0), C0,0); \
    GAPB(o[1]=__builtin_amdgcn_mfma_f32_32x32x16_bf16(PAF(0),VFR(4),o[1],0,0,0), C0,4); \
    KRD(GL,0); GAPB(o[0]=__builtin_amdgcn_mfma_f32_32x32x16_bf16(PAF(1),VFR(1),o[0],0,0,0), C0,8); \
    KRD(GL,1); GAPB(o[1]=__builtin_amdgcn_mfma_f32_32x32x16_bf16(PAF(1),VFR(5),o[1],0,0,0), C0,12); \
    KRD(GL,2); GAPB(o[0]=__builtin_amdgcn_mfma_f32_32x32x16_bf16(PAF(2),VFR(2),o[0],0,0,0), C1,0); \
    KRD(GL,3); GAPB(o[1]=__builtin_amdgcn_mfma_f32_32x32x16_bf16(PAF(2),VFR(6),o[1],0,0,0), C1,4); \
    GAPB(o[0]=__builtin_amdgcn_mfma_f32_32x32x16_bf16(PAF(3),VFR(3),o[0],0,0,0), C1,8); \
    GAPB(o[1]=__builtin_amdgcn_mfma_f32_32x32x16_bf16(PAF(3),VFR(7),o[1],0,0,0), C1,12); \
    }while(0)
  int t=1;
  #undef CMASK
  #define CMASK(P0,P1,t) do{}while(0)
  for(;t+5<NT;t+=2){
    STEP(pB0,pB1,pA0,pA1,t,true,true,true);     WAIT_BAR(2); RESC(); ROT();
    STEP(pA0,pA1,pB0,pB1,t+1,true,true,true);   WAIT_BAR(2); RESC(); ROT();
  }
  #undef CMASK
  #define CMASK(P0,P1,t) do{int jb_=(t)-(NT-4); if(jb_>=0)cmask(P0,P1,jb_,qrel,hi);}while(0)
  #define ENDW(tt) do{ if((tt)+3<NT){WAIT_BAR(2);} else if((tt)+2<NT){WAIT_BAR(1);} else {WAIT_BAR(0);} }while(0)
  for(;t+1<NT;t+=2){
    STEP(pB0,pB1,pA0,pA1,t,(t+3<NT),(t+1<NT),(t+1<NT));       ENDW(t);   RESC(); ROT();
    STEP(pA0,pA1,pB0,pB1,t+1,(t+4<NT),(t+2<NT),(t+2<NT));     ENDW(t+1); RESC(); ROT();
  }
  STEP(pB0,pB1,pA0,pA1,NT-1,false,false,false); RESC();
  { float sacc=pB0[0]+pB0[1]; _Pragma("unroll") for(int r=2;r<16;++r)sacc+=pB0[r]; _Pragma("unroll") for(int r=0;r<16;++r)sacc+=pB1[r]; l_reg+=sacc;
    pw0=(u32x4){PKW(pB0,0),PKW(pB0,2),PKW(pB0,4),PKW(pB0,6)};pw1=(u32x4){PKW(pB0,8),PKW(pB0,10),PKW(pB0,12),PKW(pB0,14)};pw2=(u32x4){PKW(pB1,0),PKW(pB1,2),PKW(pB1,4),PKW(pB1,6)};pw3=(u32x4){PKW(pB1,8),PKW(pB1,10),PKW(pB1,12),PKW(pB1,14)};
    SBAR(); pv(o,vb0+sl_cur,PAF(0),PAF(1),PAF(2),PAF(3)); }
  #undef PKW
  #undef PAF
  #undef VFR
  #undef PIN
  #undef MX3
  #undef GAPA
  #undef GAPB
  #undef EX
  #undef VRD
  #undef KRD
  #undef STEP
  #undef ENDW
  {auto rr=__builtin_amdgcn_permlane32_swap(__float_as_uint(l_reg),__float_as_uint(l_reg),false,false);l_reg=__uint_as_float(rr[0])+__uint_as_float(rr[1]);}
  if(hi==0)wsf[32+r32]=l_reg;asm volatile("s_waitcnt lgkmcnt(0)":::"memory");
  float rli[16];
  #pragma unroll
  for(int r=0;r<16;++r)rli[r]=__builtin_amdgcn_rcpf(wsf[32+crow(r,hi)]);
  bf16*Ow=O+(rowbase+q0+wid*QBLK)*ODM+h*D;
  { bf16*stg=(bf16*)(shm+LDS_OST)+wid*2048;
    #pragma unroll
    for(int r=0;r<16;++r){const int orow=crow(r,hi);
      #pragma unroll
      for(int d0=0;d0<2;++d0)stg[orow*64+d0*32+r32]=__float2bfloat16(o[d0][r]*rli[r]);}
    asm volatile("s_waitcnt lgkmcnt(0)":::"memory");
    #pragma unroll
    for(int i=0;i<4;++i){const int row=i*8+(lane>>3),ch=lane&7; const u32x4 v=*(const u32x4*)(stg+row*64+ch*8); ATTN_STORE16(Ow+(long)row*ODM+ch*8,v);} }
  asm volatile("s_waitcnt lgkmcnt(0)\n\ts_barrier":::"memory");
  #undef DMA_K
  #undef DMA_V
  #undef CMASK
  #undef START
  #undef RESC
  #undef ROT
}
constexpr int ATTN_LDS_BYTES=LDS_BYTES;
struct AttnTensors { const bf16* Q; const bf16* K; const bf16* V; bf16* O; const float* CK; const float* NRM; };
struct AttnUnit { int bh; int qb; };
struct StaticOrder {
  int vcu;
  __device__ __forceinline__ explicit StaticOrder(int grid,int block):vcu((block%8)*(grid/8)+block/8){}
  __device__ __forceinline__ bool next(int i,AttnUnit&u)const{ if(i>=8)return false; const int s=vcu&7,j=i&3; u.bh=(vcu>>3)+32*(i>>2); u.qb=(j==0)?s:(j==1)?15-s:(j==2)?16+s:31-s; return true; }
  __device__ __forceinline__ void a_ready(const AttnUnit&)const{}
  __device__ __forceinline__ void done(const AttnUnit&)const{}
};
struct DynOrder {
  unsigned*ctr; volatile __attribute__((address_space(3))) unsigned*slot; int x;
  __device__ __forceinline__ bool next(int,AttnUnit&u)const{
    if(threadIdx.x==0)*slot=atomicAdd(ctr+64*x,1u);
    __syncthreads(); const unsigned n=*slot; __syncthreads();
    if(n>=256u)return false; const int hs=7-(int)(n>>5), j=(x-hs)&7; u.bh=j*8+hs; u.qb=31-(int)(n&31u); return true; }
  __device__ __forceinline__ void a_ready(const AttnUnit&)const{}
  __device__ __forceinline__ void done(const AttnUnit&)const{}
};
template<class Sched,int THRL=32> __device__ __forceinline__ void attn_phase(char*lds,const AttnTensors&T,const Sched&S){
  AttnUnit u;
  for(int i=0;S.next(i,u);++i){ S.a_ready(u); { const float*nr=T.NRM+u.bh*4; const float tsk=ATTN_SKIP_LOG2+2.f+2.002f*sqrtf((nr[0]+nr[1])*(nr[2]+nr[3])); attn_unit<THRL>(u.bh/NHEAD,u.bh%NHEAD,u.qb,T.Q,T.K,T.V,T.O,lds,T.CK,tsk); } S.done(u); }
}
#undef SBAR
#undef WAIT_BAR
}
namespace cg = cooperative_groups;
#define LAS __attribute__((address_space(3)))
typedef unsigned v4u __attribute__((ext_vector_type(4)));
typedef unsigned v2u __attribute__((ext_vector_type(2)));
typedef float f32x4 __attribute__((ext_vector_type(4)));
using pg8::bf16_t;
#ifndef WGM_WIDE
#define WGM_WIDE 4
#endif
#ifndef WGM_NARROW
#define WGM_NARROW 2
#endif
constexpr int NWAVES = 8, SEQ = 8192, DM = 1024, NB = 8, DFF = 2816, NIN = 5128;
constexpr float LN_EPS = 1e-5f, LOG2E_F = 1.4426950408889634f;
constexpr size_t MiB = 1u << 20;
constexpr size_t WS_MOD = 0, WS_WFT = 512 * 1024, WS_NRM = 768 * 1024, WS_CTR = 772 * 1024, WS_BAR = 800 * 1024, WS_LF = 1 * MiB, WS_CK = 3 * MiB;
constexpr size_t WS_WIN = 6 * MiB, WS_WFS = 16 * MiB, WS_WO = 18 * MiB, WS_WUP = 20 * MiB, WS_WDN = 31 * MiB;
constexpr size_t WS_U = 40 * MiB;
constexpr size_t WS_QKV = 168 * MiB;
constexpr size_t WS_MERGED = WS_QKV + 128 * MiB;
constexpr size_t WS_ACT = WS_QKV;
constexpr size_t WS_G = 552 * MiB;
constexpr size_t WS_H1 = WS_G;
constexpr size_t WS_HALO = 808 * MiB;
constexpr size_t WS_END = 832 * MiB;
constexpr int RING_BYTES = 131072, XCH_OFF = RING_BYTES, MISC_OFF = XCH_OFF + 8192, LDS_BYTES = 147456;

#define LDS_WAIT() asm volatile("s_waitcnt lgkmcnt(0)" ::: "memory")
#define XB_TMO      128
#define XB_XCNT(j)  (256  + 64 * (j))
#define XB_XSUB(j)  (1280 + 64 * (j))
#define XB_XGEN(j)  (2304 + 64 * (j))
#define XB_TOP      3328
#define XB_TOPGEN   3392
#define XCD_BAR_WORDS 3456
#define XB_SPIN_CAP (1u << 18)

__device__ __forceinline__ unsigned xb_ld(unsigned* p)              { return __hip_atomic_load(p, __ATOMIC_RELAXED, __HIP_MEMORY_SCOPE_AGENT); }
__device__ __forceinline__ unsigned xb_add(unsigned* p, unsigned v) { return __hip_atomic_fetch_add(p, v, __ATOMIC_RELAXED, __HIP_MEMORY_SCOPE_AGENT); }
__device__ __forceinline__ unsigned xb_xcc_id() { return (unsigned)__builtin_amdgcn_s_getreg((3 << 11) | 20) & 0xFu; }
#define XB_SPIN(cond, bar) do { unsigned _sp = 0; while (cond) { __builtin_amdgcn_s_sleep(1); \
    if ((++_sp & 255u) == 0u) { if (xb_ld(&(bar)[XB_TMO])) break; if (_sp > XB_SPIN_CAP) { atomicAdd(&(bar)[XB_TMO], 1u); break; } } } } while (0)

struct XcdBarrier {
    unsigned* bar; unsigned x;
    volatile LAS unsigned* st;
};

__device__ __forceinline__ XcdBarrier xcd_barrier_post(unsigned* bar, volatile LAS unsigned* st) {
    XcdBarrier b; b.bar = bar; b.x = xb_xcc_id(); b.st = st;
    if (threadIdx.x == 0) (void)xb_add(&bar[XB_XCNT(b.x)], 1u);
    return b;
}
__device__ __forceinline__ void xcd_barrier_complete(unsigned* bar, unsigned x, unsigned& nloc, unsigned& nx) {
    const unsigned G = gridDim.x * gridDim.y * gridDim.z;
    unsigned sum, cnt, mine, sp = 0u;
    for (;;) {
        sum = 0u; cnt = 0u; mine = 0u;
#pragma unroll
        for (unsigned j = 0; j < 16; ++j) { const unsigned c = xb_ld(&bar[XB_XCNT(j)]); sum += c; cnt += (c > 0u) ? 1u : 0u; mine = (j == x) ? c : mine; }
        if (sum == G) break;
        __builtin_amdgcn_s_sleep(1);
        if ((++sp & 255u) == 0u) { if (xb_ld(&bar[XB_TMO])) break; if (sp > XB_SPIN_CAP) { atomicAdd(&bar[XB_TMO], 1u); break; } }
    }
    nloc = mine > 0u ? mine : 1u; nx = cnt > 0u ? cnt : 1u;
}

__device__ __forceinline__ void xcd_barrier(const XcdBarrier& b) {
    asm volatile("s_waitcnt vmcnt(0)" ::: "memory");
    __syncthreads();
    if (threadIdx.x == 0) {
        unsigned* bar = b.bar;
        __builtin_amdgcn_s_waitcnt(0);
        unsigned nloc = b.st[0], nx = b.st[1];
        if (nloc == 0u) { xcd_barrier_complete(bar, b.x, nloc, nx); b.st[0] = nloc; b.st[1] = nx; }
        const unsigned old = xb_add(&bar[XB_XSUB(b.x)], 1u);
        const unsigned gen = old / nloc;
        if (old + 1u == (gen + 1u) * nloc) {
            __builtin_amdgcn_fence(__ATOMIC_RELEASE, "agent");
            asm volatile("s_waitcnt vmcnt(0)" ::: "memory");
            const unsigned og = xb_add(&bar[XB_TOP], 1u);
            const unsigned tg = og / nx;
            if (og + 1u == (tg + 1u) * nx) xb_add(&bar[XB_TOPGEN], 1u);
            else XB_SPIN(xb_ld(&bar[XB_TOPGEN]) == tg, bar);
            __builtin_amdgcn_fence(__ATOMIC_ACQUIRE, "agent");
            xb_add(&bar[XB_XGEN(b.x)], 1u);
            asm volatile("s_waitcnt vmcnt(0)" ::: "memory");
        } else {
            XB_SPIN(xb_ld(&bar[XB_XGEN(b.x)]) == gen, bar);
            __builtin_amdgcn_fence(__ATOMIC_ACQUIRE, "agent");
            asm volatile("s_waitcnt vmcnt(0)" ::: "memory");
        }
    }
    __syncthreads();
}
__device__ __forceinline__ unsigned f2bf(float f) { unsigned u = __builtin_bit_cast(unsigned, f); return (u + 0x7fffu + ((u >> 16) & 1u)) >> 16; }
__device__ __forceinline__ unsigned pk2(float lo, float hi) { return f2bf(lo) | (f2bf(hi) << 16); }
__device__ __forceinline__ float wave_sum(float v) {
#pragma unroll
    for (int o = 1; o < 64; o <<= 1) v += __shfl_xor(v, o);
    return v;
}
__device__ __forceinline__ void wave_sum4(float (&s)[4]) {
#pragma unroll
    for (int o = 1; o < 64; o <<= 1) {
#pragma unroll
        for (int i = 0; i < 4; ++i) s[i] += __shfl_xor(s[i], o); }
}
__device__ __forceinline__ void tr_item(const float* W, int ldw, int srcc0, int k0, bf16_t* WT, int ldk, int dstr0, LAS float* scr, int lane, int dk0 = 0) {
#pragma unroll 8
    for (int i = 0; i < 32; ++i) { const int kk = 2 * i + (lane >> 5); scr[kk * 33 + (lane & 31)] = W[(size_t)(k0 + kk) * ldw + srcc0 + (lane & 31)]; }
    LDS_WAIT();
    const int c = lane & 7;
#pragma unroll
    for (int j = 0; j < 4; ++j) { const int n = (lane >> 3) + 8 * j; const LAS float* s = scr + (8 * c) * 33 + n;
        v4u o; o.x = pk2(s[0 * 33], s[1 * 33]); o.y = pk2(s[2 * 33], s[3 * 33]); o.z = pk2(s[4 * 33], s[5 * 33]); o.w = pk2(s[6 * 33], s[7 * 33]);
        *(v4u*)(WT + (size_t)(dstr0 + n) * ldk + dk0 + k0 + 8 * c) = o; }
    LDS_WAIT();
}

constexpr float SB_STICK_MIN = 3.3881318e-21f;
typedef short s16x8 __attribute__((ext_vector_type(8)));
typedef float f32x16 __attribute__((ext_vector_type(16)));
__device__ __forceinline__ int crow16(int r, int hi) { return (r & 3) + 8 * (r >> 2) + 4 * hi; }
template <bool DIAG> __device__ __forceinline__ float sb_weights(const f32x16& s, int k0, int q, int hi, float C, float (&av)[16]) {
    float uv[16], bt[16], sfx[16], own[4], oth[4], sufg[4];
#pragma unroll
    for (int r = 0; r < 16; ++r) { const float zz = __builtin_fminf(s[r], 100.f), ex = __builtin_amdgcn_exp2f(zz), ui = __builtin_amdgcn_rcpf(1.0f + ex);
        if (DIAG) { const bool valid = (k0 + crow16(r, hi)) < q; uv[r] = valid ? ui : 1.0f; bt[r] = valid ? ex * ui : 0.f; } else { uv[r] = ui; bt[r] = ex * ui; } }
#pragma unroll
    for (int i = 0; i < 4; ++i) { const float a3 = uv[4 * i + 3], a2 = a3 * uv[4 * i + 2], a1 = a2 * uv[4 * i + 1]; own[i] = a1 * uv[4 * i];
        sfx[4 * i + 3] = bt[4 * i + 3]; sfx[4 * i + 2] = bt[4 * i + 2] * a3; sfx[4 * i + 1] = bt[4 * i + 1] * a2; sfx[4 * i] = bt[4 * i] * a1; }
#pragma unroll
    for (int i = 0; i < 4; ++i) oth[i] = __shfl_xor(own[i], 32);
    float accs = C;
#pragma unroll
    for (int i = 3; i >= 0; --i) { sufg[i] = (hi == 0) ? accs * oth[i] : accs; accs *= own[i] * oth[i]; }
#pragma unroll
    for (int r = 0; r < 16; ++r) av[r] = sfx[r] * sufg[r >> 2];
    return accs;
}
__device__ __forceinline__ void sb_unit(int b, int h, int qblk, const bf16_t* Q, const bf16_t* __restrict__ K, const bf16_t* __restrict__ V, bf16_t* O, LAS unsigned char* vst, int lane_) {
    int lane = lane_; asm volatile("" : "+v"(lane));
    const int r32 = lane & 31, hi = lane >> 5; const size_t rowbase = (size_t)b * SEQ; const int qw0 = qblk * 32, q = qw0 + r32;
    const bf16_t* Qw = Q + (rowbase + qw0) * 512 + h * 64;
    s16x8 qr[4];
#pragma unroll
    for (int d0 = 0; d0 < 4; ++d0) qr[d0] = *(const s16x8*)(Qw + (size_t)r32 * 512 + d0 * 16 + hi * 8);
    f32x16 o0 = {}, o1 = {}; float C = 1.f;
    s16x8 kn[4]; v4u vn[4];
    { const bf16_t* Kp = K + (rowbase + qblk * 32 + r32) * 512 + h * 64 + hi * 8;
#pragma unroll
      for (int d0 = 0; d0 < 4; ++d0) kn[d0] = *(const s16x8*)(Kp + d0 * 16);
#pragma unroll
      for (int i = 0; i < 4; ++i) { const int c = lane + 64 * i; vn[i] = *(const v4u*)(V + (rowbase + qblk * 32 + (c >> 3)) * 512 + h * 64 + (c & 7) * 8); } }
    for (int jt = qblk; jt >= 0; --jt) {
        const int k0 = jt * 32;
        s16x8 kf[4];
#pragma unroll
        for (int d0 = 0; d0 < 4; ++d0) kf[d0] = kn[d0];
#pragma unroll
        for (int i = 0; i < 4; ++i) { const int c = lane + 64 * i, key = c >> 3, part = c & 7; *(LAS v4u*)(vst + key * 144 + part * 16) = vn[i]; }
        if (jt > 0) { const bf16_t* Kp = K + (rowbase + k0 - 32 + r32) * 512 + h * 64 + hi * 8;
#pragma unroll
            for (int d0 = 0; d0 < 4; ++d0) kn[d0] = *(const s16x8*)(Kp + d0 * 16);
#pragma unroll
            for (int i = 0; i < 4; ++i) { const int c = lane + 64 * i; vn[i] = *(const v4u*)(V + (rowbase + k0 - 32 + (c >> 3)) * 512 + h * 64 + (c & 7) * 8); } }
        f32x16 s = {};
#pragma unroll
        for (int d0 = 0; d0 < 4; ++d0) s = __builtin_amdgcn_mfma_f32_32x32x16_bf16(kf[d0], qr[d0], s, 0, 0, 0);
        float av[16];
        if (jt == qblk) C = sb_weights<true>(s, k0, q, hi, C, av); else C = sb_weights<false>(s, k0, q, hi, C, av);
        v4u pa0, pa1;
        pa0.x = pg8::cvt_pk_bf16(av[0], av[1]); pa0.y = pg8::cvt_pk_bf16(av[2], av[3]); pa0.z = pg8::cvt_pk_bf16(av[4], av[5]); pa0.w = pg8::cvt_pk_bf16(av[6], av[7]);
        pa1.x = pg8::cvt_pk_bf16(av[8], av[9]); pa1.y = pg8::cvt_pk_bf16(av[10], av[11]); pa1.z = pg8::cvt_pk_bf16(av[12], av[13]); pa1.w = pg8::cvt_pk_bf16(av[14], av[15]);
        LDS_WAIT();
#pragma unroll
        for (int ks = 0; ks < 2; ++ks)
#pragma unroll
            for (int d0 = 0; d0 < 2; ++d0) { unsigned short e[8];
#pragma unroll
                for (int j = 0; j < 8; ++j) e[j] = *(const LAS unsigned short*)(vst + (16 * ks + 8 * (j >> 2) + 4 * hi + (j & 3)) * 144 + (32 * d0 + r32) * 2);
                v4u vb; vb.x = e[0] | ((unsigned)e[1] << 16); vb.y = e[2] | ((unsigned)e[3] << 16); vb.z = e[4] | ((unsigned)e[5] << 16); vb.w = e[6] | ((unsigned)e[7] << 16);
                const s16x8 pa = __builtin_bit_cast(s16x8, ks == 0 ? pa0 : pa1), vf = __builtin_bit_cast(s16x8, vb);
                if (d0 == 0) o0 = __builtin_amdgcn_mfma_f32_32x32x16_bf16(pa, vf, o0, 0, 0, 0); else o1 = __builtin_amdgcn_mfma_f32_32x32x16_bf16(pa, vf, o1, 0, 0, 0); }
        LDS_WAIT();
        if (__all((SKIP_LOG2 >= 149.f) ? (C == 0.f) : (C < SB_STICK_MIN))) break;
    }
    bf16_t* Ow = O + (rowbase + qw0) * 1024 + 512 + h * 64;
#pragma unroll
    for (int r = 0; r < 16; ++r) { const int orow = crow16(r, hi);
        Ow[(size_t)orow * 1024 + r32] = (bf16_t)f2bf(o0[r]); Ow[(size_t)orow * 1024 + 32 + r32] = (bf16_t)f2bf(o1[r]); }
}

struct Args { const float* in[17]; float* out; unsigned char* ws; };

__global__ void __launch_bounds__(NWAVES * 64, 2) fwd_mega(Args args) {
    extern __shared__ __attribute__((aligned(16))) unsigned char lds[];
    cg::grid_group grid = cg::this_grid();
    LAS unsigned char* L = (LAS unsigned char*)lds;
    const int tid = threadIdx.x, lane = tid & 63, wave = __builtin_amdgcn_readfirstlane(tid >> 6);
    const int G = gridDim.x, gw = blockIdx.x * NWAVES + wave, NGW = G * NWAVES;
    unsigned char* ws = args.ws;
    volatile LAS unsigned* xst = (volatile LAS unsigned*)(L + MISC_OFF + 512);
    if (tid == 0) { xst[0] = 0u; xst[1] = 0u; }
    __syncthreads();
    const XcdBarrier xbar = xcd_barrier_post((unsigned*)(ws + WS_BAR), xst);
#if defined(PROBE_AT)
    if (blockIdx.x == 0 && tid == 0) { *(volatile LAS unsigned long long*)(L + MISC_OFF + 256) = __builtin_amdgcn_s_memrealtime(); }
#define PROBE_MARK(k) do { if ((k) == PROBE_AT && blockIdx.x == 0 && tid == 0) { *(volatile LAS unsigned long long*)(L + MISC_OFF + 264) = __builtin_amdgcn_s_memrealtime(); } } while (0)
#else
#define PROBE_MARK(k) do {} while (0)
#endif
    const float* x = args.in[0]; const float* cvec = args.in[1]; const float* w_ada = args.in[2]; const float* b_ada = args.in[3]; const float* w_in = args.in[4];
    const float* b_forget = args.in[5]; const float* w_fox = args.in[6]; const float* w_sb = args.in[7]; const float* w_o = args.in[8];
    const float* ln1_g = args.in[9]; const float* ln1_b = args.in[10]; const float* w_up = args.in[11]; const float* conv_w = args.in[12]; const float* conv_b = args.in[13];
    const float* w_dn = args.in[14]; const float* ln2_g = args.in[15]; const float* ln2_b = args.in[16];
    float* MOD = (float*)(ws + WS_MOD); float* WFT = (float*)(ws + WS_WFT); float* LF = (float*)(ws + WS_LF); float* CK = (float*)(ws + WS_CK);
    bf16_t* WIN = (bf16_t*)(ws + WS_WIN); bf16_t* WFS = (bf16_t*)(ws + WS_WFS); bf16_t* WO = (bf16_t*)(ws + WS_WO); bf16_t* WUP = (bf16_t*)(ws + WS_WUP); bf16_t* WDN = (bf16_t*)(ws + WS_WDN);
    bf16_t* U = (bf16_t*)(ws + WS_U); bf16_t* QKV = (bf16_t*)(ws + WS_QKV); bf16_t* MERGED = (bf16_t*)(ws + WS_MERGED); bf16_t* ACT = (bf16_t*)(ws + WS_ACT);
    bf16_t* GATES = (bf16_t*)(ws + WS_G); float* H1 = (float*)(ws + WS_H1);
    const size_t SLOT = (size_t)MTOK * 512;
    bf16_t* QA = QKV; bf16_t* QB = QKV + SLOT; bf16_t* KA = QKV + 2 * SLOT; bf16_t* VA = QKV + 3 * SLOT; bf16_t* KB = QKV + 4 * SLOT; bf16_t* VB = QKV + 5 * SLOT;

#if !defined(SKIP_P0)
    {
        LAS float* scr = (LAS float*)(L + wave * 16384);
        constexpr int I_IN = 16 * 160, I_FS = 8 * 32, I_O = 16 * 32, I_UP = 16 * 176, I_DN = 44 * 32, I_MOD = 768;
        constexpr int NIT = I_MOD + I_IN + 2 * I_FS + I_O + I_UP + I_DN;
        for (int it = gw; it < NIT; it += NGW) {
            int r = it;
            if (r < I_MOD) {
                const int j0 = 8 * r; float a[8][8];
#pragma unroll
                for (int bb = 0; bb < 8; ++bb)
#pragma unroll
                    for (int j = 0; j < 8; ++j) a[bb][j] = 0.f;
#pragma unroll 4
                for (int i = 0; i < 16; ++i) { const int k = lane + 64 * i; const f32x4 w0 = *(const f32x4*)(w_ada + (size_t)k * 6144 + j0), w1 = *(const f32x4*)(w_ada + (size_t)k * 6144 + j0 + 4);
#pragma unroll
                    for (int bb = 0; bb < 8; ++bb) { const float cb = cvec[bb * 1024 + k];
                        a[bb][0] += cb * w0[0]; a[bb][1] += cb * w0[1]; a[bb][2] += cb * w0[2]; a[bb][3] += cb * w0[3]; a[bb][4] += cb * w1[0]; a[bb][5] += cb * w1[1]; a[bb][6] += cb * w1[2]; a[bb][7] += cb * w1[3]; } }
                float mine = 0.f;
#pragma unroll
                for (int bb = 0; bb < 8; ++bb)
#pragma unroll
                    for (int j = 0; j < 8; ++j) { const float s = wave_sum(a[bb][j]); if (lane == bb * 8 + j) mine = s; }
                MOD[(lane >> 3) * 6144 + j0 + (lane & 7)] = mine + b_ada[j0 + (lane & 7)];
                continue;
            }
            r -= I_MOD;
            if (r < I_IN) { const int kb = r / 160, nb = r % 160, n0 = 32 * nb; const int t = n0 - 3072;
                const int src = (n0 < 1536) ? n0 : (n0 < 3072) ? n0 + 8 : 3080 + ((t >> 7) & 1) * 1024 + 128 * (t >> 8) + (t & 127);
                tr_item(w_in, NIN, src, 64 * kb, WIN, 1024, n0, scr, lane); continue; } r -= I_IN;
            if (r < I_FS) { const int kb = r / 32, nb = r % 32; tr_item(w_fox, 1024, 32 * nb, 64 * kb, WFS, 1024, 32 * nb, scr, lane, 0); continue; } r -= I_FS;
            if (r < I_FS) { const int kb = r / 32, nb = r % 32; tr_item(w_sb, 1024, 32 * nb, 64 * kb, WFS, 1024, 32 * nb, scr, lane, 512); continue; } r -= I_FS;
            if (r < I_O) { const int kb = r / 32, nb = r % 32; tr_item(w_o, 1024, 32 * nb, 64 * kb, WO, 1024, 32 * nb, scr, lane); continue; } r -= I_O;
            if (r < I_UP) { const int kb = r / 176, nb = r % 176, nn0 = 32 * nb; const int src = ((nn0 >> 7) & 1) * DFF + 128 * (nn0 >> 8) + (nn0 & 127);
                tr_item(w_up, 2 * DFF, src, 64 * kb, WUP, 1024, nn0, scr, lane); continue; } r -= I_UP;
            { const int kb = r / 32, nb = r % 32; tr_item(w_dn, 1024, 32 * nb, 64 * kb, WDN, DFF, 32 * nb, scr, lane); }
        }
        if (blockIdx.x == 0) { ((float*)(ws + WS_NRM))[tid & 255] = 0.f; ((unsigned*)(ws + WS_CTR))[tid] = 0u; }
        for (int e = blockIdx.x * (NWAVES * 64) + tid; e < 8192; e += G * NWAVES * 64) WFT[e] = w_in[(size_t)(e & 1023) * NIN + 1536 + (e >> 10)];
    }
#endif
    if (G == 0x7fffffff) grid.sync();
    xcd_barrier(xbar);
    PROBE_MARK(0);

#if !defined(SKIP_P1)
    LAS f32x4* wfl = (LAS f32x4*)L;
    for (int i = tid; i < 2048; i += NWAVES * 64) wfl[i] = ((const f32x4*)WFT)[i];
    __syncthreads();
    for (int blk = gw; blk < MTOK / 32; blk += NGW) {
        const int m0 = blk * 32, b = m0 >> 13; const float* mb = MOD + (size_t)b * 6144;
        const float bf = b_forget[lane & 7];
        f32x4 xn[4];
#pragma unroll
        for (int j = 0; j < 4; ++j) xn[j] = __builtin_nontemporal_load(((const f32x4*)(x + (size_t)m0 * 1024) + lane) + 64 * j);
        for (int r = 0; r < 32; ++r) {
            const int m = m0 + r; unsigned long long* o8 = (unsigned long long*)(U + (size_t)m * 1024) + lane;
            f32x4 u[4], xc[4];
#pragma unroll
            for (int j = 0; j < 4; ++j) xc[j] = xn[j];
            if (r < 31) {
#pragma unroll
                for (int j = 0; j < 4; ++j) xn[j] = __builtin_nontemporal_load(((const f32x4*)(x + (size_t)(m + 1) * 1024) + lane) + 64 * j); }
#pragma unroll
            for (int j = 0; j < 4; ++j) { const f32x4 shj = *(const f32x4*)(mb + 4 * lane + 256 * j), scj = *(const f32x4*)(mb + 1024 + 4 * lane + 256 * j) + 1.0f; u[j] = xc[j] * scj + shj; o8[64 * j] = (unsigned long long)pk2(u[j][0], u[j][1]) | ((unsigned long long)pk2(u[j][2], u[j][3]) << 32); }
            float mine = 0.f;
#pragma unroll
            for (int hh = 0; hh < 8; ++hh) { float s = 0.f;
#pragma unroll
                for (int j = 0; j < 4; ++j) { const f32x4 p = u[j] * wfl[hh * 256 + lane + 64 * j]; s += (p[0] + p[1]) + (p[2] + p[3]); }
                s = wave_sum(s); if ((lane & 7) == hh) mine = s; }
            if (lane < 8) { const float f = mine + bf; const float ls = (f >= 0.f) ? -log1pf(expf(-f)) : (f - log1pf(expf(f)));
                LF[((size_t)(b * 8 + lane)) * SEQ + (m & (SEQ - 1))] = ls * LOG2E_F; }
        }
    }
#endif
    xcd_barrier(xbar);
    PROBE_MARK(1);

#if !defined(SKIP_P2)
    if (blockIdx.x < 64) {
        LAS double* sm = (LAS double*)(L + MISC_OFF);
        const float* src = LF + (size_t)blockIdx.x * SEQ + 16 * tid; float* dst = CK + (size_t)blockIdx.x * SEQ + 16 * tid;
        f32x4 v[4]; double loc[16]; double run = 0.0;
#pragma unroll
        for (int j = 0; j < 4; ++j) v[j] = *(const f32x4*)(src + 4 * j);
#pragma unroll
        for (int i = 0; i < 16; ++i) { run += (double)v[i >> 2][i & 3]; loc[i] = run; }
        double inc = run;
#pragma unroll
        for (int o = 1; o < 64; o <<= 1) { const double t = __shfl_up(inc, o); if (lane >= o) inc += t; }
        if (lane == 63) sm[wave] = inc;
        __syncthreads();
        double woff = 0.0;
        for (int w = 0; w < wave; ++w) woff += sm[w];
        const double excl = woff + inc - run;
#pragma unroll
        for (int j = 0; j < 4; ++j) *(f32x4*)(dst + 4 * j) = (f32x4){(float)(excl + loc[4 * j]), (float)(excl + loc[4 * j + 1]), (float)(excl + loc[4 * j + 2]), (float)(excl + loc[4 * j + 3])};
        __syncthreads();
    }
    {
        pg8::Gemm g{U, WIN, MTOK, 5120, 1024, (size_t)256 * 1024 * 2}; pg8::StaticOrder S; S.init(MTOK, 5120, G, (int)blockIdx.x); S.wgm = WGM_WIDE;
        pg8::EpiInProj E{QKV, GATES, (unsigned*)(ws + WS_NRM)};
        pg8::gemm_phase<pg8::EpiInProj, pg8::StaticOrder, true, true>(L, g, S, E);
    }
#endif
    xcd_barrier(xbar);
    PROBE_MARK(2);

#if !defined(SKIP_P3)
    {
        LAS unsigned char* vst = L + wave * 4608;
        for (int i = 0; i < (64 * 256) / NGW + 1; ++i) { const int uid = i * NGW + gw; if (uid >= 64 * 256) break; const int bh = uid >> 8, qblk = uid & 255;
            sb_unit(bh >> 3, bh & 7, qblk, QB, KB, VB, U, vst, lane); }
        __syncthreads();
        PROBE_MARK(20);
        const attn_body::AttnTensors AT{(const attn_body::bf16*)QA, (const attn_body::bf16*)KA, (const attn_body::bf16*)VA, (attn_body::bf16*)U, CK, (const float*)(ws + WS_NRM)};
        const attn_body::DynOrder S{(unsigned*)(ws + WS_CTR), (volatile LAS unsigned*)(L + MISC_OFF + 128), (int)(blockIdx.x & 7)};
        attn_body::attn_phase<attn_body::DynOrder>((char*)lds, AT, S);
    }
#endif
    xcd_barrier(xbar);
    PROBE_MARK(3);

#if !defined(SKIP_P4)
    {
        pg8::Gemm g{U, WFS, MTOK, 1024, 1024, (size_t)256 * 1024 * 2}; pg8::StaticOrder S; S.init(MTOK, 1024, G, (int)blockIdx.x); S.wgm = WGM_NARROW;
        pg8::EpiMerge E{GATES, MERGED};
        pg8::gemm_phase<pg8::EpiMerge, pg8::StaticOrder, true, true>(L, g, S, E);
    }
#endif
    xcd_barrier(xbar);
    PROBE_MARK(4);

#if !defined(SKIP_P5)
    {
        pg8::Gemm g{MERGED, WO, MTOK, 1024, 1024, (size_t)256 * 1024 * 2}; pg8::StaticOrder S; S.init(MTOK, 1024, G, (int)blockIdx.x); S.wgm = WGM_NARROW;
        pg8::EpiBranch E{MOD + 2048, U};
        pg8::gemm_phase<pg8::EpiBranch, pg8::StaticOrder, true, true>(L, g, S, E);
    }
#endif
    xcd_barrier(xbar);
    PROBE_MARK(5);

#if !defined(SKIP_P6)
    for (int blk = gw; blk < MTOK / 32; blk += NGW) {
        const int m0 = blk * 32, b = m0 >> 13; const float* mb = MOD + (size_t)b * 6144;
        f32x4 sc[4], sh[4], lg[4], lb[4];
#pragma unroll
        for (int j = 0; j < 4; ++j) { sh[j] = *(const f32x4*)(mb + 3072 + 4 * lane + 256 * j); sc[j] = *(const f32x4*)(mb + 4096 + 4 * lane + 256 * j) + 1.0f;
            lg[j] = *(const f32x4*)(ln1_g + 4 * lane + 256 * j); lb[j] = *(const f32x4*)(ln1_b + 4 * lane + 256 * j); }
        for (int g4 = 0; g4 < 8; ++g4) {
            const int mg = m0 + 4 * g4;
            f32x4 v[4][4]; unsigned long long bb[4][4];
#pragma unroll
            for (int i = 0; i < 4; ++i)
#pragma unroll
                for (int j = 0; j < 4; ++j) { v[i][j] = __builtin_nontemporal_load(((const f32x4*)(x + (size_t)(mg + i) * 1024) + lane) + 64 * j); bb[i][j] = __builtin_nontemporal_load(((const unsigned long long*)(U + (size_t)(mg + i) * 1024) + lane) + 64 * j); }
            float s[4], s2[4];
#pragma unroll
            for (int i = 0; i < 4; ++i) { s[i] = 0.f;
#pragma unroll
                for (int j = 0; j < 4; ++j) { const unsigned blo = (unsigned)bb[i][j], bhi = (unsigned)(bb[i][j] >> 32);
                    v[i][j] = v[i][j] * DN_ALPHA + (f32x4){pg8::bflo(blo), pg8::bfhi(blo), pg8::bflo(bhi), pg8::bfhi(bhi)}; s[i] += (v[i][j][0] + v[i][j][1]) + (v[i][j][2] + v[i][j][3]); } }
            wave_sum4(s);
#pragma unroll
            for (int i = 0; i < 4; ++i) { const float mean = s[i] * (1.f / 1024.f); s2[i] = 0.f;
#pragma unroll
                for (int j = 0; j < 4; ++j) { v[i][j] = v[i][j] - mean; s2[i] += (v[i][j][0] * v[i][j][0] + v[i][j][1] * v[i][j][1]) + (v[i][j][2] * v[i][j][2] + v[i][j][3] * v[i][j][3]); } }
            wave_sum4(s2);
#pragma unroll
            for (int i = 0; i < 4; ++i) { const float rstd = 1.f / sqrtf(s2[i] * (1.f / 1024.f) + LN_EPS);
                unsigned long long* hr = (unsigned long long*)((bf16_t*)H1 + (size_t)(mg + i) * 1024) + lane; unsigned long long* o8 = (unsigned long long*)(U + (size_t)(mg + i) * 1024) + lane;
#pragma unroll
                for (int j = 0; j < 4; ++j) { const f32x4 x1 = v[i][j] * rstd * lg[j] + lb[j]; hr[64 * j] = (unsigned long long)pk2(x1[0], x1[1]) | ((unsigned long long)pk2(x1[2], x1[3]) << 32);
                    const f32x4 u2 = x1 * sc[j] + sh[j]; o8[64 * j] = (unsigned long long)pk2(u2[0], u2[1]) | ((unsigned long long)pk2(u2[2], u2[3]) << 32); } }
        }
    }
#endif
    xcd_barrier(xbar);
    PROBE_MARK(6);

#if !defined(SKIP_P7)
    {
        pg8::Gemm g{U, WUP, MTOK, 2 * DFF, 1024, (size_t)256 * 1024 * 2}; pg8::StaticOrder S; S.init(MTOK, 2 * DFF, G, (int)blockIdx.x); S.wgm = WGM_WIDE;
        pg8::EpiUpConv E{conv_w, conv_b, ACT, (LAS f32x4*)(L + XCH_OFF), (LAS float*)(L + MISC_OFF + 1024), (float*)(ws + WS_HALO)};
        pg8::gemm_phase<pg8::EpiUpConv, pg8::StaticOrder, true, true>(L, g, S, E);
    }
    xcd_barrier(xbar);
    {
        const float* HALO = (const float*)(ws + WS_HALO);
        for (int idx = blockIdx.x * (NWAVES * 64) + tid; idx < 43 * DFF; idx += G * NWAVES * 64) {
            const int pg = idx / DFF, ch = idx - pg * DFF, nng = 256 * (ch >> 7) + (ch & 127);
            float w0[2], w1[2], w2[2], bb[2];
#pragma unroll
            for (int v = 0; v < 2; ++v) { const int cc = ch + DFF * v; w0[v] = conv_w[cc]; w1[v] = conv_w[5632 + cc]; w2[v] = conv_w[2 * 5632 + cc]; bb[v] = conv_b[cc]; }
            float h0[6][2], h1[6][2], hm2[6][2], hm1[6][2];
#pragma unroll
            for (int k = 0; k < 6; ++k) { const int p = 6 * pg + k; const bool in = p < 256, s0 = (p & 31) == 0;
                const float* Hc = HALO + (size_t)(in ? p : 0) * 4 * 5632; const float* Hp = Hc - (s0 ? 0 : 4 * 5632);
#pragma unroll
                for (int v = 0; v < 2; ++v) { const int nn = nng + 128 * v; h0[k][v] = Hc[nn]; h1[k][v] = Hc[5632 + nn]; hm2[k][v] = Hp[2 * 5632 + nn]; hm1[k][v] = Hp[3 * 5632 + nn]; } }
#pragma unroll
            for (int k = 0; k < 6; ++k) { const int p = 6 * pg + k; if (p >= 256) break; const bool s0 = (p & 31) == 0; float cr0[2], cr1[2];
#pragma unroll
                for (int v = 0; v < 2; ++v) { const float a2 = s0 ? 0.f : hm2[k][v], a1 = s0 ? 0.f : hm1[k][v];
                    cr0[v] = bb[v] + w0[v] * a2 + w1[v] * a1 + w2[v] * h0[k][v]; cr1[v] = bb[v] + w0[v] * a1 + w1[v] * h0[k][v] + w2[v] * h1[k][v]; }
                ACT[(size_t)(256 * p) * DFF + ch] = (bf16_t)f2bf(cr0[0] * pg8::sigm(cr0[0]) * cr0[1]);
                ACT[(size_t)(256 * p + 1) * DFF + ch] = (bf16_t)f2bf(cr1[0] * pg8::sigm(cr1[0]) * cr1[1]); }
        }
    }
#endif
    xcd_barrier(xbar);
    PROBE_MARK(7);

#if !defined(SKIP_P8)
    {
        pg8::Gemm g{ACT, WDN, MTOK, 1024, DFF, (size_t)256 * DFF * 2}; pg8::StaticOrder S; S.init(MTOK, 1024, G, (int)blockIdx.x); S.wgm = WGM_NARROW;
        pg8::EpiBranch E{MOD + 5120, U};
        pg8::gemm_phase<pg8::EpiBranch, pg8::StaticOrder, true, true>(L, g, S, E);
    }
#endif
    xcd_barrier(xbar);
    PROBE_MARK(8);

#if !defined(SKIP_P9)
    {
        f32x4 lg[4], lb[4]; const bf16_t* X1B = (const bf16_t*)H1;
#pragma unroll
        for (int j = 0; j < 4; ++j) { lg[j] = *(const f32x4*)(ln2_g + 4 * lane + 256 * j); lb[j] = *(const f32x4*)(ln2_b + 4 * lane + 256 * j); }
        for (int blk = gw; blk < MTOK / 32; blk += NGW)
        for (int g4 = 0; g4 < 8; ++g4) {
            const int mg = blk * 32 + 4 * g4;
            unsigned long long xb[4][4], bb[4][4];
#pragma unroll
            for (int i = 0; i < 4; ++i)
#pragma unroll
                for (int j = 0; j < 4; ++j) { xb[i][j] = __builtin_nontemporal_load(((const unsigned long long*)(X1B + (size_t)(mg + i) * 1024) + lane) + 64 * j); bb[i][j] = __builtin_nontemporal_load(((const unsigned long long*)(U + (size_t)(mg + i) * 1024) + lane) + 64 * j); }
            f32x4 v[4][4]; float s[4], s2[4];
#pragma unroll
            for (int i = 0; i < 4; ++i) { s[i] = 0.f;
#pragma unroll
                for (int j = 0; j < 4; ++j) { const unsigned xlo = (unsigned)xb[i][j], xhi = (unsigned)(xb[i][j] >> 32), blo = (unsigned)bb[i][j], bhi = (unsigned)(bb[i][j] >> 32);
                    v[i][j] = (f32x4){pg8::bflo(xlo), pg8::bfhi(xlo), pg8::bflo(xhi), pg8::bfhi(xhi)} * DN_ALPHA + (f32x4){pg8::bflo(blo), pg8::bfhi(blo), pg8::bflo(bhi), pg8::bfhi(bhi)};
                    s[i] += (v[i][j][0] + v[i][j][1]) + (v[i][j][2] + v[i][j][3]); } }
            wave_sum4(s);
#pragma unroll
            for (int i = 0; i < 4; ++i) { const float mean = s[i] * (1.f / 1024.f); s2[i] = 0.f;
#pragma unroll
                for (int j = 0; j < 4; ++j) { v[i][j] = v[i][j] - mean; s2[i] += (v[i][j][0] * v[i][j][0] + v[i][j][1] * v[i][j][1]) + (v[i][j][2] * v[i][j][2] + v[i][j][3] * v[i][j][3]); } }
            wave_sum4(s2);
#pragma unroll
            for (int i = 0; i < 4; ++i) { const float rstd = 1.f / sqrtf(s2[i] * (1.f / 1024.f) + LN_EPS); f32x4* hr = (f32x4*)(args.out + (size_t)(mg + i) * 1024) + lane;
#pragma unroll
                for (int j = 0; j < 4; ++j) hr[64 * j] = v[i][j] * rstd * lg[j] + lb[j]; }
        }
    }
#endif
#if defined(PROBE_AT)
    if (blockIdx.x == 0 && tid == 0) { const unsigned long long a = *(volatile LAS unsigned long long*)(L + MISC_OFF + 256), b = *(volatile LAS unsigned long long*)(L + MISC_OFF + 264);
        const unsigned long long t1 = __builtin_amdgcn_s_memrealtime(); while (__builtin_amdgcn_s_memrealtime() - t1 < 2 * (b - a)) __builtin_amdgcn_s_sleep(8); }
#endif
}

extern "C" void kernel_launch(void* const* d_in, const int* in_sizes, int n_in, void* d_out, int out_size, void* d_ws, size_t ws_size, hipStream_t stream) {
    static int grid = 0;
    if (grid == 0) {
        if (n_in != 17 || out_size != MTOK * 1024 || ws_size < WS_END) { fprintf(stderr, "kernel_launch: unexpected shapes (n_in %d out %d ws %zu)\n", n_in, out_size, ws_size); grid = -1; return; }
        int dev = 0, cus = 0, per_cu = 0;
        hipGetDevice(&dev); hipDeviceGetAttribute(&cus, hipDeviceAttributeMultiprocessorCount, dev);
        if (hipFuncSetAttribute((const void*)fwd_mega, hipFuncAttributeMaxDynamicSharedMemorySize, LDS_BYTES) != hipSuccess) { fprintf(stderr, "kernel_launch: hipFuncSetAttribute failed\n"); grid = -1; return; }
        hipOccupancyMaxActiveBlocksPerMultiprocessor(&per_cu, (const void*)fwd_mega, NWAVES * 64, LDS_BYTES);
        (void)hipGetLastError();
        if (per_cu < 1) per_cu = 1;
        grid = cus * 1;
    }
    if (grid < 0) return;
    if (hipMemsetAsync((char*)d_ws + WS_BAR, 0, XCD_BAR_WORDS * 4, stream) != hipSuccess) { fprintf(stderr, "kernel_launch: memset of the barrier words failed\n"); return; }
    Args a{};
    for (int i = 0; i < 17; ++i) a.in[i] = (const float*)d_in[i];
    a.out = (float*)d_out; a.ws = (unsigned char*)d_ws;
    void* kargs[] = {&a};
    hipError_t e = hipLaunchCooperativeKernel((const void*)fwd_mega, dim3(grid), dim3(NWAVES * 64), kargs, LDS_BYTES, stream);
    if (e != hipSuccess) fprintf(stderr, "cooperative launch failed: %s (grid %d)\n", hipGetErrorString(e), grid);
}
```
